# Optimizing an MI355X kernel written in HIP

```python
import jax
import jax.numpy as jnp
from jax import lax
import numpy as np

D_MODEL = 1024
BATCH = 32
SEQ = 2048
DEPTH = 2

CTX_LEN = 256
GRID_W = 64
HEAD_DIM = 64
NA_HEADS = 4
NA_ROWS = 8
NA_COLS = 16
GQA_HEADS = 8
GQA_KV_HEADS = 2
MLA_HEADS = 4
MLA_Q_RANK = 256
MLA_KV_RANK = 128
MLA_NOPE = 64
MLA_ROPE = 32
MLA_V = 64
N_BRANCH = 3
N_MOD = 9
D_FF = ((8 * D_MODEL // 3 + 127) // 128) * 128
Q_BLOCK = 128
ROPE_THETA = 10000.0
EPS = 1e-6
NEG_BIG = -1e30

NA_WIDTH = NA_HEADS * HEAD_DIM
GQA_Q_WIDTH = GQA_HEADS * HEAD_DIM
GQA_KV_WIDTH = GQA_KV_HEADS * HEAD_DIM
MLA_OUT_WIDTH = MLA_HEADS * MLA_V
IN_SIZES = (NA_WIDTH, NA_WIDTH, NA_WIDTH, GQA_Q_WIDTH, GQA_KV_WIDTH, GQA_KV_WIDTH,
            MLA_Q_RANK, MLA_KV_RANK, MLA_ROPE, N_BRANCH * D_MODEL)
IN_SPLITS = tuple(int(s) for s in np.cumsum(IN_SIZES)[:-1])
IN_WIDTH = sum(IN_SIZES)

kernel_name = "hybrid_na_gqa_mla_macaron_dit"


def rmsnorm(x, g):
    xf = x.astype(jnp.float32)
    y = xf * lax.rsqrt(jnp.mean(xf * xf, axis=-1, keepdims=True) + EPS)
    return (y * g.astype(jnp.float32)).astype(x.dtype)


def modulate(h, shift, scale):
    return h * (1.0 + scale) + shift


def swiglu(h, w_gate, w_up, w_down):
    return (jax.nn.silu(h @ w_gate) * (h @ w_up)) @ w_down


def half_ffn(h, shift, scale, gate, g_norm, w_gate, w_up, w_down):
    n = modulate(rmsnorm(h, g_norm), shift, scale)
    return h + 0.5 * gate * swiglu(n, w_gate, w_up, w_down)


def axial_rope(n_tok, d_rot):
    half = d_rot // 2
    freqs = ROPE_THETA ** (-jnp.arange(0, half, 2, dtype=jnp.float32) / half)
    t = jnp.arange(n_tok)
    row = (t // GRID_W).astype(jnp.float32)[:, None] * freqs
    col = (t % GRID_W).astype(jnp.float32)[:, None] * freqs
    ang = jnp.concatenate([row, row, col, col], axis=-1)
    return jnp.cos(ang), jnp.sin(ang)


def apply_rope(x, cos, sin):
    xr = x.reshape(x.shape[:-1] + (2, 2, -1))
    rot = jnp.concatenate([-xr[..., 1:, :], xr[..., :1, :]], axis=-2).reshape(x.shape)
    return x * cos.astype(x.dtype) + rot * sin.astype(x.dtype)


def project_heads(n, w_in, q_norm, k_norm, mq_norm, mkv_norm, w_uq, w_ukv, rope):
    bn, t_len, _ = n.shape
    a_q, a_k, a_v, b_q, b_k, b_v, c_q, c_kv, c_kr, gates = jnp.split(n @ w_in, IN_SPLITS, axis=-1)

    def heads(t, h):
        return t.reshape(bn, t_len, h, -1).transpose(0, 2, 1, 3)

    attn_a = (heads(a_q, NA_HEADS), heads(a_k, NA_HEADS), heads(a_v, NA_HEADS))
    b_q = rmsnorm(heads(b_q, GQA_HEADS), q_norm)
    b_k = rmsnorm(heads(b_k, GQA_KV_HEADS), k_norm)
    q_lat = heads(rmsnorm(c_q, mq_norm) @ w_uq, MLA_HEADS)
    kv_lat = heads(rmsnorm(c_kv, mkv_norm) @ w_ukv, MLA_HEADS)
    q_nope, q_rope = q_lat[..., :MLA_NOPE], q_lat[..., MLA_NOPE:]
    k_nope, m_v = kv_lat[..., :MLA_NOPE], kv_lat[..., MLA_NOPE:]
    k_rope = c_kr[:, None]
    if rope is not None:
        cos_b, sin_b, cos_m, sin_m = rope
        b_q = apply_rope(b_q, cos_b, sin_b)
        b_k = apply_rope(b_k, cos_b, sin_b)
        q_rope = apply_rope(q_rope, cos_m, sin_m)
        k_rope = apply_rope(k_rope, cos_m, sin_m)
    m_q = jnp.concatenate([q_nope, q_rope], axis=-1)
    m_k = jnp.concatenate([k_nope, jnp.broadcast_to(k_rope, k_nope.shape[:-1] + (MLA_ROPE,))], axis=-1)
    return attn_a, (b_q, b_k, heads(b_v, GQA_KV_HEADS)), (m_q, m_k, m_v), gates


def block_attention(q, k, v, scale):
    bn, hq, t_len, dk = q.shape
    hkv = k.shape[1]
    grp = hq // hkv
    nblk = t_len // Q_BLOCK
    qb = q.reshape(bn, hkv, grp, nblk, Q_BLOCK, dk).transpose(3, 0, 1, 2, 4, 5)

    def one_block(qi):
        s = jnp.einsum('bhgqd,bhkd->bhgqk', qi, k).astype(jnp.float32) * scale
        p = jax.nn.softmax(s, axis=-1).astype(v.dtype)
        return jnp.einsum('bhgqk,bhkd->bhgqd', p, v)

    o = lax.map(one_block, qb)
    return o.transpose(1, 2, 3, 0, 4, 5).reshape(bn, hq, t_len, v.shape[-1])


def neighbourhood_attention(q, k, v, k_ctx, v_ctx, rel_bias):
    bn, h, s_len, d = q.shape
    rows = s_len // GRID_W
    wr = min(NA_ROWS, rows)
    scale = d ** -0.5

    def grid(t):
        return t.reshape(bn, h, rows, GRID_W, d)

    kg, vg = grid(k), grid(v)
    q_rows = jnp.moveaxis(grid(q), 2, 0)
    cols = jnp.arange(GRID_W)
    c0 = jnp.clip(cols - NA_COLS // 2, 0, GRID_W - NA_COLS)
    col_in = (cols[None, :] >= c0[:, None]) & (cols[None, :] < c0[:, None] + NA_COLS)
    col_idx = jnp.clip(cols[None, :] - cols[:, None] + NA_COLS - 1, 0, 2 * NA_COLS - 2)
    mask = jnp.broadcast_to(col_in[:, None, :], (GRID_W, wr, GRID_W)).reshape(GRID_W, wr * GRID_W)
    n_loc = wr * GRID_W

    def row_block(args):
        qr, r = args
        r0 = jnp.clip(r - wr // 2, 0, rows - wr)
        kr = lax.dynamic_slice_in_dim(kg, r0, wr, axis=2).reshape(bn, h, n_loc, d)
        vr = lax.dynamic_slice_in_dim(vg, r0, wr, axis=2).reshape(bn, h, n_loc, d)
        dr_idx = r0 + jnp.arange(wr) - r + (NA_ROWS - 1)
        bias = rel_bias[:, dr_idx[None, :, None], col_idx[:, None, :]].reshape(h, GRID_W, n_loc)
        s_loc = jnp.einsum('bhqd,bhkd->bhqk', qr, kr).astype(jnp.float32) * scale + bias.astype(jnp.float32)
        s_loc = jnp.where(mask, s_loc, NEG_BIG)
        s_ctx = jnp.einsum('bhqd,bhkd->bhqk', qr, k_ctx).astype(jnp.float32) * scale
        p = jax.nn.softmax(jnp.concatenate([s_loc, s_ctx], axis=-1), axis=-1).astype(v.dtype)
        return (jnp.einsum('bhqk,bhkd->bhqd', p[..., :n_loc], vr)
                + jnp.einsum('bhqk,bhkd->bhqd', p[..., n_loc:], v_ctx))

    o = lax.map(row_block, (q_rows, jnp.arange(rows)))
    return jnp.moveaxis(o, 0, 2).reshape(bn, h, s_len, d)


def merge_branches(o_a, o_b, o_m, gate_logits, w_a, w_b, w_m, w_o):
    def flat(o):
        return o.transpose(0, 2, 1, 3).reshape(o.shape[0], o.shape[2], -1)

    g_a, g_b, g_m = jnp.split(jax.nn.sigmoid(gate_logits), N_BRANCH, axis=-1)
    y = g_a * (flat(o_a) @ w_a) + g_b * (flat(o_b) @ w_b) + g_m * (flat(o_m) @ w_m)
    return y @ w_o


def setup_inputs(seed: int = 0) -> dict:
    key = jax.random.key(seed)
    ks = iter(jax.random.split(key, 32))
    d = D_MODEL

    def nrm(shape, s):
        return jax.random.normal(next(ks), shape, jnp.float32) * s

    def lin(shape):
        return nrm(shape, shape[-2] ** -0.5)

    def gain(shape):
        return 1.0 + nrm(shape, 0.1)

    return {
        "x": nrm((BATCH, SEQ, d), 1.0),
        "c": nrm((BATCH, d), 1.0),
        "ctx": nrm((BATCH, CTX_LEN, d), 1.0),
        "c_ctx": nrm((d,), 1.0),
        "w_ada": nrm((DEPTH, d, N_MOD * d), 0.5 * d ** -0.5),
        "b_ada": nrm((DEPTH, N_MOD * d), 0.02),
        "ffn1_norm": gain((DEPTH, d)),
        "ffn1_w_gate": lin((DEPTH, d, D_FF)),
        "ffn1_w_up": lin((DEPTH, d, D_FF)),
        "ffn1_w_down": lin((DEPTH, D_FF, d)),
        "mix_norm": gain((DEPTH, d)),
        "w_in": lin((DEPTH, d, IN_WIDTH)),
        "na_rel_bias": nrm((DEPTH, NA_HEADS, 2 * NA_ROWS - 1, 2 * NA_COLS - 1), 0.2),
        "gqa_q_norm": gain((DEPTH, HEAD_DIM)),
        "gqa_k_norm": gain((DEPTH, HEAD_DIM)),
        "mla_q_norm": gain((DEPTH, MLA_Q_RANK)),
        "mla_kv_norm": gain((DEPTH, MLA_KV_RANK)),
        "mla_w_uq": lin((DEPTH, MLA_Q_RANK, MLA_HEADS * (MLA_NOPE + MLA_ROPE))),
        "mla_w_ukv": lin((DEPTH, MLA_KV_RANK, MLA_HEADS * (MLA_NOPE + MLA_V))),
        "w_branch_a": lin((DEPTH, NA_WIDTH, d)),
        "w_branch_b": lin((DEPTH, GQA_Q_WIDTH, d)),
        "w_branch_c": lin((DEPTH, MLA_OUT_WIDTH, d)),
        "w_out": lin((DEPTH, d, d)),
        "ffn2_norm": gain((DEPTH, d)),
        "ffn2_w_gate": lin((DEPTH, d, D_FF)),
        "ffn2_w_up": lin((DEPTH, d, D_FF)),
        "ffn2_w_down": lin((DEPTH, D_FF, d)),
        "final_norm": gain((d,)),
    }


def reference(x, c, ctx, c_ctx, w_ada, b_ada, ffn1_norm, ffn1_w_gate, ffn1_w_up, ffn1_w_down,
              mix_norm, w_in, na_rel_bias, gqa_q_norm, gqa_k_norm, mla_q_norm, mla_kv_norm,
              mla_w_uq, mla_w_ukv, w_branch_a, w_branch_b, w_branch_c, w_out,
              ffn2_norm, ffn2_w_gate, ffn2_w_up, ffn2_w_down, final_norm):
    n_tok = x.shape[1]
    cos_b, sin_b = axial_rope(n_tok, HEAD_DIM)
    cos_m, sin_m = axial_rope(n_tok, MLA_ROPE)
    rope = (cos_b, sin_b, cos_m, sin_m)
    na_scale = HEAD_DIM ** -0.5
    gqa_scale = HEAD_DIM ** -0.5
    mla_scale = (MLA_NOPE + MLA_ROPE) ** -0.5

    for i in range(DEPTH):
        mod_x = [m[:, None, :] for m in jnp.split(jax.nn.silu(c) @ w_ada[i] + b_ada[i], N_MOD, axis=-1)]
        mod_c = jnp.split(jax.nn.silu(c_ctx) @ w_ada[i] + b_ada[i], N_MOD, axis=-1)
        ffn1 = (ffn1_norm[i], ffn1_w_gate[i], ffn1_w_up[i], ffn1_w_down[i])
        ffn2 = (ffn2_norm[i], ffn2_w_gate[i], ffn2_w_up[i], ffn2_w_down[i])
        proj = (w_in[i], gqa_q_norm[i], gqa_k_norm[i], mla_q_norm[i], mla_kv_norm[i], mla_w_uq[i], mla_w_ukv[i])
        merge = (w_branch_a[i], w_branch_b[i], w_branch_c[i], w_out[i])

        x = half_ffn(x, mod_x[0], mod_x[1], mod_x[2], *ffn1)
        ctx = half_ffn(ctx, mod_c[0], mod_c[1], mod_c[2], *ffn1)

        nx = modulate(rmsnorm(x, mix_norm[i]), mod_x[3], mod_x[4])
        nc = modulate(rmsnorm(ctx, mix_norm[i]), mod_c[3], mod_c[4])
        (aq, ak, av), (bq, bk, bv), (mq, mk, mv), gates = project_heads(nx, *proj, rope)
        (caq, cak, cav), (cbq, cbk, cbv), (cmq, cmk, cmv), cgates = project_heads(nc, *proj, None)

        o_a = neighbourhood_attention(aq, ak, av, cak, cav, na_rel_bias[i])
        o_b = block_attention(bq, jnp.concatenate([bk, cbk], axis=2), jnp.concatenate([bv, cbv], axis=2), gqa_scale)
        o_m = block_attention(mq, jnp.concatenate([mk, cmk], axis=2), jnp.concatenate([mv, cmv], axis=2), mla_scale)
        x = x + mod_x[5] * merge_branches(o_a, o_b, o_m, gates, *merge)
        x = half_ffn(x, mod_x[6], mod_x[7], mod_x[8], *ffn2)

        if i < DEPTH - 1:
            oc_a = block_attention(caq, cak, cav, na_scale)
            oc_b = block_attention(cbq, cbk, cbv, gqa_scale)
            oc_m = block_attention(cmq, cmk, cmv, mla_scale)
            ctx = ctx + mod_c[5] * merge_branches(oc_a, oc_b, oc_m, cgates, *merge)
            ctx = half_ffn(ctx, mod_c[6], mod_c[7], mod_c[8], *ffn2)

    return rmsnorm(x, final_norm)
```

```cpp
#include <hip/hip_runtime.h>
#include <hip/hip_cooperative_groups.h>
#include <cstdio>
#include <cstdint>
namespace cg = cooperative_groups;
namespace pg8 {
#define PG8_LAS __attribute__((address_space(3)))
typedef unsigned short bf16_t;
typedef short bf16x8 __attribute__((ext_vector_type(8)));
typedef float f32x4 __attribute__((ext_vector_type(4)));
typedef unsigned u32x4 __attribute__((ext_vector_type(4)));
constexpr int BM = 256, BK = 64, HALF = 128, HTB = HALF * BK * 2  , STAGE_BYTES = 8 * HTB, NXCD = 8, WGM = 8;

__host__ __device__ __forceinline__ int lds_byte(int r, int c) { const int st = (r >> 4) * 2 + (c >> 5), rr = r & 15, cc = c & 31, ob = rr * 64 + cc * 2; return st * 1024 + (ob ^ (((ob >> 9) & 1) << 5)); }
__host__ __device__ __forceinline__ void stage_rc(int b, int& R, int& C) { const int st = b / 1024, sb = b % 1024, swz = sb ^ (((sb >> 9) & 1) << 5); R = (st >> 1) * 16 + swz / 64; C = (st & 1) * 32 + (swz % 64) / 2; }
__host__ __device__ __forceinline__ int perm32(int rho) { const int n = rho >> 4, i = rho & 15; return 8 * (i >> 2) + 4 * n + (i & 3); }

struct Unit { int pm, pn; };
struct Gemm { const bf16_t* A; const bf16_t* Bt; int lda, ldb, K; };

struct StaticOrder {
    int nM, nN, nwg, G, c;
    __host__ __device__ void init(int M, int N, int G_, int c_) { nM = M / BM; nN = N / BM; nwg = nM * nN; G = G_; c = c_; }
    __host__ __device__ bool next(int i, Unit& u) const {
        const long L = (long)i * G + c; if (L >= nwg) return false;
        int wgid = (int)L; { const int q = nwg / NXCD, r = nwg % NXCD, xcd = wgid % NXCD, off = wgid / NXCD; wgid = (xcd < r ? xcd * (q + 1) : r * (q + 1) + (xcd - r) * q) + off; }
        const int nig = WGM * nN, gid = wgid / nig, fm = gid * WGM, gsz = (nM - fm) < WGM ? (nM - fm) : WGM;
        u.pm = fm + ((wgid % nig) % gsz); u.pn = (wgid % nig) / gsz; return true;
    }
    __device__ __forceinline__ void a_ready(const Unit&) const {}
    __device__ __forceinline__ void done(const Unit&) const {}
};

__device__ __forceinline__ unsigned cvt_pk_bf16(float lo, float hi) { unsigned r; asm volatile("v_cvt_pk_bf16_f32 %0, %1, %2" : "=v"(r) : "v"(lo), "v"(hi)); return r; }
template <class Epi, class Sched, bool ALIGN_EPI = false, bool SP2 = false>
__device__ __forceinline__ void gemm_phase(PG8_LAS unsigned char* lds, const Gemm g, const Sched& S, const Epi& E, const int tid) {
    const int wid = __builtin_amdgcn_readfirstlane(tid >> 6), lane = tid & 63, wr = wid >> 2, wc = wid & 3, fr = lane & 15, fq = lane >> 4;
    const int K = g.K, nt = K / BK;
    unsigned voffA[2], voffB[2];
#pragma unroll
    for (int i = 0; i < 2; ++i) { int R, C; stage_rc(tid * 16 + i * 8192, R, C); const int Rb = Epi::PERM ? ((R & ~31) + perm32(R & 31)) : R;
        voffA[i] = (unsigned)(R * g.lda + C) * 2u; voffB[i] = (unsigned)(Rb * g.ldb + C) * 2u; }
    const size_t kstep = (size_t)(BK * 2);
    const size_t hstepA = (size_t)HALF * g.lda * 2, hstepB = (size_t)HALF * g.ldb * 2;
    const size_t tstepA = 2 * hstepA, tstepB = 2 * hstepB;
    const unsigned ldsw = (unsigned)wid * 1024u;
    const int aoff = lds_byte(wr * 64 + fr, fq * 8), boff = lds_byte(wc * 32 + fr, fq * 8);
#define PG8_SA(b, h) (((b) * 2 + (h)) * HTB)
#define PG8_SB(b, h) ((4 + (b) * 2 + (h)) * HTB)
#define PG8_STAGE(bufoff, gbase, voff) do { _Pragma("unroll") for (int _i = 0; _i < 2; ++_i) \
        __builtin_amdgcn_global_load_lds((const unsigned*)((const char*)(gbase) + (voff)[_i]), (PG8_LAS unsigned*)(lds + (bufoff) + ldsw + _i * 8192), 16, 0, 0); } while (0)
#define PG8_LDA(dst, b, h) do { _Pragma("unroll") for (int m = 0; m < 4; ++m) _Pragma("unroll") for (int k = 0; k < 2; ++k) dst[m][k] = *(const PG8_LAS bf16x8*)(lds + PG8_SA(b, h) + aoff + m * 2048 + k * 1024); } while (0)
#define PG8_LDB(dst, b, h) do { _Pragma("unroll") for (int n = 0; n < 2; ++n) _Pragma("unroll") for (int k = 0; k < 2; ++k) dst[n][k] = *(const PG8_LAS bf16x8*)(lds + PG8_SB(b, h) + boff + n * 2048 + k * 1024); } while (0)
#define PG8_MMA(ai, bj, At, Bt) do { __builtin_amdgcn_s_setprio(1); _Pragma("unroll") for (int m = 0; m < 4; ++m) _Pragma("unroll") for (int n = 0; n < 2; ++n) _Pragma("unroll") for (int k = 0; k < 2; ++k) \
        acc[ai][bj][m][n] = __builtin_amdgcn_mfma_f32_16x16x32_bf16(Bt[n][k], At[m][k], acc[ai][bj][m][n], 0, 0, 0); __builtin_amdgcn_s_setprio(0); } while (0)
#define PG8_WAIT_V(n) asm volatile("s_waitcnt vmcnt(" #n ")" ::: "memory")
#define PG8_WAIT_L(n) asm volatile("s_waitcnt lgkmcnt(" #n ")" ::: "memory")
#define PG8_BAR __builtin_amdgcn_s_barrier()
#define PG8_SCHED __builtin_amdgcn_sched_barrier(0)
    Unit cur, nxt; int ui = 0;
    if (!S.next(0, cur)) return;
    f32x4 acc[2][2][4][2];
#pragma unroll
    for (int a = 0; a < 2; ++a)
#pragma unroll
        for (int b = 0; b < 2; ++b)
#pragma unroll
            for (int m = 0; m < 4; ++m)
#pragma unroll
                for (int n = 0; n < 2; ++n) acc[a][b][m][n] = (f32x4){0.f, 0.f, 0.f, 0.f};
    bf16x8 At[4][2], B0[2][2], B1[2][2];
    const char* cA = (const char*)g.A + (size_t)cur.pm * tstepA; const char* cB = (const char*)g.Bt + (size_t)cur.pn * tstepB;
    S.a_ready(cur);
    if constexpr (SP2) {
        PG8_STAGE(PG8_SB(0, 0), cB, voffB); PG8_STAGE(PG8_SB(0, 1), cB + hstepB, voffB); PG8_STAGE(PG8_SA(0, 0), cA, voffA); PG8_STAGE(PG8_SA(0, 1), cA + hstepA, voffA);
        if (wr == 1) PG8_BAR;
        PG8_WAIT_V(2); PG8_BAR;
        PG8_STAGE(PG8_SB(1, 0), cB + kstep, voffB); PG8_STAGE(PG8_SA(1, 0), cA + kstep, voffA); PG8_STAGE(PG8_SB(1, 1), cB + hstepB + kstep, voffB);
        PG8_WAIT_V(6); PG8_BAR;
    } else {
        PG8_STAGE(PG8_SB(0, 0), cB, voffB); PG8_STAGE(PG8_SA(0, 0), cA, voffA); PG8_STAGE(PG8_SB(0, 1), cB + hstepB, voffB); PG8_STAGE(PG8_SA(0, 1), cA + hstepA, voffA);
        if (wr == 1) PG8_BAR;
        PG8_WAIT_V(4); PG8_BAR;
        PG8_STAGE(PG8_SB(1, 0), cB + kstep, voffB); PG8_STAGE(PG8_SA(1, 0), cA + kstep, voffA); PG8_STAGE(PG8_SB(1, 1), cB + hstepB + kstep, voffB);
        PG8_WAIT_V(6); PG8_BAR;
    }
    for (;;) {
        const bool has_next = S.next(ui + 1, nxt);
        const char* nA = has_next ? (const char*)g.A + (size_t)nxt.pm * tstepA : cA; const char* nB = has_next ? (const char*)g.Bt + (size_t)nxt.pn * tstepB : cB;
        for (int t = 0; t < nt; t += 2) {
            const bool last = (t == nt - 2);
            const char* a1 = cA + (size_t)(t + 1) * kstep;
            const char* a2 = last ? nA : cA + (size_t)(t + 2) * kstep; const char* b2 = last ? nB : cB + (size_t)(t + 2) * kstep;
            const char* a3 = a2 + kstep; const char* b3 = b2 + kstep;
            if (last && has_next) S.a_ready(nxt);
            if constexpr (SP2) {
            PG8_LDB(B0, 0, 0); PG8_LDB(B1, 0, 1); PG8_SCHED; PG8_LDA(At, 0, 0); PG8_STAGE(PG8_SA(1, 1), a1 + hstepA, voffA);
            PG8_WAIT_V(8); PG8_WAIT_L(0); PG8_BAR; PG8_MMA(0, 0, At, B0); PG8_MMA(0, 1, At, B1); PG8_BAR; PG8_SCHED;
            PG8_LDA(At, 0, 1); PG8_STAGE(PG8_SB(0, 0), b2, voffB); PG8_STAGE(PG8_SB(0, 1), b2 + hstepB, voffB); PG8_STAGE(PG8_SA(0, 0), a2, voffA);
            PG8_WAIT_V(8); PG8_WAIT_L(0); PG8_BAR; PG8_MMA(1, 0, At, B0); PG8_MMA(1, 1, At, B1); PG8_BAR; PG8_SCHED;
            PG8_LDB(B0, 1, 0); PG8_LDB(B1, 1, 1); PG8_SCHED; PG8_LDA(At, 1, 0); PG8_STAGE(PG8_SA(0, 1), a2 + hstepA, voffA);
            PG8_WAIT_V(8); PG8_WAIT_L(0); PG8_BAR; PG8_MMA(0, 0, At, B0); PG8_MMA(0, 1, At, B1); PG8_BAR; PG8_SCHED;
            PG8_LDA(At, 1, 1); PG8_STAGE(PG8_SB(1, 0), b3, voffB); PG8_STAGE(PG8_SB(1, 1), b3 + hstepB, voffB); PG8_STAGE(PG8_SA(1, 0), a3, voffA);
            PG8_WAIT_V(8); PG8_WAIT_L(0); PG8_BAR; PG8_MMA(1, 0, At, B0); PG8_MMA(1, 1, At, B1); PG8_BAR; PG8_SCHED;
            } else {
            PG8_LDB(B0, 0, 0); PG8_SCHED; PG8_LDA(At, 0, 0); PG8_STAGE(PG8_SA(1, 1), a1 + hstepA, voffA);
            PG8_WAIT_L(8); PG8_BAR; PG8_WAIT_L(0); PG8_MMA(0, 0, At, B0); PG8_BAR; PG8_SCHED;
            PG8_LDB(B1, 0, 1); PG8_STAGE(PG8_SB(0, 0), b2, voffB);
            PG8_BAR; PG8_WAIT_L(0); PG8_MMA(0, 1, At, B1); PG8_BAR;
            PG8_LDA(At, 0, 1); PG8_STAGE(PG8_SA(0, 0), a2, voffA);
            PG8_BAR; PG8_WAIT_L(0); PG8_MMA(1, 0, At, B0); PG8_BAR; PG8_SCHED;
            PG8_STAGE(PG8_SB(0, 1), b2 + hstepB, voffB);
            PG8_WAIT_V(6); PG8_BAR; PG8_MMA(1, 1, At, B1); PG8_BAR;
            PG8_LDB(B0, 1, 0); PG8_SCHED; PG8_LDA(At, 1, 0); PG8_STAGE(PG8_SA(0, 1), a2 + hstepA, voffA);
            PG8_WAIT_L(8); PG8_BAR; PG8_WAIT_L(0); PG8_MMA(0, 0, At, B0); PG8_BAR; PG8_SCHED;
            PG8_LDB(B1, 1, 1); PG8_STAGE(PG8_SB(1, 0), b3, voffB);
            PG8_BAR; PG8_WAIT_L(0); PG8_MMA(0, 1, At, B1); PG8_BAR;
            PG8_LDA(At, 1, 1); PG8_STAGE(PG8_SA(1, 0), a3, voffA);
            PG8_BAR; PG8_WAIT_L(0); PG8_MMA(1, 0, At, B0); PG8_BAR; PG8_SCHED;
            PG8_STAGE(PG8_SB(1, 1), b3 + hstepB, voffB);
            PG8_WAIT_V(6); PG8_BAR; PG8_MMA(1, 1, At, B1); PG8_BAR;
            }
            if constexpr (Epi::HAS_MID) { if (t + 2 == Epi::MID1 || t + 2 == Epi::MID2) E.mid(acc, cur, t + 2, wr, wc, fr, fq); }
        }
        if constexpr (ALIGN_EPI) { if (wr == 0) PG8_BAR; }
        if constexpr (!Epi::AFTER_DRAIN) { E(acc, cur, wr, wc, fr, fq); S.done(cur); }
        if (!has_next) break;
#pragma unroll
        for (int a = 0; a < 2; ++a)
#pragma unroll
            for (int b = 0; b < 2; ++b)
#pragma unroll
                for (int m = 0; m < 4; ++m)
#pragma unroll
                    for (int n = 0; n < 2; ++n) acc[a][b][m][n] = (f32x4){0.f, 0.f, 0.f, 0.f};
        cur = nxt; cA = nA; cB = nB; ++ui;
        if constexpr (ALIGN_EPI) { if (wr == 1) PG8_BAR; }
    }
    PG8_WAIT_V(0);
    if constexpr (!ALIGN_EPI) { if (wr == 0) PG8_BAR; }
    PG8_BAR;
    if constexpr (Epi::AFTER_DRAIN) { E.fused(acc, cur, wr, wc, fr, fq, lds, wid, lane); S.done(cur); }
#undef PG8_SA
#undef PG8_SB
#undef PG8_STAGE
#undef PG8_LDA
#undef PG8_LDB
#undef PG8_MMA
#undef PG8_WAIT_V
#undef PG8_WAIT_L
#undef PG8_BAR
#undef PG8_SCHED
}
}
using pg8::Unit; using pg8::f32x4; using pg8::u32x4; using pg8::bf16x8;
typedef unsigned short bf16;
#define LAS __attribute__((address_space(3)))
typedef float f32x16 __attribute__((ext_vector_type(16)));
typedef float f32x2 __attribute__((ext_vector_type(2)));
typedef unsigned u32x2 __attribute__((ext_vector_type(2)));

constexpr int D = 1024, NBATCH = 32, SEQ = 2048, CTXL = 256, DFF = 2816, DEPTH = 2;
constexpr int ML = NBATCH * SEQ, MC = NBATCH * CTXL, MT = ML + MC;
constexpr int MODW = 9 * D;
constexpr int INW = 5024, INWP = 5120;
constexpr int NCH = 2, BPH = NBATCH / NCH;
constexpr int HL = BPH * SEQ, HC = BPH * CTXL, HM = HL + HC;
constexpr float EPS = 1e-6f, LOG2E = 1.4426950408889634f;

constexpr size_t MiB = 1u << 20;
constexpr size_t WS_SC = 1 * MiB;
constexpr size_t WS_MOD = 2 * MiB;
constexpr size_t WS_CTXRES = 8 * MiB;
constexpr size_t WS_W = 40 * MiB;
constexpr size_t LW_U1 = 0, LW_D1 = LW_U1 + (size_t)2 * DFF * D * 2, LW_U2 = LW_D1 + (size_t)D * DFF * 2, LW_D2 = LW_U2 + (size_t)2 * DFF * D * 2,
                 LW_IN = LW_D2 + (size_t)D * DFF * 2, LW_UQ = LW_IN + (size_t)INWP * D * 2, LW_UKV = LW_UQ + (size_t)512 * 256 * 2, LW_BR = LW_UKV + (size_t)512 * 128 * 2,
                 LW_OUT = LW_BR + (size_t)D * D * 2, LW_SIZE = LW_OUT + (size_t)D * D * 2;
static_assert(WS_W + 2 * LW_SIZE <= 136 * MiB, "weights");
constexpr size_t WS_NB = 136 * MiB;
constexpr size_t WS_Y = 280 * MiB;
constexpr size_t WS_BIG = 424 * MiB;
constexpr size_t WS_H = WS_BIG;
constexpr size_t WS_WADA = WS_BIG;
constexpr size_t WS_BA = WS_BIG;
constexpr size_t WS_BB = WS_BA + (size_t)HM * 768 * 2;
constexpr size_t WS_BC = WS_BB + (size_t)HM * 768 * 2;
constexpr size_t WS_MQ = WS_BC + (size_t)HM * 512 * 2;
constexpr size_t WS_MKV = WS_MQ + (size_t)HM * 512 * 2;
constexpr size_t WS_G = WS_MKV + (size_t)HM * 512 * 2;
constexpr size_t WS_END = WS_G + (size_t)HM * 3072 * 2;
static_assert(WS_END <= 1024 * MiB && WS_H + (size_t)MT * DFF * 2 <= 1024 * MiB, "ws map");

struct Params {
    const float* x; const float* c; const float* ctx; const float* c_ctx; const float* w_ada; const float* b_ada;
    const float* f1_norm; const float* f1_wg; const float* f1_wu; const float* f1_wd;
    const float* mix_norm; const float* w_in; const float* na_bias; const float* q_norm; const float* k_norm; const float* mq_norm; const float* mkv_norm;
    const float* w_uq; const float* w_ukv; const float* w_ba; const float* w_bb; const float* w_bc; const float* w_out;
    const float* f2_norm; const float* f2_wg; const float* f2_wu; const float* f2_wd; const float* final_norm;
    float* out; unsigned char* ws;
};

__device__ __forceinline__ float bf2f(unsigned v) { return __uint_as_float(v << 16); }
typedef __bf16 bf16x2_t __attribute__((ext_vector_type(2)));
__device__ __forceinline__ unsigned pk2(float lo, float hi) { const f32x2 v = {lo, hi}; const bf16x2_t b = __builtin_convertvector(v, bf16x2_t); return __builtin_bit_cast(unsigned, b); }
__device__ __forceinline__ float fsilu(float x) { return x * __builtin_amdgcn_rcpf(1.f + __builtin_amdgcn_exp2f(-x * LOG2E)); }
__device__ __forceinline__ float fsigm(float x) { return __builtin_amdgcn_rcpf(1.f + __builtin_amdgcn_exp2f(-x * LOG2E)); }
template <int M> __device__ __forceinline__ float swz_xor(float v) { return __int_as_float(__builtin_amdgcn_ds_swizzle(__float_as_int(v), (M << 10) | 0x1f)); }
__device__ __forceinline__ float half_sum(float v) { auto rr = __builtin_amdgcn_permlane32_swap(__float_as_uint(v), __float_as_uint(v), false, false); return __uint_as_float(rr[0]) + __uint_as_float(rr[1]); }
__device__ __forceinline__ float half_max(float v) { auto rr = __builtin_amdgcn_permlane32_swap(__float_as_uint(v), __float_as_uint(v), false, false); return __builtin_fmaxf(__uint_as_float(rr[0]), __uint_as_float(rr[1])); }
__device__ __forceinline__ float sum32(float v) { v += swz_xor<1>(v); v += swz_xor<2>(v); v += swz_xor<4>(v); v += swz_xor<8>(v); v += swz_xor<16>(v); return v; }
__device__ __forceinline__ float wave_sum(float v) { return half_sum(sum32(v)); }
#define UNPK8(W_, f) do { const u32x4 w__ = (W_); f[0] = bf2f(w__[0] & 0xffffu); f[1] = __uint_as_float(w__[0] & 0xffff0000u); f[2] = bf2f(w__[1] & 0xffffu); f[3] = __uint_as_float(w__[1] & 0xffff0000u); \
                         f[4] = bf2f(w__[2] & 0xffffu); f[5] = __uint_as_float(w__[2] & 0xffff0000u); f[6] = bf2f(w__[3] & 0xffffu); f[7] = __uint_as_float(w__[3] & 0xffff0000u); } while (0)

struct MapOrder {
    pg8::StaticOrder s; int nl, lat0, ctx0; unsigned long long cmap;
    __device__ __forceinline__ void init(int nl_, int nc_, int lat0_, int ctx0_, int N, int G, int c) { nl = nl_; lat0 = lat0_; ctx0 = ctx0_; cmap = 0ull; s.init((nl_ + nc_) * 256, N, G, c); }
    __device__ __forceinline__ bool next(int i, Unit& u) const { if (!s.next(i, u)) return false; u.pm = u.pm < nl ? lat0 + u.pm : ctx0 + (u.pm - nl);
        if (cmap) u.pn = (int)((cmap >> (4 * u.pn)) & 15ull); return true; }
    __device__ __forceinline__ void a_ready(const Unit&) const {}
    __device__ __forceinline__ void done(const Unit&) const {}
};

#ifndef RESID_ALIGN
#define RESID_ALIGN false
#endif
#define EPI_COMMON static constexpr bool PERM = true, AFTER_DRAIN = false
#define EPI_NOMID static constexpr bool HAS_MID = false; static constexpr int MID1 = -1, MID2 = -1; \
    __device__ __forceinline__ void mid(f32x4 (&)[2][2][4][2], const Unit&, int, int, int, int, int) const {}
typedef f32x4 Acc[2][2][4][2];

struct EpiSwiGLU { EPI_COMMON; static constexpr bool ALIGN = true; EPI_NOMID; bf16* H;
    __device__ __forceinline__ void operator()(const Acc& acc, const Unit& u, int wr, int wc, int fr, int fq) const {
        const int row0 = u.pm * 256 + wr * 64 + fr, col0 = u.pn * 128 + wc * 32 + 8 * fq;
#pragma unroll
        for (int ai = 0; ai < 2; ++ai)
#pragma unroll
            for (int m = 0; m < 4; ++m) {
                const f32x4 g0 = acc[ai][0][m][0], g1 = acc[ai][0][m][1], u0 = acc[ai][1][m][0], u1 = acc[ai][1][m][1];
                u32x4 w; w.x = pk2(fsilu(g0[0]) * u0[0], fsilu(g0[1]) * u0[1]); w.y = pk2(fsilu(g0[2]) * u0[2], fsilu(g0[3]) * u0[3]);
                w.z = pk2(fsilu(g1[0]) * u1[0], fsilu(g1[1]) * u1[1]); w.w = pk2(fsilu(g1[2]) * u1[2], fsilu(g1[3]) * u1[3]);
                *(u32x4*)(H + (size_t)(row0 + ai * 128 + m * 16) * DFF + col0) = w; }
    }
};
struct EpiResid { EPI_COMMON; static constexpr bool ALIGN = RESID_ALIGN; EPI_NOMID; const float* src_lat; const float* src_ctx; float* dst_lat; float* dst_ctx; const float* modl; int gidx; float coef;
    __device__ __forceinline__ void operator()(const Acc& acc, const Unit& u, int wr, int wc, int fr, int fq) const {
        const bool isl = u.pm < 256;
        const float* src = isl ? src_lat + (size_t)u.pm * 256 * D : src_ctx + (size_t)(u.pm - 256) * 256 * D;
        float* dst = isl ? dst_lat + (size_t)u.pm * 256 * D : dst_ctx + (size_t)(u.pm - 256) * 256 * D;
        const float* gate = modl + (size_t)(isl ? (u.pm >> 3) : 32) * MODW + gidx * D;
        const int col0 = u.pn * 256 + wc * 32 + 8 * fq;
#pragma unroll
        for (int bj = 0; bj < 2; ++bj) {
            const f32x4 g0 = *(const f32x4*)(gate + col0 + bj * 128) * coef, g1 = *(const f32x4*)(gate + col0 + bj * 128 + 4) * coef;
            f32x4 x0[8], x1[8];
#pragma unroll
            for (int g = 0; g < 8; ++g) { const size_t off = (size_t)((g >> 2) * 128 + wr * 64 + (g & 3) * 16 + fr) * D + col0 + bj * 128;
                x0[g] = *(const f32x4*)(src + off); x1[g] = *(const f32x4*)(src + off + 4); }
            __builtin_amdgcn_sched_barrier(0);
#pragma unroll
            for (int g = 0; g < 8; ++g) { const size_t off = (size_t)((g >> 2) * 128 + wr * 64 + (g & 3) * 16 + fr) * D + col0 + bj * 128;
                *(f32x4*)(dst + off) = x0[g] + g0 * acc[g >> 2][bj][g & 3][0]; *(f32x4*)(dst + off + 4) = x1[g] + g1 * acc[g >> 2][bj][g & 3][1]; }
            __builtin_amdgcn_sched_barrier(0);
        }
    }
};
__device__ __forceinline__ int ltile(int pm, int hb) { return pm < 256 ? pm - (HL / 256) * hb : (HL / 256) + (pm - 256 - (HC / 256) * hb); }
struct EpiWin { EPI_COMMON; static constexpr bool ALIGN = true; EPI_NOMID; bf16* bA; bf16* bB; bf16* bC; bf16* G; int hb;
    __device__ __forceinline__ void operator()(const Acc& acc, const Unit& u, int wr, int wc, int fr, int fq) const {
        const int lrow0 = ltile(u.pm, hb) * 256 + wr * 64 + fr;
        bf16* base; int ld, ct; bool sg = false;
        if (u.pn < 3) { base = bA; ld = 768; ct = u.pn; } else if (u.pn < 6) { base = bB; ld = 768; ct = u.pn - 3; } else if (u.pn < 8) { base = bC; ld = 512; ct = u.pn - 6; } else { base = G; ld = 3072; ct = u.pn - 8; sg = true; }
        const int col0 = ct * 256 + wc * 32 + 8 * fq;
        const float qs = u.pn == 0 ? 0.125f * LOG2E : 1.0f;
#pragma unroll
        for (int ai = 0; ai < 2; ++ai)
#pragma unroll
            for (int m = 0; m < 4; ++m) { bf16* rp = base + (size_t)(lrow0 + ai * 128 + m * 16) * ld + col0;
#pragma unroll
                for (int bj = 0; bj < 2; ++bj) { f32x4 v0 = acc[ai][bj][m][0] * qs, v1 = acc[ai][bj][m][1] * qs;
                    if (sg) { v0 = (f32x4){fsigm(v0[0]), fsigm(v0[1]), fsigm(v0[2]), fsigm(v0[3])}; v1 = (f32x4){fsigm(v1[0]), fsigm(v1[1]), fsigm(v1[2]), fsigm(v1[3])}; }
                    u32x4 w; w.x = pk2(v0[0], v0[1]); w.y = pk2(v0[2], v0[3]); w.z = pk2(v1[0], v1[1]); w.w = pk2(v1[2], v1[3]);
                    *(u32x4*)(rp + bj * 128) = w; } }
    }
};
struct EpiPlain { EPI_COMMON; static constexpr bool ALIGN = true; EPI_NOMID; bf16* O; int ldc; float scale;
    __device__ __forceinline__ void operator()(const Acc& acc, const Unit& u, int wr, int wc, int fr, int fq) const {
        const int row0 = u.pm * 256 + wr * 64 + fr, col0 = u.pn * 256 + wc * 32 + 8 * fq;
#pragma unroll
        for (int ai = 0; ai < 2; ++ai)
#pragma unroll
            for (int m = 0; m < 4; ++m) { bf16* rp = O + (size_t)(row0 + ai * 128 + m * 16) * ldc + col0;
#pragma unroll
                for (int bj = 0; bj < 2; ++bj) { const f32x4 v0 = acc[ai][bj][m][0] * scale, v1 = acc[ai][bj][m][1] * scale;
                    u32x4 w; w.x = pk2(v0[0], v0[1]); w.y = pk2(v0[2], v0[3]); w.z = pk2(v1[0], v1[1]); w.w = pk2(v1[2], v1[3]);
                    *(u32x4*)(rp + bj * 128) = w; } }
    }
};
struct EpiAda { EPI_COMMON; static constexpr bool ALIGN = true; EPI_NOMID; float* MOD; const float* b_ada;
    __device__ __forceinline__ void operator()(const Acc& acc, const Unit& u, int wr, int wc, int fr, int fq) const {
        if (wr != 0) return;
        const int col0 = u.pn * 256 + wc * 32 + 8 * fq;
        const int layer = u.pn / 36, j0 = col0 - layer * MODW;
#pragma unroll
        for (int m = 0; m < 3; ++m) { const int row = m * 16 + fr; if (row < 33) {
#pragma unroll
            for (int bj = 0; bj < 2; ++bj) { const f32x4 b0 = *(const f32x4*)(b_ada + col0 + bj * 128), b1 = *(const f32x4*)(b_ada + col0 + bj * 128 + 4);
                float* o = MOD + ((size_t)layer * 33 + row) * MODW + j0 + bj * 128;
                *(f32x4*)o = acc[0][bj][m][0] + b0; *(f32x4*)(o + 4) = acc[0][bj][m][1] + b1; } } }
    }
};
struct EpiBranch { EPI_COMMON; static constexpr bool ALIGN = true; static constexpr bool HAS_MID = true; static constexpr int MID1 = 4, MID2 = 12;
    const bf16* G; bf16* Y; int hb;
    __device__ __forceinline__ void mid(Acc& acc, const Unit& u, int tt, int wr, int wc, int fr, int fq) const {
        asm volatile("" : "+v"(fr), "+v"(fq));
        const int lrow0 = ltile(u.pm, hb) * 256 + wr * 64 + fr, col0 = u.pn * 256 + wc * 32 + 8 * fq;
        const int num = tt == 4 ? 0 : D, den = tt == 4 ? D : 2 * D;
#pragma unroll
        for (int ai = 0; ai < 2; ++ai) {
            u32x4 wn[4][2], wd[4][2];
#pragma unroll
            for (int m = 0; m < 4; ++m) { const bf16* gp = G + (size_t)(lrow0 + ai * 128 + m * 16) * 3072 + col0;
#pragma unroll
                for (int bj = 0; bj < 2; ++bj) { wn[m][bj] = *(const u32x4*)(gp + num + bj * 128); wd[m][bj] = *(const u32x4*)(gp + den + bj * 128); } }
            __builtin_amdgcn_sched_barrier(0);
#pragma unroll
            for (int m = 0; m < 4; ++m)
#pragma unroll
                for (int bj = 0; bj < 2; ++bj) { float fn[8], fd[8]; UNPK8(wn[m][bj], fn); UNPK8(wd[m][bj], fd);
#pragma unroll
                    for (int e = 0; e < 8; ++e) { const float r = __builtin_fmaxf(fn[e], 1e-12f) * __builtin_amdgcn_rcpf(__builtin_fmaxf(fd[e], 1e-12f)); acc[ai][bj][m][e >> 2][e & 3] *= r; } }
            asm volatile("" ::: "memory"); }
    }
    __device__ __forceinline__ void operator()(const Acc& acc, const Unit& u, int wr, int wc, int fr, int fq) const {
        const int lrow0 = ltile(u.pm, hb) * 256 + wr * 64 + fr, row0 = u.pm * 256 + wr * 64 + fr, col0 = u.pn * 256 + wc * 32 + 8 * fq;
#pragma unroll
        for (int ai = 0; ai < 2; ++ai) {
            u32x4 wg[4][2];
#pragma unroll
            for (int m = 0; m < 4; ++m)
#pragma unroll
                for (int bj = 0; bj < 2; ++bj) wg[m][bj] = *(const u32x4*)(G + (size_t)(lrow0 + ai * 128 + m * 16) * 3072 + 2 * D + col0 + bj * 128);
            __builtin_amdgcn_sched_barrier(0);
#pragma unroll
            for (int m = 0; m < 4; ++m) { bf16* yp = Y + (size_t)(row0 + ai * 128 + m * 16) * D + col0;
#pragma unroll
                for (int bj = 0; bj < 2; ++bj) { float fg[8]; UNPK8(wg[m][bj], fg);
                    const f32x4 v0 = acc[ai][bj][m][0], v1 = acc[ai][bj][m][1];
                    u32x4 w; w.x = pk2(v0[0] * __builtin_fmaxf(fg[0], 1e-12f), v0[1] * __builtin_fmaxf(fg[1], 1e-12f)); w.y = pk2(v0[2] * __builtin_fmaxf(fg[2], 1e-12f), v0[3] * __builtin_fmaxf(fg[3], 1e-12f));
                    w.z = pk2(v1[0] * __builtin_fmaxf(fg[4], 1e-12f), v1[1] * __builtin_fmaxf(fg[5], 1e-12f)); w.w = pk2(v1[2] * __builtin_fmaxf(fg[6], 1e-12f), v1[3] * __builtin_fmaxf(fg[7], 1e-12f));
                    *(u32x4*)(yp + bj * 128) = w; } } }
    }
};
__device__ __forceinline__ int rope_logical(int p) { return 16 * ((p >> 3) & 1) + 8 * (p >> 4) + (p & 7); }
template <int KIND> __device__ __forceinline__ void tr_item(const float* W0, const float* W1, int ldw, bf16* WT, int ldd, int koff, int item, int nblk, LAS float* scr, int lane) {
    const int kb = item / nblk, nb = item % nblk, k0 = 64 * kb, n0 = 32 * nb;
    const int np = n0 + (lane & 31);
    const float* src = W0; int col = np;
    if (KIND == 1) { const int pn = np >> 8, j = np & 255; src = j < 128 ? W0 : W1; col = 128 * pn + (j & 127); }
    if (KIND == 2) { if (np < 1920) col = np; else if (np < 1952) col = 1920 + rope_logical(np - 1920); else if (np < 2048) col = -1; else col = np - 96; }
    if (KIND == 3) { if (np < 384) { const int h = np / 96, j = np % 96; col = j < 64 ? np : 96 * h + 64 + rope_logical(j - 64); } else col = -1; }
#pragma unroll
    for (int i = 0; i < 32; ++i) { const int kk = 2 * i + (lane >> 5); scr[kk * 33 + (lane & 31)] = col >= 0 ? src[(size_t)(k0 + kk) * ldw + col] : 0.f; }
    asm volatile("s_waitcnt lgkmcnt(0)" ::: "memory");
    const int c = lane & 7;
#pragma unroll
    for (int j = 0; j < 4; ++j) { const int n = (lane >> 3) + 8 * j; const LAS float* s = scr + (8 * c) * 33 + n;
        u32x4 o; o.x = pk2(s[0 * 33], s[1 * 33]); o.y = pk2(s[2 * 33], s[3 * 33]); o.z = pk2(s[4 * 33], s[5 * 33]); o.w = pk2(s[6 * 33], s[7 * 33]);
        *(u32x4*)(WT + (size_t)(n0 + n) * ldd + koff + k0 + 8 * c) = o; }
    asm volatile("s_waitcnt lgkmcnt(0)" ::: "memory");
}
constexpr int PREP_PER_LAYER = 2 * (16 * 176) + 2 * (44 * 32) + 16 * 160 + 4 * 16 + 2 * 16 + 4 * 32 + 8 * 32 + 4 * 32 + 16 * 32, PREP_ADA = 2 * 16 * 288, PREP_TOTAL = PREP_ADA + 2 * PREP_PER_LAYER;
__device__ __forceinline__ void prep_phase(const Params& p, LAS unsigned char* lds, int tid, int bid, int nbk, int item_lo, int item_hi, int wg0, bool misc) {
    asm volatile("" : "+v"(tid)); const int lane = tid & 63, wave = __builtin_amdgcn_readfirstlane(tid >> 6);
    LAS float* scr = (LAS float*)(lds + wave * 16384);
    const int gw = (bid - wg0) * 8 + wave, NGW = (nbk - wg0) * 8;
    unsigned char* ws = p.ws;
#define TRY_JOB(KIND, W0, W1, K, LDW, DST, LDD, KOFF, NROWS) { const int cnt = ((K) / 64) * ((NROWS) / 32); if (r < cnt) { tr_item<KIND>(W0, W1, LDW, (bf16*)(DST), LDD, KOFF, r, (NROWS) / 32, scr, lane); continue; } r -= cnt; }
    constexpr int PER_LAYER = 2 * (16 * 176) + 2 * (44 * 32) + 16 * 160 + 4 * 16 + 2 * 16 + 4 * 32 + 8 * 32 + 4 * 32 + 16 * 32;
    constexpr int ADA_ITEMS = 16 * 288;
    constexpr int TOTAL = 2 * PER_LAYER + 2 * ADA_ITEMS;
    static_assert(TOTAL == PREP_TOTAL, "prep item count");
    if (bid >= wg0) for (int it = item_lo + gw; it < item_hi; it += NGW) {
        int r = it;
        if (r < 2 * ADA_ITEMS) { const int L = r / ADA_ITEMS; r -= L * ADA_ITEMS;
            tr_item<0>(p.w_ada + (size_t)L * D * MODW, nullptr, MODW, (bf16*)(ws + WS_WADA) + (size_t)L * MODW * D, D, 0, r, MODW / 32, scr, lane); continue; }
        r -= 2 * ADA_ITEMS;
        const int L = r / PER_LAYER; r -= L * PER_LAYER;
        unsigned char* wl = ws + WS_W + (size_t)L * LW_SIZE;
        TRY_JOB(1, p.f1_wg + (size_t)L * D * DFF, p.f1_wu + (size_t)L * D * DFF, D, DFF, wl + LW_U1, D, 0, 2 * DFF)
        TRY_JOB(0, p.f1_wd + (size_t)L * DFF * D, nullptr, DFF, D, wl + LW_D1, DFF, 0, D)
        TRY_JOB(1, p.f2_wg + (size_t)L * D * DFF, p.f2_wu + (size_t)L * D * DFF, D, DFF, wl + LW_U2, D, 0, 2 * DFF)
        TRY_JOB(0, p.f2_wd + (size_t)L * DFF * D, nullptr, DFF, D, wl + LW_D2, DFF, 0, D)
        TRY_JOB(2, p.w_in + (size_t)L * D * INW, nullptr, D, INW, wl + LW_IN, D, 0, INWP)
        TRY_JOB(3, p.w_uq + (size_t)L * 256 * 384, nullptr, 256, 384, wl + LW_UQ, 256, 0, 512)
        TRY_JOB(0, p.w_ukv + (size_t)L * 128 * 512, nullptr, 128, 512, wl + LW_UKV, 128, 0, 512)
        TRY_JOB(0, p.w_ba + (size_t)L * 256 * D, nullptr, 256, D, wl + LW_BR, D, 0, D)
        TRY_JOB(0, p.w_bb + (size_t)L * 512 * D, nullptr, 512, D, wl + LW_BR, D, 256, D)
        TRY_JOB(0, p.w_bc + (size_t)L * 256 * D, nullptr, 256, D, wl + LW_BR, D, 768, D)
        TRY_JOB(0, p.w_out + (size_t)L * D * D, nullptr, D, D, wl + LW_OUT, D, 0, D)
    }
#undef TRY_JOB
    bf16* SC = (bf16*)(ws + WS_SC);
    if (misc) for (int i = bid * 512 + tid; i < 256 * D; i += nbk * 512) { const int row = i >> 10, col = i & 1023;
        float v = 0.f; if (row < 32) v = fsilu(p.c[row * D + col]); else if (row == 32) v = fsilu(p.c_ctx[col]);
        SC[i] = (bf16)(pk2(v, 0.f) & 0xffffu); }
}

__device__ __forceinline__ void normmod_phase(const float* xlat, const float* xctx, const float* gain, const float* modl, int sidx, bf16* NBp, int nrows, int tid, int bid, int nbk) {
    asm volatile("" : "+v"(tid)); const int lane = tid & 63, wave = __builtin_amdgcn_readfirstlane(tid >> 6);
    const int gw = bid * 8 + wave, NGW = nbk * 8;
    f32x4 gv[4];
#pragma unroll
    for (int j = 0; j < 4; ++j) gv[j] = *(const f32x4*)(gain + 4 * lane + 256 * j);
    constexpr int R = 4;
    for (int row0 = gw; row0 < nrows; row0 += R * NGW) {
        f32x4 v[R][4];
#pragma unroll
        for (int q = 0; q < R; ++q) { const int row = row0 + q * NGW; if (row < nrows) {
            const float* xr = row < ML ? xlat + (size_t)row * D : xctx + (size_t)(row - ML) * D;
#pragma unroll
            for (int j = 0; j < 4; ++j) v[q][j] = *(const f32x4*)(xr + 4 * lane + 256 * j); } }
#pragma unroll
        for (int q = 0; q < R; ++q) { const int row = row0 + q * NGW; if (row < nrows) {
            const float* mr = modl + (size_t)(row < ML ? (row >> 11) : 32) * MODW + sidx * D;
            f32x4 sh[4], sc[4];
#pragma unroll
            for (int j = 0; j < 4; ++j) { sh[j] = *(const f32x4*)(mr + 4 * lane + 256 * j); sc[j] = *(const f32x4*)(mr + D + 4 * lane + 256 * j); }
            float ss = 0.f;
#pragma unroll
            for (int j = 0; j < 4; ++j) ss += (v[q][j].x * v[q][j].x + v[q][j].y * v[q][j].y) + (v[q][j].z * v[q][j].z + v[q][j].w * v[q][j].w);
            const float rstd = 1.0f / sqrtf(wave_sum(ss) * (1.f / D) + EPS);
            u32x2* o = (u32x2*)(NBp + (size_t)row * D) + lane;
#pragma unroll
            for (int j = 0; j < 4; ++j) { const f32x4 n = (v[q][j] * rstd) * gv[j] * (sc[j] + 1.0f) + sh[j];
                u32x2 w; w.x = pk2(n.x, n.y); w.y = pk2(n.z, n.w); o[64 * j] = w; } } }
    }
}
__device__ __forceinline__ void final_phase(float* out, const float* gain, int tid, int bid, int nbk) {
    asm volatile("" : "+v"(tid)); const int lane = tid & 63, wave = __builtin_amdgcn_readfirstlane(tid >> 6);
    const int gw = bid * 8 + wave, NGW = nbk * 8;
    f32x4 gv[4];
#pragma unroll
    for (int j = 0; j < 4; ++j) gv[j] = *(const f32x4*)(gain + 4 * lane + 256 * j);
    constexpr int R = 4;
    for (int row0 = gw; row0 < ML; row0 += R * NGW) {
        f32x4 v[R][4];
#pragma unroll
        for (int q = 0; q < R; ++q) { const int row = row0 + q * NGW; if (row < ML) {
#pragma unroll
            for (int j = 0; j < 4; ++j) v[q][j] = *(const f32x4*)(out + (size_t)row * D + 4 * lane + 256 * j); } }
#pragma unroll
        for (int q = 0; q < R; ++q) { const int row = row0 + q * NGW; if (row < ML) {
            float ss = 0.f;
#pragma unroll
            for (int j = 0; j < 4; ++j) ss += (v[q][j].x * v[q][j].x + v[q][j].y * v[q][j].y) + (v[q][j].z * v[q][j].z + v[q][j].w * v[q][j].w);
            const float rstd = 1.0f / sqrtf(wave_sum(ss) * (1.f / D) + EPS);
#pragma unroll
            for (int j = 0; j < 4; ++j) *(f32x4*)(out + (size_t)row * D + 4 * lane + 256 * j) = (v[q][j] * rstd) * gv[j]; } }
    }
}

__device__ __forceinline__ void post_phase(bf16* bB, bf16* bC, const float* k_norm, const float* mq_norm, const float* mkv_norm, int tid, int bid, int nbk) {
    asm volatile("" : "+v"(tid)); const int lane = tid & 63, wave = __builtin_amdgcn_readfirstlane(tid >> 6);
    const int gw = bid * 8 + wave, NGW = nbk * 8;
    for (int row = gw; row < HM; row += NGW) {
        const bool lat = row < HL; const int t = row & (SEQ - 1); const float prow = (float)(t >> 6), pcol = (float)(t & 63);
        { bf16* kp = bB + (size_t)row * 768 + 512; const int hd = lane >> 5, a = (lane >> 4) & 1, f = lane & 15; const int d0 = 32 * a + f;
          float x0 = bf2f(kp[hd * 64 + d0]), x1 = bf2f(kp[hd * 64 + d0 + 16]);
          float ss = x0 * x0 + x1 * x1;
          ss = sum32(ss);
          const float rstd = 1.0f / sqrtf(ss * (1.f / 64.f) + EPS);
          x0 = x0 * rstd * k_norm[d0]; x1 = x1 * rstd * k_norm[d0 + 16];
          if (lat) { const float ang = (a ? pcol : prow) * __builtin_amdgcn_exp2f(-(float)f * (13.287712379549449f / 16.f)); const float cs = __cosf(ang), sn = __sinf(ang);
              const float y0 = x0 * cs - x1 * sn, y1 = x1 * cs + x0 * sn; x0 = y0; x1 = y1; }
          kp[hd * 64 + d0] = (bf16)(pk2(x0, 0.f) & 0xffffu); kp[hd * 64 + d0 + 16] = (bf16)(pk2(x1, 0.f) & 0xffffu); }
        { bf16* cp = bC + (size_t)row * 512; const u32x2 w = *(const u32x2*)(cp + 4 * lane);
          float x[4] = {bf2f(w.x & 0xffffu), __uint_as_float(w.x & 0xffff0000u), bf2f(w.y & 0xffffu), __uint_as_float(w.y & 0xffff0000u)};
          const float rstd = 1.0f / sqrtf(wave_sum((x[0] * x[0] + x[1] * x[1]) + (x[2] * x[2] + x[3] * x[3])) * (1.f / 256.f) + EPS);
          const f32x4 g = *(const f32x4*)(mq_norm + 4 * lane);
          u32x2 o; o.x = pk2(x[0] * rstd * g.x, x[1] * rstd * g.y); o.y = pk2(x[2] * rstd * g.z, x[3] * rstd * g.w); *(u32x2*)(cp + 4 * lane) = o; }
        { bf16* cp = bC + (size_t)row * 512 + 256; const unsigned w = *(const unsigned*)(cp + 2 * lane);
          const float x0 = bf2f(w & 0xffffu), x1 = __uint_as_float(w & 0xffff0000u);
          const float rstd = 1.0f / sqrtf(wave_sum(x0 * x0 + x1 * x1) * (1.f / 128.f) + EPS);
          *(unsigned*)(cp + 2 * lane) = pk2(x0 * rstd * mkv_norm[2 * lane], x1 * rstd * mkv_norm[2 * lane + 1]); }
        if (lat && lane < 16) { bf16* rp = bC + (size_t)row * 512 + 384; const int a = lane >> 3, f = lane & 7;
          const float x0 = bf2f(rp[8 * a + f]), x1 = bf2f(rp[16 + 8 * a + f]);
          const float ang = (a ? pcol : prow) * __builtin_amdgcn_exp2f(-(float)f * (13.287712379549449f / 8.f)); const float cs = __cosf(ang), sn = __sinf(ang);
          rp[8 * a + f] = (bf16)(pk2(x0 * cs - x1 * sn, 0.f) & 0xffffu); rp[16 + 8 * a + f] = (bf16)(pk2(x1 * cs + x0 * sn, 0.f) & 0xffffu); }
    }
}
constexpr int KTP = 208, KTB = 64 * KTP, VTP = 144, VTB = 64 * VTP;
constexpr int A_KT = 0, A_VT = 2 * KTB, A_BIAS = A_VT + 3 * VTB, A_END = A_BIAS + 480 * 4;
struct AttnArgs { const bf16* bA; const bf16* bB; const bf16* bC; const bf16* MQ; const bf16* MKV; bf16* OB; const float* q_norm; const float* na_bias; int hb; int with_ctx_q; };
__device__ __forceinline__ int crow(int r, int hi) { return (r & 3) + 8 * (r >> 2) + 4 * hi; }
__device__ __forceinline__ int na_r0(int r) { const int v = r - 4; return v < 0 ? 0 : (v > 24 ? 24 : v); }


template <int QD> __device__ __forceinline__ void attn_tile(const bf16x8 (&qf)[QD], bool& fresh, f32x16& negm, float& m2, float& lsum, f32x16& o0, f32x16& o1, const LAS unsigned char* kb, const LAS unsigned char* vb,
                                                           bool local, const LAS float* bt, int c0, int hi) {
    bf16x8 k0[QD], k1[QD];
#pragma unroll
    for (int d0 = 0; d0 < QD; ++d0) { k0[d0] = *(const LAS bf16x8*)(kb + d0 * 32); k1[d0] = *(const LAS bf16x8*)(kb + 32 * KTP + d0 * 32); }
    bf16x8 vfa[4], vfc[4];
#pragma unroll
    for (int j4 = 0; j4 < 4; ++j4) { vfa[j4] = *(const LAS bf16x8*)(vb + j4 * 32); vfc[j4] = *(const LAS bf16x8*)(vb + 32 * VTP + j4 * 32); }
    __builtin_amdgcn_sched_barrier(0);
    f32x16 s0, s1;
    s0 = __builtin_amdgcn_mfma_f32_32x32x16_bf16(k0[0], qf[0], negm, 0, 0, 0); s1 = __builtin_amdgcn_mfma_f32_32x32x16_bf16(k1[0], qf[0], negm, 0, 0, 0);
#pragma unroll
    for (int d0 = 1; d0 < QD; ++d0) { s0 = __builtin_amdgcn_mfma_f32_32x32x16_bf16(k0[d0], qf[d0], s0, 0, 0, 0); s1 = __builtin_amdgcn_mfma_f32_32x32x16_bf16(k1[d0], qf[d0], s1, 0, 0, 0); }
    if (local) {
        int base = 4 * hi - c0; asm volatile("" : "+v"(base));
        const LAS float* btl = bt + 4 * hi;
#pragma unroll
        for (int r = 0; r < 16; ++r) { const int cr = (r & 3) + 8 * (r >> 2);
            s0[r] = ((unsigned)(cr + base) < 16u) ? s0[r] + btl[cr] : -1e30f;
            s1[r] = ((unsigned)(cr + 32 + base) < 16u) ? s1[r] + btl[cr + 32] : -1e30f; }
    }
    float tmax;
    { float a = __builtin_fmaxf(s0[0], s1[0]), b = __builtin_fmaxf(s0[1], s1[1]);
#pragma unroll
      for (int r = 2; r < 16; r += 2) { a = __builtin_fmaxf(__builtin_fmaxf(a, s0[r]), s1[r]); b = __builtin_fmaxf(__builtin_fmaxf(b, s0[r + 1]), s1[r + 1]); }
      tmax = half_max(__builtin_fmaxf(a, b)); }
    if (fresh || __any(tmax > 8.0f)) {
        const float dl = fresh ? tmax : __builtin_fmaxf(tmax, 0.f); m2 += dl; fresh = false;
#pragma unroll
        for (int r = 0; r < 16; ++r) { s0[r] -= dl; s1[r] -= dl; negm[r] = -m2; }
        const float al = __builtin_amdgcn_exp2f(-dl); lsum *= al;
#pragma unroll
        for (int r = 0; r < 16; ++r) { o0[r] *= al; o1[r] *= al; } }
    float ps0 = 0.f, ps1 = 0.f;
#pragma unroll
    for (int r = 0; r < 16; ++r) { s0[r] = __builtin_amdgcn_exp2f(s0[r]); s1[r] = __builtin_amdgcn_exp2f(s1[r]); ps0 += s0[r]; ps1 += s1[r]; }
    lsum += ps0 + ps1;
    bf16x8 pb[4];
    { u32x4 w;
      w.x = pk2(s0[0], s0[1]); w.y = pk2(s0[2], s0[3]); w.z = pk2(s0[4], s0[5]); w.w = pk2(s0[6], s0[7]); pb[0] = __builtin_bit_cast(bf16x8, w);
      w.x = pk2(s0[8], s0[9]); w.y = pk2(s0[10], s0[11]); w.z = pk2(s0[12], s0[13]); w.w = pk2(s0[14], s0[15]); pb[1] = __builtin_bit_cast(bf16x8, w);
      w.x = pk2(s1[0], s1[1]); w.y = pk2(s1[2], s1[3]); w.z = pk2(s1[4], s1[5]); w.w = pk2(s1[6], s1[7]); pb[2] = __builtin_bit_cast(bf16x8, w);
      w.x = pk2(s1[8], s1[9]); w.y = pk2(s1[10], s1[11]); w.z = pk2(s1[12], s1[13]); w.w = pk2(s1[14], s1[15]); pb[3] = __builtin_bit_cast(bf16x8, w); }
#pragma unroll
    for (int j4 = 0; j4 < 4; ++j4) {
        o0 = __builtin_amdgcn_mfma_f32_32x32x16_bf16(vfa[j4], pb[j4], o0, 0, 0, 0);
        o1 = __builtin_amdgcn_mfma_f32_32x32x16_bf16(vfc[j4], pb[j4], o1, 0, 0, 0); }
}

template <int TYPE  >
__device__ __forceinline__ void attn_unit(const AttnArgs& a, int bl, int head, int qb  , LAS unsigned char* lds, int tid) {
    constexpr int QD = TYPE == 2 ? 6 : 4;
    asm volatile("" : "+v"(tid));
    const int lane = tid & 63, wid = __builtin_amdgcn_readfirstlane(tid >> 6), q32 = lane & 31, hi = lane >> 5;
    const bool isctx = qb < 0;
    const int lat_row0 = bl * SEQ, ctx_row0 = HL + bl * CTXL;
    const bf16* Qb; const bf16* Kb; const bf16* Vb; int qp, kp, vp, ocol; float scale;
    if (TYPE == 0) { Qb = a.bA + 64 * head; Kb = a.bA + 256 + 64 * head; Vb = a.bA + 512 + 64 * head; qp = kp = vp = 768; ocol = 64 * head; scale = 0.125f; }
    else if (TYPE == 1) { Qb = a.bB + 64 * head; Kb = a.bB + 512 + 64 * (head >> 2); Vb = a.bB + 640 + 64 * (head >> 2); qp = kp = vp = 768; ocol = 256 + 64 * head; scale = 0.125f; }
    else { Qb = a.MQ + 96 * head; Kb = a.MKV + 128 * head; Vb = a.MKV + 128 * head + 64; qp = kp = vp = 512; ocol = 768 + 64 * head; scale = 0.10206207261596575f; }
    const float sc2 = scale * LOG2E;
    int nfirst, first_base, kr_lo = 0;
    if (isctx) { nfirst = 0; first_base = 0; }
    else if (TYPE == 0) { kr_lo = na_r0(4 * qb); const int kr_hi = na_r0(4 * qb + 3) + 7; nfirst = kr_hi - kr_lo + 1; first_base = lat_row0 + 64 * kr_lo; }
    else { nfirst = 32; first_base = lat_row0; }
    const int NT = nfirst + 4;
#define TILE_ROW(j) ((j) < nfirst ? first_base + 64 * (j) : ctx_row0 + 64 * ((j) - nfirst))
    const int krow = tid >> 3, kc = tid & 7, k2row = tid >> 2, k2c = tid & 3;
    u32x4 kA, vA, k2A = (u32x4){0u, 0u, 0u, 0u}, kB, vB, k2B = (u32x4){0u, 0u, 0u, 0u};
#define LOAD_TILE(j, kreg, vreg, k2reg) do { const int rb_ = TILE_ROW(j); kreg = *(const u32x4*)(Kb + (size_t)(rb_ + krow) * kp + 8 * kc); vreg = *(const u32x4*)(Vb + (size_t)(rb_ + krow) * vp + 8 * kc); \
        if (TYPE == 2 && tid < 256) k2reg = *(const u32x4*)(a.bC + (size_t)(rb_ + k2row) * 512 + 384 + 8 * k2c); } while (0)
#define STORE_TILE(buf, vbuf, kreg, vreg, k2reg) do { *(LAS u32x4*)(lds + A_KT + (buf) * KTB + krow * KTP + kc * 16) = kreg; \
        if (TYPE == 2 && tid < 256) *(LAS u32x4*)(lds + A_KT + (buf) * KTB + k2row * KTP + 128 + k2c * 16) = k2reg; \
          \
        { const bool odd_ = krow & 1; \
          const unsigned snd0_ = odd_ ? vreg.x : vreg.z, snd1_ = odd_ ? vreg.y : vreg.w;             \
          const unsigned rcv0_ = (unsigned)__builtin_amdgcn_ds_swizzle((int)snd0_, (8 << 10) | 0x1f), rcv1_ = (unsigned)__builtin_amdgcn_ds_swizzle((int)snd1_, (8 << 10) | 0x1f); \
          const unsigned ev0_ = odd_ ? rcv0_ : vreg.x, ev1_ = odd_ ? rcv1_ : vreg.y, od0_ = odd_ ? vreg.z : rcv0_, od1_ = odd_ ? vreg.w : rcv1_;     \
          const int kvp_ = (krow & 0x30) | ((krow & 4) << 1) | ((krow & 8) >> 1) | (krow & 2);        \
          LAS unsigned* vt_ = (LAS unsigned*)(lds + A_VT + (vbuf) * VTB + (8 * kc + 4 * (krow & 1)) * VTP + kvp_ * 2); \
          vt_[0 * (VTP / 4)] = __builtin_amdgcn_perm(od0_, ev0_, 0x05040100u); vt_[1 * (VTP / 4)] = __builtin_amdgcn_perm(od0_, ev0_, 0x07060302u); \
          vt_[2 * (VTP / 4)] = __builtin_amdgcn_perm(od1_, ev1_, 0x05040100u); vt_[3 * (VTP / 4)] = __builtin_amdgcn_perm(od1_, ev1_, 0x07060302u); } } while (0)
    LOAD_TILE(0, kA, vA, k2A);
    if (TYPE == 0 && !isctx) { if (tid < 465) ((LAS float*)(lds + A_BIAS))[tid] = a.na_bias[head * 465 + tid] * LOG2E; }
    const int qloc = 32 * wid + q32;
    const int qrow_l = isctx ? ctx_row0 + qloc : lat_row0 + 256 * qb + qloc;
    const size_t orow_p = isctx ? (size_t)ML + (size_t)(a.hb * BPH + bl) * CTXL + qloc : (size_t)(a.hb * BPH + bl) * SEQ + 256 * qb + qloc;
    bf16x8 qf[QD];
    {
        u32x4 qw[QD];
#pragma unroll
        for (int d0 = 0; d0 < QD; ++d0) qw[d0] = *(const u32x4*)(Qb + (size_t)qrow_l * qp + 16 * d0 + 8 * hi);
        if (TYPE == 1) {
            float x[4][8]; float ss = 0.f;
#pragma unroll
            for (int d0 = 0; d0 < 4; ++d0) { UNPK8(qw[d0], x[d0]);
#pragma unroll
                for (int i = 0; i < 8; ++i) ss += x[d0][i] * x[d0][i]; }
            ss = half_sum(ss);
            const float rstd = sc2 / sqrtf(ss * (1.f / 64.f) + EPS);
#pragma unroll
            for (int d0 = 0; d0 < 4; ++d0) { const f32x4 g0 = *(const f32x4*)(a.q_norm + 16 * d0 + 8 * hi), g1 = *(const f32x4*)(a.q_norm + 16 * d0 + 8 * hi + 4);
#pragma unroll
                for (int i = 0; i < 4; ++i) { x[d0][i] *= rstd * g0[i]; x[d0][4 + i] *= rstd * g1[i]; } }
            if (!isctx) { const int t = 256 * qb + qloc; const float prow = (float)(t >> 6), pcol = (float)(t & 63);
#pragma unroll
                for (int i = 0; i < 8; ++i) { const float fr_ = __builtin_amdgcn_exp2f(-(float)(8 * hi + i) * (13.287712379549449f / 16.f));
                    { const float ang = prow * fr_, cs = __cosf(ang), sn = __sinf(ang), y0 = x[0][i] * cs - x[1][i] * sn, y1 = x[1][i] * cs + x[0][i] * sn; x[0][i] = y0; x[1][i] = y1; }
                    { const float ang = pcol * fr_, cs = __cosf(ang), sn = __sinf(ang), y0 = x[2][i] * cs - x[3][i] * sn, y1 = x[3][i] * cs + x[2][i] * sn; x[2][i] = y0; x[3][i] = y1; } } }
#pragma unroll
            for (int d0 = 0; d0 < 4; ++d0) { qw[d0].x = pk2(x[d0][0], x[d0][1]); qw[d0].y = pk2(x[d0][2], x[d0][3]); qw[d0].z = pk2(x[d0][4], x[d0][5]); qw[d0].w = pk2(x[d0][6], x[d0][7]); }
        }
        if (TYPE == 2 && !isctx) {
            float x0[8], x1[8]; UNPK8(qw[4], x0); UNPK8(qw[5], x1);
            const int t = 256 * qb + qloc; const float pos = hi ? (float)(t & 63) : (float)(t >> 6);
#pragma unroll
            for (int i = 0; i < 8; ++i) { const float ang = pos * __builtin_amdgcn_exp2f(-(float)i * (13.287712379549449f / 8.f)), cs = __cosf(ang), sn = __sinf(ang);
                const float y0 = x0[i] * cs - x1[i] * sn, y1 = x1[i] * cs + x0[i] * sn; x0[i] = y0; x1[i] = y1; }
            qw[4].x = pk2(x0[0], x0[1]); qw[4].y = pk2(x0[2], x0[3]); qw[4].z = pk2(x0[4], x0[5]); qw[4].w = pk2(x0[6], x0[7]);
            qw[5].x = pk2(x1[0], x1[1]); qw[5].y = pk2(x1[2], x1[3]); qw[5].z = pk2(x1[4], x1[5]); qw[5].w = pk2(x1[6], x1[7]);
        }
#pragma unroll
        for (int d0 = 0; d0 < QD; ++d0) qf[d0] = __builtin_bit_cast(bf16x8, qw[d0]);
    }
    STORE_TILE(0, 0, kA, vA, k2A);
    if (NT > 1) LOAD_TILE(1, kA, vA, k2A);
    if (NT > 2) LOAD_TILE(2, kB, vB, k2B);
    __syncthreads();
    const int na_r = 4 * qb + (wid >> 1), na_w0 = na_r0(na_r), qc = 32 * (wid & 1) + q32;
    const int c0 = (qc - 8) < 0 ? 0 : ((qc - 8) > 48 ? 48 : (qc - 8));
    bool fresh = true; float m2 = 0.f, lsum = 0.f; f32x16 o0 = {}, o1 = {}, negm = {};
#define ATT_COMPUTE(IT) do { bool act_c = true; const bool local = (TYPE == 0) && ((IT) < nfirst); \
        if (local) { const int kr = kr_lo + (IT); act_c = (kr >= na_w0) && (kr < na_w0 + 8); } \
        if (act_c) attn_tile<QD>(qf, fresh, negm, m2, lsum, o0, o1, lds + A_KT + ((IT) & 1) * KTB + q32 * KTP + hi * 16, lds + A_VT + ((IT) & 1) * VTB + q32 * VTP + hi * 16, \
                                 local, (const LAS float*)(lds + A_BIAS) + (kr_lo + (IT) - na_r + 7) * 31 + 15 - qc, c0, hi); } while (0)
    for (int it = 0; it < NT; it += 2) {
        ATT_COMPUTE(it);
        if (it + 1 < NT) STORE_TILE(1, 1, kA, vA, k2A);
        if (it + 3 < NT) LOAD_TILE(it + 3, kA, vA, k2A);
        __syncthreads();
        if (it + 1 < NT) {
            ATT_COMPUTE(it + 1);
            if (it + 2 < NT) STORE_TILE(0, 0, kB, vB, k2B);
            if (it + 4 < NT) LOAD_TILE(it + 4, kB, vB, k2B);
            __syncthreads();
        }
    }
#undef ATT_COMPUTE
    lsum = half_sum(lsum);
    const float inv = 1.0f / lsum;
    bf16* op = a.OB + orow_p * D + ocol + 4 * hi;
#pragma unroll
    for (int g = 0; g < 4; ++g) { u32x2 w;
        w.x = pk2(o0[4 * g] * inv, o0[4 * g + 1] * inv); w.y = pk2(o0[4 * g + 2] * inv, o0[4 * g + 3] * inv); *(u32x2*)(op + 8 * g) = w;
        w.x = pk2(o1[4 * g] * inv, o1[4 * g + 1] * inv); w.y = pk2(o1[4 * g + 2] * inv, o1[4 * g + 3] * inv); *(u32x2*)(op + 32 + 8 * g) = w; }
#undef TILE_ROW
#undef LOAD_TILE
#undef STORE_TILE
}
__device__ __forceinline__ void attn_phase(const AttnArgs& a, LAS unsigned char* lds, int tid, int bid, int nbk) {
    const int nunits = 2048 + (a.with_ctx_q ? 256 : 0);
    for (int u = bid; u < nunits; u += nbk) {
        const int rnd = u >> 8, blk = u & 255, x = blk & 7, y = blk >> 3;
        int type, bl, head, qb;
        if (rnd < 4) { const int g = 4 * x + rnd; type = 1; bl = g >> 1; head = 4 * (g & 1) + (y >> 3); qb = y & 7; }
        else if (rnd < 8) { const int g = ((rnd - 4) & 1) * 32 + 4 * x + (y >> 3); type = rnd < 6 ? 2 : 0; bl = g >> 2; head = g & 3; qb = y & 7; }
        else { const int h16 = blk & 15; bl = blk >> 4; qb = -1; if (h16 < 4) { type = 0; head = h16; } else if (h16 < 12) { type = 1; head = h16 - 4; } else { type = 2; head = h16 - 12; } }
        if (type == 1) attn_unit<1>(a, bl, head, qb, lds, tid); else if (type == 2) attn_unit<2>(a, bl, head, qb, lds, tid); else attn_unit<0>(a, bl, head, qb, lds, tid);
    }
}
constexpr size_t WS_CTL = 0, CTL_ZERO_BYTES = 16384;
#define XB_TMO      128
#define XB_XCNT(j)  (256  + 64 * (j))
#define XB_XSUB(j)  (1280 + 64 * (j))
#define XB_XGEN(j)  (2304 + 64 * (j))
#define XB_TOP      3328
#define XB_TOPGEN   3392
#define XCD_BAR_WORDS 3456
#define XB_SPIN_CAP (1u << 18)

__device__ __forceinline__ unsigned xb_ld(unsigned* p)              { return __hip_atomic_load(p, __ATOMIC_RELAXED, __HIP_MEMORY_SCOPE_AGENT); }
__device__ __forceinline__ unsigned xb_add(unsigned* p, unsigned v) { return __hip_atomic_fetch_add(p, v, __ATOMIC_RELAXED, __HIP_MEMORY_SCOPE_AGENT); }
__device__ __forceinline__ unsigned xb_xcc_id() { return (unsigned)__builtin_amdgcn_s_getreg((3 << 11) | 20) & 0xFu; }
#define XB_SPIN(cond, bar) do { unsigned _sp = 0; while (cond) { __builtin_amdgcn_s_sleep(1); \
    if ((++_sp & 255u) == 0u) { if (xb_ld(&(bar)[XB_TMO])) break; if (_sp > XB_SPIN_CAP) { atomicAdd(&(bar)[XB_TMO], 1u); break; } } } } while (0)

struct XcdBarrier {
    unsigned* bar; unsigned x;
    volatile LAS unsigned* st;
};

__device__ __forceinline__ XcdBarrier xcd_barrier_post(unsigned* bar, volatile LAS unsigned* st) {
    XcdBarrier b; b.bar = bar; b.x = xb_xcc_id(); b.st = st;
    if (threadIdx.x == 0) (void)xb_add(&bar[XB_XCNT(b.x)], 1u);
    return b;
}
__device__ __forceinline__ void xcd_barrier_complete(unsigned* bar, unsigned x, unsigned& nloc, unsigned& nx) {
    const unsigned G = gridDim.x * gridDim.y * gridDim.z;
    unsigned sum, cnt, mine, sp = 0u;
    for (;;) {
        sum = 0u; cnt = 0u; mine = 0u;
#pragma unroll
        for (unsigned j = 0; j < 16; ++j) { const unsigned c = xb_ld(&bar[XB_XCNT(j)]); sum += c; cnt += (c > 0u) ? 1u : 0u; mine = (j == x) ? c : mine; }
        if (sum == G) break;
        __builtin_amdgcn_s_sleep(1);
        if ((++sp & 255u) == 0u) { if (xb_ld(&bar[XB_TMO])) break; if (sp > XB_SPIN_CAP) { atomicAdd(&bar[XB_TMO], 1u); break; } }
    }
    nloc = mine > 0u ? mine : 1u; nx = cnt > 0u ? cnt : 1u;
}

__device__ __forceinline__ void xcd_barrier(const XcdBarrier& b) {
    asm volatile("s_waitcnt vmcnt(0)" ::: "memory");
    __syncthreads();
    if (threadIdx.x == 0) {
        unsigned* bar = b.bar;
        __builtin_amdgcn_s_waitcnt(0);
        unsigned nloc = b.st[0], nx = b.st[1];
        if (nloc == 0u) { xcd_barrier_complete(bar, b.x, nloc, nx); b.st[0] = nloc; b.st[1] = nx; }
        const unsigned old = xb_add(&bar[XB_XSUB(b.x)], 1u);
        const unsigned gen = old / nloc;
        if (old + 1u == (gen + 1u) * nloc) {
            __builtin_amdgcn_fence(__ATOMIC_RELEASE, "agent");
            asm volatile("s_waitcnt vmcnt(0)" ::: "memory");
            const unsigned og = xb_add(&bar[XB_TOP], 1u);
            const unsigned tg = og / nx;
            if (og + 1u == (tg + 1u) * nx) xb_add(&bar[XB_TOPGEN], 1u);
            else XB_SPIN(xb_ld(&bar[XB_TOPGEN]) == tg, bar);
            __builtin_amdgcn_fence(__ATOMIC_ACQUIRE, "agent");
            xb_add(&bar[XB_XGEN(b.x)], 1u);
            asm volatile("s_waitcnt vmcnt(0)" ::: "memory");
        } else {
            XB_SPIN(xb_ld(&bar[XB_XGEN(b.x)]) == gen, bar);
            __builtin_amdgcn_fence(__ATOMIC_ACQUIRE, "agent");
            asm volatile("s_waitcnt vmcnt(0)" ::: "memory");
        }
    }
    __syncthreads();
}
constexpr int XB_LDS_OFF = pg8::STAGE_BYTES, LDS_BYTES = pg8::STAGE_BYTES + 64;
static_assert(A_END <= pg8::STAGE_BYTES && XCD_BAR_WORDS * 4 <= (int)CTL_ZERO_BYTES && CTL_ZERO_BYTES <= WS_SC, "LDS / ctl map");
#define GEMM_RUN(EPI_T, E, APTR, LDA, BPTR, LDB, KK, NN, NL, NC, LAT0, CTX0) do { const pg8::Gemm g_{(const bf16*)(APTR), (const bf16*)(BPTR), (LDA), (LDB), (KK)}; \
    MapOrder S_; S_.init((NL), (NC), (LAT0), (CTX0), (NN), nbk, bid); pg8::gemm_phase<EPI_T, MapOrder, EPI_T::ALIGN, true>(lds, g_, S_, E, tid); } while (0)
constexpr int PH_PER_LAYER = 4 + 5 * NCH + 4, PH_TOTAL = 2 + DEPTH * PH_PER_LAYER + 1;

__global__ void __launch_bounds__(512, 2) mega_fwd(Params p_unused) {
#if defined(__HIP_DEVICE_COMPILE__)
    extern __shared__ __attribute__((aligned(16))) unsigned char lds_raw[];
    LAS unsigned char* lds = (LAS unsigned char*)lds_raw;
    cg::grid_group grid = cg::this_grid();
    typedef const __attribute__((address_space(4))) Params* KP;
    const int wave_s = __builtin_amdgcn_readfirstlane(threadIdx.x >> 6);
    if (threadIdx.x < 16) ((LAS unsigned*)(lds + XB_LDS_OFF))[threadIdx.x] = 0u;
    __syncthreads();
    { KP pp0 = (KP)__builtin_amdgcn_kernarg_segment_ptr(); (void)xcd_barrier_post((unsigned*)(pp0->ws + WS_CTL), (volatile LAS unsigned*)(lds + XB_LDS_OFF)); }
#ifndef PROBE_KIND
#define PROBE_KIND -1
#endif
#ifndef PROBE_SYNCS
#define PROBE_SYNCS 0
#endif
    for (int ph2 = 0; ph2 < PH_TOTAL * 2; ++ph2) {
        const int ph = ph2 >> 1;
        if (ph2 & 1) { bool rep = false;
            if (PROBE_KIND >= 0 && ph >= 2 && ph < PH_TOTAL - 1) { const int st_ = (ph - 2) % PH_PER_LAYER; int k_;
                if (st_ < 3) k_ = st_; else if (st_ == 3) k_ = 0; else if (st_ < 4 + 5 * NCH) k_ = 3 + (st_ - 4) % 5; else if (st_ == 4 + 5 * NCH) k_ = 8; else k_ = st_ - (5 + 5 * NCH);
                rep = (k_ == PROBE_KIND); }
            if (PROBE_KIND == 12) rep = (ph == 4);
            if (PROBE_KIND == 13) rep = (ph == 0);
            if (!rep) continue; }
        int lane_, wv_ = wave_s, bid = blockIdx.x, nbk = gridDim.x; KP pp = (KP)__builtin_amdgcn_kernarg_segment_ptr();
        asm volatile("v_mbcnt_lo_u32_b32 %0, -1, 0\n\tv_mbcnt_hi_u32_b32 %0, -1, %0" : "=v"(lane_));
        asm volatile("" : "+s"(wv_), "+s"(bid), "+s"(nbk), "+s"(pp));
        int tid = wv_ * 64 + lane_; asm volatile("" : "+v"(tid));
        unsigned char* ws = pp->ws;
        float* MOD = (float*)(ws + WS_MOD); float* CTXRES = (float*)(ws + WS_CTXRES);
        bf16* NBp = (bf16*)(ws + WS_NB);
        if (ph == 0) { { const Params p = *pp; prep_phase(p, lds, tid, bid, nbk, 0, PREP_ADA + PREP_PER_LAYER, 0, true); } __syncthreads(); }
        else if (ph == 1) { EpiAda E; E.MOD = MOD; E.b_ada = pp->b_ada; GEMM_RUN(EpiAda, E, ws + WS_SC, D, ws + WS_WADA, D, D, 2 * MODW, 1, 0, 0, 0); }
        else if (ph == PH_TOTAL - 1) { final_phase(pp->out, pp->final_norm, tid, bid, nbk); }
        else {
            const int L = (ph - 2) / PH_PER_LAYER, st = (ph - 2) % PH_PER_LAYER;
            const bool last = (L == DEPTH - 1);
            const float* modl = MOD + (size_t)L * 33 * MODW;
            const unsigned char* wl = ws + WS_W + (size_t)L * LW_SIZE;
            int kind, which = 0, hb = 0;
            if (st < 3) { kind = st; which = 0; }
            else if (st == 3) { kind = 0; which = 1; }
            else if (st < 4 + 5 * NCH) { hb = (st - 4) / 5; kind = 3 + (st - 4) % 5; }
            else if (st == 4 + 5 * NCH) { kind = 8; }
            else { kind = st - (5 + 5 * NCH); which = 2; }
            const bool first_in = (L == 0 && which == 0);
            const float* xl = first_in ? pp->x : pp->out; const float* xc = first_in ? pp->ctx : CTXRES;
            const int nctx = (last && (which == 2 || kind >= 7)) ? 0 : 32;
            if (kind == 0) {
                const float* gain = (which == 0 ? pp->f1_norm : which == 1 ? pp->mix_norm : pp->f2_norm) + L * D;
                normmod_phase(xl, xc, gain, modl, 3 * which, NBp, nctx ? MT : ML, tid, bid, nbk);
            } else if (kind == 1) {
                EpiSwiGLU E; E.H = (bf16*)(ws + WS_H);
                GEMM_RUN(EpiSwiGLU, E, NBp, D, wl + (which == 0 ? LW_U1 : LW_U2), D, D, 2 * DFF, 256, nctx, 0, 256);
            } else if (kind == 2) {
                EpiResid E; E.src_lat = xl; E.src_ctx = xc; E.dst_lat = pp->out; E.dst_ctx = CTXRES; E.modl = modl; E.gidx = which == 0 ? 2 : 8; E.coef = 0.5f;
                GEMM_RUN(EpiResid, E, ws + WS_H, DFF, wl + (which == 0 ? LW_D1 : LW_D2), DFF, DFF, D, 256, nctx, 0, 256);
                if (L == 0 && DEPTH > 1) { const int lo_ = PREP_ADA + PREP_PER_LAYER + (which == 0 ? 0 : PREP_PER_LAYER / 2), hi_ = PREP_ADA + PREP_PER_LAYER + (which == 0 ? PREP_PER_LAYER / 2 : PREP_PER_LAYER);
                    __syncthreads(); const Params p = *pp; prep_phase(p, lds, tid, bid, nbk, lo_, hi_, nbk / 2, false); __syncthreads(); }
            } else if (kind == 8) {
                EpiResid E; E.src_lat = pp->out; E.src_ctx = CTXRES; E.dst_lat = pp->out; E.dst_ctx = CTXRES; E.modl = modl; E.gidx = 5; E.coef = 1.0f;
                GEMM_RUN(EpiResid, E, ws + WS_Y, D, wl + LW_OUT, D, D, D, 256, nctx, 0, 256);
            } else if (kind == 3) {
                EpiWin E; E.bA = (bf16*)(ws + WS_BA); E.bB = (bf16*)(ws + WS_BB); E.bC = (bf16*)(ws + WS_BC); E.G = (bf16*)(ws + WS_G); E.hb = hb;
                if (!last) { GEMM_RUN(EpiWin, E, NBp, D, wl + LW_IN, D, D, INWP, HL / 256, HC / 256, (HL / 256) * hb, 256 + (HC / 256) * hb); }
                else {
                    GEMM_RUN(EpiWin, E, NBp, D, wl + LW_IN, D, D, INWP, HL / 256, 0, (HL / 256) * hb, 0);
                    { const pg8::Gemm g_{(const bf16*)NBp, (const bf16*)(wl + LW_IN), D, D, D}; MapOrder S_; S_.init(0, HC / 256, 0, 256 + (HC / 256) * hb, 4 * 256, nbk, (bid + nbk / 2) % nbk); S_.cmap = 0x7521ull;
                      pg8::gemm_phase<EpiWin, MapOrder, EpiWin::ALIGN, true>(lds, g_, S_, E, tid); } }
            } else if (kind == 4) {
                post_phase((bf16*)(ws + WS_BB), (bf16*)(ws + WS_BC), pp->k_norm + L * 64, pp->mq_norm + L * 256, pp->mkv_norm + L * 128, tid, bid, nbk);
            } else if (kind == 5) {
                for (int s = 0; s < 2; ++s) { EpiPlain E; E.O = (bf16*)(ws + (s ? WS_MKV : WS_MQ)); E.ldc = 512; E.scale = s ? 1.0f : 0.10206207261596575f * LOG2E;
                    GEMM_RUN(EpiPlain, E, (bf16*)(ws + WS_BC) + (s ? 256 : 0), 512, wl + (s ? LW_UKV : LW_UQ), s ? 128 : 256, s ? 128 : 256, 512, HM / 256, 0, 0, 0); }
            } else if (kind == 6) {
                AttnArgs a; a.bA = (const bf16*)(ws + WS_BA); a.bB = (const bf16*)(ws + WS_BB); a.bC = (const bf16*)(ws + WS_BC); a.MQ = (const bf16*)(ws + WS_MQ); a.MKV = (const bf16*)(ws + WS_MKV); a.OB = NBp;
                a.q_norm = pp->q_norm + L * 64; a.na_bias = pp->na_bias + (size_t)L * 4 * 465; a.hb = hb; a.with_ctx_q = last ? 0 : 1;
                attn_phase(a, lds, tid, bid, nbk);
            } else {
                EpiBranch E; E.G = (const bf16*)(ws + WS_G); E.Y = (bf16*)(ws + WS_Y); E.hb = hb;
                GEMM_RUN(EpiBranch, E, NBp, D, wl + LW_BR, D, D, D, HL / 256, nctx ? HC / 256 : 0, (HL / 256) * hb, 256 + (HC / 256) * hb);
            }
        }
        if (ph + 1 < PH_TOTAL) {
            if (ph == 0) grid.sync();
            else { XcdBarrier xb_; xb_.bar = (unsigned*)(pp->ws + WS_CTL); xb_.x = xb_xcc_id(); xb_.st = (volatile LAS unsigned*)(lds + XB_LDS_OFF); xcd_barrier(xb_); }
            for (int e_ = 0; e_ < PROBE_SYNCS; ++e_) grid.sync(); }
    }
#endif
}

extern "C" void kernel_launch(void* const* d_in, const int* in_sizes, int n_in, void* d_out, int out_size, void* d_ws, size_t ws_size, hipStream_t stream) {
    static int grid = 0;
    if (grid == 0) {
        if (n_in != 28 || out_size != ML * D || ws_size < (size_t)1024 * MiB) { fprintf(stderr, "kernel_launch: unexpected problem (n_in %d, out %d, ws %zu)\n", n_in, out_size, ws_size); grid = -1; return; }
        int dev = 0, cus = 0, per_cu = 0;
        (void)hipGetDevice(&dev); (void)hipDeviceGetAttribute(&cus, hipDeviceAttributeMultiprocessorCount, dev);
        (void)hipFuncSetAttribute((const void*)mega_fwd, hipFuncAttributeMaxDynamicSharedMemorySize, LDS_BYTES);
        (void)hipOccupancyMaxActiveBlocksPerMultiprocessor(&per_cu, (const void*)mega_fwd, 512, LDS_BYTES);
        if (per_cu < 1) per_cu = 1;
        grid = cus * per_cu;
    }
    if (grid < 0) return;
    if (hipMemsetAsync((char*)d_ws + WS_CTL, 0, CTL_ZERO_BYTES, stream) != hipSuccess) { fprintf(stderr, "kernel_launch: memset of barrier words failed\n"); return; }
    Params p{};
    const float* const* in = (const float* const*)d_in;
    p.x = in[0]; p.c = in[1]; p.ctx = in[2]; p.c_ctx = in[3]; p.w_ada = in[4]; p.b_ada = in[5];
    p.f1_norm = in[6]; p.f1_wg = in[7]; p.f1_wu = in[8]; p.f1_wd = in[9];
    p.mix_norm = in[10]; p.w_in = in[11]; p.na_bias = in[12]; p.q_norm = in[13]; p.k_norm = in[14]; p.mq_norm = in[15]; p.mkv_norm = in[16];
    p.w_uq = in[17]; p.w_ukv = in[18]; p.w_ba = in[19]; p.w_bb = in[20]; p.w_bc = in[21]; p.w_out = in[22];
    p.f2_norm = in[23]; p.f2_wg = in[24]; p.f2_wu = in[25]; p.f2_wd = in[26]; p.final_norm = in[27];
    p.out = (float*)d_out; p.ws = (unsigned char*)d_ws;
    void* args[] = {&p};
    hipError_t e = hipLaunchCooperativeKernel((const void*)mega_fwd, dim3(grid), dim3(512), args, LDS_BYTES, stream);
    if (e != hipSuccess) fprintf(stderr, "cooperative launch failed: %s (grid %d)\n", hipGetErrorString(e), grid);
}
```

```cpp
#include <hip/hip_runtime.h>
#include <hip/hip_cooperative_groups.h>
#include <cstdio>
#include <cstdint>
namespace cg = cooperative_groups;
namespace pg8 {
#define PG8_LAS __attribute__((address_space(3)))
typedef unsigned short bf16_t;
typedef short bf16x8 __attribute__((ext_vector_type(8)));
typedef float f32x4 __attribute__((ext_vector_type(4)));
typedef unsigned u32x4 __attribute__((ext_vector_type(4)));
constexpr int BM = 256, BK = 64, HALF = 128, HTB = HALF * BK * 2  , STAGE_BYTES = 8 * HTB, NXCD = 8, WGM = 8;

__host__ __device__ __forceinline__ int lds_byte(int r, int c) { const int st = (r >> 4) * 2 + (c >> 5), rr = r & 15, cc = c & 31, ob = rr * 64 + cc * 2; return st * 1024 + (ob ^ (((ob >> 9) & 1) << 5)); }
__host__ __device__ __forceinline__ void stage_rc(int b, int& R, int& C) { const int st = b / 1024, sb = b % 1024, swz = sb ^ (((sb >> 9) & 1) << 5); R = (st >> 1) * 16 + swz / 64; C = (st & 1) * 32 + (swz % 64) / 2; }
__host__ __device__ __forceinline__ int perm32(int rho) { const int n = rho >> 4, i = rho & 15; return 8 * (i >> 2) + 4 * n + (i & 3); }

struct Unit { int pm, pn; };
struct Gemm { const bf16_t* A; const bf16_t* Bt; int lda, ldb, K; };

struct StaticOrder {
    int nM, nN, nwg, G, c;
    __host__ __device__ void init(int M, int N, int G_, int c_) { nM = M / BM; nN = N / BM; nwg = nM * nN; G = G_; c = c_; }
    __host__ __device__ bool next(int i, Unit& u) const {
        const long L = (long)i * G + c; if (L >= nwg) return false;
        int wgid = (int)L; { const int q = nwg / NXCD, r = nwg % NXCD, xcd = wgid % NXCD, off = wgid / NXCD; wgid = (xcd < r ? xcd * (q + 1) : r * (q + 1) + (xcd - r) * q) + off; }
        const int nig = WGM * nN, gid = wgid / nig, fm = gid * WGM, gsz = (nM - fm) < WGM ? (nM - fm) : WGM;
        u.pm = fm + ((wgid % nig) % gsz); u.pn = (wgid % nig) / gsz; return true;
    }
    __device__ __forceinline__ void a_ready(const Unit&) const {}
    __device__ __forceinline__ void done(const Unit&) const {}
};

__device__ __forceinline__ unsigned cvt_pk_bf16(float lo, float hi) { unsigned r; asm volatile("v_cvt_pk_bf16_f32 %0, %1, %2" : "=v"(r) : "v"(lo), "v"(hi)); return r; }
template <class Epi, class Sched, bool ALIGN_EPI = false, bool SP2 = false>
__device__ __forceinline__ void gemm_phase(PG8_LAS unsigned char* lds, const Gemm g, const Sched& S, const Epi& E, const int tid) {
    const int wid = __builtin_amdgcn_readfirstlane(tid >> 6), lane = tid & 63, wr = wid >> 2, wc = wid & 3, fr = lane & 15, fq = lane >> 4;
    const int K = g.K, nt = K / BK;
    unsigned voffA[2], voffB[2];
#pragma unroll
    for (int i = 0; i < 2; ++i) { int R, C; stage_rc(tid * 16 + i * 8192, R, C); const int Rb = Epi::PERM ? ((R & ~31) + perm32(R & 31)) : R;
        voffA[i] = (unsigned)(R * g.lda + C) * 2u; voffB[i] = (unsigned)(Rb * g.ldb + C) * 2u; }
    const size_t kstep = (size_t)(BK * 2);
    const size_t hstepA = (size_t)HALF * g.lda * 2, hstepB = (size_t)HALF * g.ldb * 2;
    const size_t tstepA = 2 * hstepA, tstepB = 2 * hstepB;
    const unsigned ldsw = (unsigned)wid * 1024u;
    const int aoff = lds_byte(wr * 64 + fr, fq * 8), boff = lds_byte(wc * 32 + fr, fq * 8);
#define PG8_SA(b, h) (((b) * 2 + (h)) * HTB)
#define PG8_SB(b, h) ((4 + (b) * 2 + (h)) * HTB)
#define PG8_STAGE(bufoff, gbase, voff) do { _Pragma("unroll") for (int _i = 0; _i < 2; ++_i) \
        __builtin_amdgcn_global_load_lds((const unsigned*)((const char*)(gbase) + (voff)[_i]), (PG8_LAS unsigned*)(lds + (bufoff) + ldsw + _i * 8192), 16, 0, 0); } while (0)
#define PG8_LDA(dst, b, h) do { _Pragma("unroll") for (int m = 0; m < 4; ++m) _Pragma("unroll") for (int k = 0; k < 2; ++k) dst[m][k] = *(const PG8_LAS bf16x8*)(lds + PG8_SA(b, h) + aoff + m * 2048 + k * 1024); } while (0)
#define PG8_LDB(dst, b, h) do { _Pragma("unroll") for (int n = 0; n < 2; ++n) _Pragma("unroll") for (int k = 0; k < 2; ++k) dst[n][k] = *(const PG8_LAS bf16x8*)(lds + PG8_SB(b, h) + boff + n * 2048 + k * 1024); } while (0)
#define PG8_MMA(ai, bj, At, Bt) do { __builtin_amdgcn_s_setprio(1); _Pragma("unroll") for (int m = 0; m < 4; ++m) _Pragma("unroll") for (int n = 0; n < 2; ++n) _Pragma("unroll") for (int k = 0; k < 2; ++k) \
        acc[ai][bj][m][n] = __builtin_amdgcn_mfma_f32_16x16x32_bf16(Bt[n][k], At[m][k], acc[ai][bj][m][n], 0, 0, 0); __builtin_amdgcn_s_setprio(0); } while (0)
#define PG8_WAIT_V(n) asm volatile("s_waitcnt vmcnt(" #n ")" ::: "memory")
#define PG8_WAIT_L(n) asm volatile("s_waitcnt lgkmcnt(" #n ")" ::: "memory")
#define PG8_BAR __builtin_amdgcn_s_barrier()
#define PG8_SCHED __builtin_amdgcn_sched_barrier(0)
    Unit cur, nxt; int ui = 0;
    if (!S.next(0, cur)) return;
    f32x4 acc[2][2][4][2];
#pragma unroll
    for (int a = 0; a < 2; ++a)
#pragma unroll
        for (int b = 0; b < 2; ++b)
#pragma unroll
            for (int m = 0; m < 4; ++m)
#pragma unroll
                for (int n = 0; n < 2; ++n) acc[a][b][m][n] = (f32x4){0.f, 0.f, 0.f, 0.f};
    bf16x8 At[4][2], B0[2][2], B1[2][2];
    const char* cA = (const char*)g.A + (size_t)cur.pm * tstepA; const char* cB = (const char*)g.Bt + (size_t)cur.pn * tstepB;
    S.a_ready(cur);
    if constexpr (SP2) {
        PG8_STAGE(PG8_SB(0, 0), cB, voffB); PG8_STAGE(PG8_SB(0, 1), cB + hstepB, voffB); PG8_STAGE(PG8_SA(0, 0), cA, voffA); PG8_STAGE(PG8_SA(0, 1), cA + hstepA, voffA);
        if (wr == 1) PG8_BAR;
        PG8_WAIT_V(2); PG8_BAR;
        PG8_STAGE(PG8_SB(1, 0), cB + kstep, voffB); PG8_STAGE(PG8_SA(1, 0), cA + kstep, voffA); PG8_STAGE(PG8_SB(1, 1), cB + hstepB + kstep, voffB);
        PG8_WAIT_V(6); PG8_BAR;
    } else {
        PG8_STAGE(PG8_SB(0, 0), cB, voffB); PG8_STAGE(PG8_SA(0, 0), cA, voffA); PG8_STAGE(PG8_SB(0, 1), cB + hstepB, voffB); PG8_STAGE(PG8_SA(0, 1), cA + hstepA, voffA);
        if (wr == 1) PG8_BAR;
        PG8_WAIT_V(4); PG8_BAR;
        PG8_STAGE(PG8_SB(1, 0), cB + kstep, voffB); PG8_STAGE(PG8_SA(1, 0), cA + kstep, voffA); PG8_STAGE(PG8_SB(1, 1), cB + hstepB + kstep, voffB);
        PG8_WAIT_V(6); PG8_BAR;
    }
    for (;;) {
        const bool has_next = S.next(ui + 1, nxt);
        const char* nA = has_next ? (const char*)g.A + (size_t)nxt.pm * tstepA : cA; const char* nB = has_next ? (const char*)g.Bt + (size_t)nxt.pn * tstepB : cB;
        for (int t = 0; t < nt; t += 2) {
            const bool last = (t == nt - 2);
            const char* a1 = cA + (size_t)(t + 1) * kstep;
            const char* a2 = last ? nA : cA + (size_t)(t + 2) * kstep; const char* b2 = last ? nB : cB + (size_t)(t + 2) * kstep;
            const char* a3 = a2 + kstep; const char* b3 = b2 + kstep;
            if (last && has_next) S.a_ready(nxt);
            if constexpr (SP2) {
            PG8_LDB(B0, 0, 0); PG8_LDB(B1, 0, 1); PG8_SCHED; PG8_LDA(At, 0, 0); PG8_STAGE(PG8_SA(1, 1), a1 + hstepA, voffA);
            PG8_WAIT_V(8); PG8_WAIT_L(0); PG8_BAR; PG8_MMA(0, 0, At, B0); PG8_MMA(0, 1, At, B1); PG8_BAR; PG8_SCHED;
            PG8_LDA(At, 0, 1); PG8_STAGE(PG8_SB(0, 0), b2, voffB); PG8_STAGE(PG8_SB(0, 1), b2 + hstepB, voffB); PG8_STAGE(PG8_SA(0, 0), a2, voffA);
            PG8_WAIT_V(8); PG8_WAIT_L(0); PG8_BAR; PG8_MMA(1, 0, At, B0); PG8_MMA(1, 1, At, B1); PG8_BAR; PG8_SCHED;
            PG8_LDB(B0, 1, 0); PG8_LDB(B1, 1, 1); PG8_SCHED; PG8_LDA(At, 1, 0); PG8_STAGE(PG8_SA(0, 1), a2 + hstepA, voffA);
            PG8_WAIT_V(8); PG8_WAIT_L(0); PG8_BAR; PG8_MMA(0, 0, At, B0); PG8_MMA(0, 1, At, B1); PG8_BAR; PG8_SCHED;
            PG8_LDA(At, 1, 1); PG8_STAGE(PG8_SB(1, 0), b3, voffB); PG8_STAGE(PG8_SB(1, 1), b3 + hstepB, voffB); PG8_STAGE(PG8_SA(1, 0), a3, voffA);
            PG8_WAIT_V(8); PG8_WAIT_L(0); PG8_BAR; PG8_MMA(1, 0, At, B0); PG8_MMA(1, 1, At, B1); PG8_BAR; PG8_SCHED;
            } else {
            PG8_LDB(B0, 0, 0); PG8_SCHED; PG8_LDA(At, 0, 0); PG8_STAGE(PG8_SA(1, 1), a1 + hstepA, voffA);
            PG8_WAIT_L(8); PG8_BAR; PG8_WAIT_L(0); PG8_MMA(0, 0, At, B0); PG8_BAR; PG8_SCHED;
            PG8_LDB(B1, 0, 1); PG8_STAGE(PG8_SB(0, 0), b2, voffB);
            PG8_BAR; PG8_WAIT_L(0); PG8_MMA(0, 1, At, B1); PG8_BAR;
            PG8_LDA(At, 0, 1); PG8_STAGE(PG8_SA(0, 0), a2, voffA);
            PG8_BAR; PG8_WAIT_L(0); PG8_MMA(1, 0, At, B0); PG8_BAR; PG8_SCHED;
            PG8_STAGE(PG8_SB(0, 1), b2 + hstepB, voffB);
            PG8_WAIT_V(6); PG8_BAR; PG8_MMA(1, 1, At, B1); PG8_BAR;
            PG8_LDB(B0, 1, 0); PG8_SCHED; PG8_LDA(At, 1, 0); PG8_STAGE(PG8_SA(0, 1), a2 + hstepA, voffA);
            PG8_WAIT_L(8); PG8_BAR; PG8_WAIT_L(0); PG8_MMA(0, 0, At, B0); PG8_BAR; PG8_SCHED;
            PG8_LDB(B1, 1, 1); PG8_STAGE(PG8_SB(1, 0), b3, voffB);
            PG8_BAR; PG8_WAIT_L(0); PG8_MMA(0, 1, At, B1); PG8_BAR;
            PG8_LDA(At, 1, 1); PG8_STAGE(PG8_SA(1, 0), a3, voffA);
            PG8_BAR; PG8_WAIT_L(0); PG8_MMA(1, 0, At, B0); PG8_BAR; PG8_SCHED;
            PG8_STAGE(PG8_SB(1, 1), b3 + hstepB, voffB);
            PG8_WAIT_V(6); PG8_BAR; PG8_MMA(1, 1, At, B1); PG8_BAR;
            }
            if constexpr (Epi::HAS_MID) { if (t + 2 == Epi::MID1 || t + 2 == Epi::MID2) E.mid(acc, cur, t + 2, wr, wc, fr, fq); }
        }
        if constexpr (ALIGN_EPI) { if (wr == 0) PG8_BAR; }
        if constexpr (!Epi::AFTER_DRAIN) { E(acc, cur, wr, wc, fr, fq); S.done(cur); }
        if (!has_next) break;
#pragma unroll
        for (int a = 0; a < 2; ++a)
#pragma unroll
            for (int b = 0; b < 2; ++b)
#pragma unroll
                for (int m = 0; m < 4; ++m)
#pragma unroll
                    for (int n = 0; n < 2; ++n) acc[a][b][m][n] = (f32x4){0.f, 0.f, 0.f, 0.f};
        cur = nxt; cA = nA; cB = nB; ++ui;
        if constexpr (ALIGN_EPI) { if (wr == 1) PG8_BAR; }
    }
    PG8_WAIT_V(0);
    if constexpr (!ALIGN_EPI) { if (wr == 0) PG8_BAR; }
    PG8_BAR;
    if constexpr (Epi::AFTER_DRAIN) { E.fused(acc, cur, wr, wc, fr, fq, lds, wid, lane); S.done(cur); }
#undef PG8_SA
#undef PG8_SB
#undef PG8_STAGE
#undef PG8_LDA
#undef PG8_LDB
#undef PG8_MMA
#undef PG8_WAIT_V
#undef PG8_WAIT_L
#undef PG8_BAR
#undef PG8_SCHED
}
}
using pg8::Unit; using pg8::f32x4; using pg8::u32x4; using pg8::bf16x8;
typedef unsigned short bf16;
#define LAS __attribute__((address_space(3)))
typedef float f32x16 __attribute__((ext_vector_type(16)));
typedef float f32x2 __attribute__((ext_vector_type(2)));
typedef unsigned u32x2 __attribute__((ext_vector_type(2)));

constexpr int D = 1024, NBATCH = 32, SEQ = 2048, CTXL = 256, DFF = 2816, DEPTH = 2;
constexpr int ML = NBATCH * SEQ, MC = NBATCH * CTXL, MT = ML + MC;
constexpr int MODW = 9 * D;
constexpr int INW = 5024, INWP = 5120;
constexpr int NCH = 2, BPH = NBATCH / NCH;
constexpr int HL = BPH * SEQ, HC = BPH * CTXL, HM = HL + HC;
constexpr float EPS = 1e-6f, LOG2E = 1.4426950408889634f;

constexpr size_t MiB = 1u << 20;
constexpr size_t WS_SC = 1 * MiB;
constexpr size_t WS_MOD = 2 * MiB;
constexpr size_t WS_CTXRES = 8 * MiB;
constexpr size_t WS_W = 40 * MiB;
constexpr size_t LW_U1 = 0, LW_D1 = LW_U1 + (size_t)2 * DFF * D * 2, LW_U2 = LW_D1 + (size_t)D * DFF * 2, LW_D2 = LW_U2 + (size_t)2 * DFF * D * 2,
                 LW_IN = LW_D2 + (size_t)D * DFF * 2, LW_UQ = LW_IN + (size_t)INWP * D * 2, LW_UKV = LW_UQ + (size_t)512 * 256 * 2, LW_BR = LW_UKV + (size_t)512 * 128 * 2,
                 LW_OUT = LW_BR + (size_t)D * D * 2, LW_SIZE = LW_OUT + (size_t)D * D * 2;
static_assert(WS_W + 2 * LW_SIZE <= 136 * MiB, "weights");
constexpr size_t WS_NB = 136 * MiB;
constexpr size_t WS_Y = 280 * MiB;
constexpr size_t WS_BIG = 424 * MiB;
constexpr size_t WS_H = WS_BIG;
constexpr size_t WS_WADA = WS_BIG;
constexpr size_t WS_BA = WS_BIG;
constexpr size_t WS_BB = WS_BA + (size_t)HM * 768 * 2;
constexpr size_t WS_BC = WS_BB + (size_t)HM * 768 * 2;
constexpr size_t WS_MQ = WS_BC + (size_t)HM * 512 * 2;
constexpr size_t WS_MKV = WS_MQ + (size_t)HM * 512 * 2;
constexpr size_t WS_G = WS_MKV + (size_t)HM * 512 * 2;
constexpr size_t WS_END = WS_G + (size_t)HM * 3072 * 2;
static_assert(WS_END <= 1024 * MiB && WS_H + (size_t)MT * DFF * 2 <= 1024 * MiB, "ws map");

struct Params {
    const float* x; const float* c; const float* ctx; const float* c_ctx; const float* w_ada; const float* b_ada;
    const float* f1_norm; const float* f1_wg; const float* f1_wu; const float* f1_wd;
    const float* mix_norm; const float* w_in; const float* na_bias; const float* q_norm; const float* k_norm; const float* mq_norm; const float* mkv_norm;
    const float* w_uq; const float* w_ukv; const float* w_ba; const float* w_bb; const float* w_bc; const float* w_out;
    const float* f2_norm; const float* f2_wg; const float* f2_wu; const float* f2_wd; const float* final_norm;
    float* out; unsigned char* ws;
};

__device__ __forceinline__ float bf2f(unsigned v) { return __uint_as_float(v << 16); }
typedef __bf16 bf16x2_t __attribute__((ext_vector_type(2)));
__device__ __forceinline__ unsigned pk2(float lo, float hi) { const f32x2 v = {lo, hi}; const bf16x2_t b = __builtin_convertvector(v, bf16x2_t); return __builtin_bit_cast(unsigned, b); }
__device__ __forceinline__ float fsilu(float x) { return x * __builtin_amdgcn_rcpf(1.f + __builtin_amdgcn_exp2f(-x * LOG2E)); }
__device__ __forceinline__ float fsigm(float x) { return __builtin_amdgcn_rcpf(1.f + __builtin_amdgcn_exp2f(-x * LOG2E)); }
template <int M> __device__ __forceinline__ float swz_xor(float v) { return __int_as_float(__builtin_amdgcn_ds_swizzle(__float_as_int(v), (M << 10) | 0x1f)); }
__device__ __forceinline__ float half_sum(float v) { auto rr = __builtin_amdgcn_permlane32_swap(__float_as_uint(v), __float_as_uint(v), false, false); return __uint_as_float(rr[0]) + __uint_as_float(rr[1]); }
__device__ __forceinline__ float half_max(float v) { auto rr = __builtin_amdgcn_permlane32_swap(__float_as_uint(v), __float_as_uint(v), false, false); return __builtin_fmaxf(__uint_as_float(rr[0]), __uint_as_float(rr[1])); }
__device__ __forceinline__ float sum32(float v) { v += swz_xor<1>(v); v += swz_xor<2>(v); v += swz_xor<4>(v); v += swz_xor<8>(v); v += swz_xor<16>(v); return v; }
__device__ __forceinline__ float wave_sum(float v) { return half_sum(sum32(v)); }
#define UNPK8(W_, f) do { const u32x4 w__ = (W_); f[0] = bf2f(w__[0] & 0xffffu); f[1] = __uint_as_float(w__[0] & 0xffff0000u); f[2] = bf2f(w__[1] & 0xffffu); f[3] = __uint_as_float(w__[1] & 0xffff0000u); \
                         f[4] = bf2f(w__[2] & 0xffffu); f[5] = __uint_as_float(w__[2] & 0xffff0000u); f[6] = bf2f(w__[3] & 0xffffu); f[7] = __uint_as_float(w__[3] & 0xffff0000u); } while (0)

struct MapOrder {
    pg8::StaticOrder s; int nl, lat0, ctx0; unsigned long long cmap;
    __device__ __forceinline__ void init(int nl_, int nc_, int lat0_, int ctx0_, int N, int G, int c) { nl = nl_; lat0 = lat0_; ctx0 = ctx0_; cmap = 0ull; s.init((nl_ + nc_) * 256, N, G, c); }
    __device__ __forceinline__ bool next(int i, Unit& u) const { if (!s.next(i, u)) return false; u.pm = u.pm < nl ? lat0 + u.pm : ctx0 + (u.pm - nl);
        if (cmap) u.pn = (int)((cmap >> (4 * u.pn)) & 15ull); return true; }
    __device__ __forceinline__ void a_ready(const Unit&) const {}
    __device__ __forceinline__ void done(const Unit&) const {}
};

#ifndef RESID_ALIGN
#define RESID_ALIGN false
#endif
#define EPI_COMMON static constexpr bool PERM = true, AFTER_DRAIN = false
#define EPI_NOMID static constexpr bool HAS_MID = false; static constexpr int MID1 = -1, MID2 = -1; \
    __device__ __forceinline__ void mid(f32x4 (&)[2][2][4][2], const Unit&, int, int, int, int, int) const {}
typedef f32x4 Acc[2][2][4][2];

struct EpiSwiGLU { EPI_COMMON; static constexpr bool ALIGN = true; EPI_NOMID; bf16* H;
    __device__ __forceinline__ void operator()(const Acc& acc, const Unit& u, int wr, int wc, int fr, int fq) const {
        const int row0 = u.pm * 256 + wr * 64 + fr, col0 = u.pn * 128 + wc * 32 + 8 * fq;
#pragma unroll
        for (int ai = 0; ai < 2; ++ai)
#pragma unroll
            for (int m = 0; m < 4; ++m) {
                const f32x4 g0 = acc[ai][0][m][0], g1 = acc[ai][0][m][1], u0 = acc[ai][1][m][0], u1 = acc[ai][1][m][1];
                u32x4 w; w.x = pk2(fsilu(g0[0]) * u0[0], fsilu(g0[1]) * u0[1]); w.y = pk2(fsilu(g0[2]) * u0[2], fsilu(g0[3]) * u0[3]);
                w.z = pk2(fsilu(g1[0]) * u1[0], fsilu(g1[1]) * u1[1]); w.w = pk2(fsilu(g1[2]) * u1[2], fsilu(g1[3]) * u1[3]);
                *(u32x4*)(H + (size_t)(row0 + ai * 128 + m * 16) * DFF + col0) = w; }
    }
};
struct EpiResid { EPI_COMMON; static constexpr bool ALIGN = RESID_ALIGN; EPI_NOMID; const float* src_lat; const float* src_ctx; float* dst_lat; float* dst_ctx; const float* modl; int gidx; float coef;
    __device__ __forceinline__ void operator()(const Acc& acc, const Unit& u, int wr, int wc, int fr, int fq) const {
        const bool isl = u.pm < 256;
        const float* src = isl ? src_lat + (size_t)u.pm * 256 * D : src_ctx + (size_t)(u.pm - 256) * 256 * D;
        float* dst = isl ? dst_lat + (size_t)u.pm * 256 * D : dst_ctx + (size_t)(u.pm - 256) * 256 * D;
        const float* gate = modl + (size_t)(isl ? (u.pm >> 3) : 32) * MODW + gidx * D;
        const int col0 = u.pn * 256 + wc * 32 + 8 * fq;
#pragma unroll
        for (int bj = 0; bj < 2; ++bj) {
            const f32x4 g0 = *(const f32x4*)(gate + col0 + bj * 128) * coef, g1 = *(const f32x4*)(gate + col0 + bj * 128 + 4) * coef;
            f32x4 x0[8], x1[8];
#pragma unroll
            for (int g = 0; g < 8; ++g) { const size_t off = (size_t)((g >> 2) * 128 + wr * 64 + (g & 3) * 16 + fr) * D + col0 + bj * 128;
                x0[g] = *(const f32x4*)(src + off); x1[g] = *(const f32x4*)(src + off + 4); }
            __builtin_amdgcn_sched_barrier(0);
#pragma unroll
            for (int g = 0; g < 8; ++g) { const size_t off = (size_t)((g >> 2) * 128 + wr * 64 + (g & 3) * 16 + fr) * D + col0 + bj * 128;
                *(f32x4*)(dst + off) = x0[g] + g0 * acc[g >> 2][bj][g & 3][0]; *(f32x4*)(dst + off + 4) = x1[g] + g1 * acc[g >> 2][bj][g & 3][1]; }
            __builtin_amdgcn_sched_barrier(0);
        }
    }
};
__device__ __forceinline__ int ltile(int pm, int hb) { return pm < 256 ? pm - (HL / 256) * hb : (HL / 256) + (pm - 256 - (HC / 256) * hb); }
struct EpiWin { EPI_COMMON; static constexpr bool ALIGN = true; EPI_NOMID; bf16* bA; bf16* bB; bf16* bC; bf16* G; int hb;
    __device__ __forceinline__ void operator()(const Acc& acc, const Unit& u, int wr, int wc, int fr, int fq) const {
        const int lrow0 = ltile(u.pm, hb) * 256 + wr * 64 + fr;
        bf16* base; int ld, ct; bool sg = false;
        if (u.pn < 3) { base = bA; ld = 768; ct = u.pn; } else if (u.pn < 6) { base = bB; ld = 768; ct = u.pn - 3; } else if (u.pn < 8) { base = bC; ld = 512; ct = u.pn - 6; } else { base = G; ld = 3072; ct = u.pn - 8; sg = true; }
        const int col0 = ct * 256 + wc * 32 + 8 * fq;
        const float qs = u.pn == 0 ? 0.125f * LOG2E : 1.0f;
#pragma unroll
        for (int ai = 0; ai < 2; ++ai)
#pragma unroll
            for (int m = 0; m < 4; ++m) { bf16* rp = base + (size_t)(lrow0 + ai * 128 + m * 16) * ld + col0;
#pragma unroll
                for (int bj = 0; bj < 2; ++bj) { f32x4 v0 = acc[ai][bj][m][0] * qs, v1 = acc[ai][bj][m][1] * qs;
                    if (sg) { v0 = (f32x4){fsigm(v0[0]), fsigm(v0[1]), fsigm(v0[2]), fsigm(v0[3])}; v1 = (f32x4){fsigm(v1[0]), fsigm(v1[1]), fsigm(v1[2]), fsigm(v1[3])}; }
                    u32x4 w; w.x = pk2(v0[0], v0[1]); w.y = pk2(v0[2], v0[3]); w.z = pk2(v1[0], v1[1]); w.w = pk2(v1[2], v1[3]);
                    *(u32x4*)(rp + bj * 128) = w; } }
    }
};
struct EpiPlain { EPI_COMMON; static constexpr bool ALIGN = true; EPI_NOMID; bf16* O; int ldc; float scale;
    __device__ __forceinline__ void operator()(const Acc& acc, const Unit& u, int wr, int wc, int fr, int fq) const {
        const int row0 = u.pm * 256 + wr * 64 + fr, col0 = u.pn * 256 + wc * 32 + 8 * fq;
#pragma unroll
        for (int ai = 0; ai < 2; ++ai)
#pragma unroll
            for (int m = 0; m < 4; ++m) { bf16* rp = O + (size_t)(row0 + ai * 128 + m * 16) * ldc + col0;
#pragma unroll
                for (int bj = 0; bj < 2; ++bj) { const f32x4 v0 = acc[ai][bj][m][0] * scale, v1 = acc[ai][bj][m][1] * scale;
                    u32x4 w; w.x = pk2(v0[0], v0[1]); w.y = pk2(v0[2], v0[3]); w.z = pk2(v1[0], v1[1]); w.w = pk2(v1[2], v1[3]);
                    *(u32x4*)(rp + bj * 128) = w; } }
    }
};
struct EpiAda { EPI_COMMON; static constexpr bool ALIGN = true; EPI_NOMID; float* MOD; const float* b_ada;
    __device__ __forceinline__ void operator()(const Acc& acc, const Unit& u, int wr, int wc, int fr, int fq) const {
        if (wr != 0) return;
        const int col0 = u.pn * 256 + wc * 32 + 8 * fq;
        const int layer = u.pn / 36, j0 = col0 - layer * MODW;
#pragma unroll
        for (int m = 0; m < 3; ++m) { const int row = m * 16 + fr; if (row < 33) {
#pragma unroll
            for (int bj = 0; bj < 2; ++bj) { const f32x4 b0 = *(const f32x4*)(b_ada + col0 + bj * 128), b1 = *(const f32x4*)(b_ada + col0 + bj * 128 + 4);
                float* o = MOD + ((size_t)layer * 33 + row) * MODW + j0 + bj * 128;
                *(f32x4*)o = acc[0][bj][m][0] + b0; *(f32x4*)(o + 4) = acc[0][bj][m][1] + b1; } } }
    }
};
struct EpiBranch { EPI_COMMON; static constexpr bool ALIGN = true; static constexpr bool HAS_MID = true; static constexpr int MID1 = 4, MID2 = 12;
    const bf16* G; bf16* Y; int hb;
    __device__ __forceinline__ void mid(Acc& acc, const Unit& u, int tt, int wr, int wc, int fr, int fq) const {
        asm volatile("" : "+v"(fr), "+v"(fq));
        const int lrow0 = ltile(u.pm, hb) * 256 + wr * 64 + fr, col0 = u.pn * 256 + wc * 32 + 8 * fq;
        const int num = tt == 4 ? 0 : D, den = tt == 4 ? D : 2 * D;
#pragma unroll
        for (int ai = 0; ai < 2; ++ai) {
            u32x4 wn[4][2], wd[4][2];
#pragma unroll
            for (int m = 0; m < 4; ++m) { const bf16* gp = G + (size_t)(lrow0 + ai * 128 + m * 16) * 3072 + col0;
#pragma unroll
                for (int bj = 0; bj < 2; ++bj) { wn[m][bj] = *(const u32x4*)(gp + num + bj * 128); wd[m][bj] = *(const u32x4*)(gp + den + bj * 128); } }
            __builtin_amdgcn_sched_barrier(0);
#pragma unroll
            for (int m = 0; m < 4; ++m)
#pragma unroll
                for (int bj = 0; bj < 2; ++bj) { float fn[8], fd[8]; UNPK8(wn[m][bj], fn); UNPK8(wd[m][bj], fd);
#pragma unroll
                    for (int e = 0; e < 8; ++e) { const float r = __builtin_fmaxf(fn[e], 1e-12f) * __builtin_amdgcn_rcpf(__builtin_fmaxf(fd[e], 1e-12f)); acc[ai][bj][m][e >> 2][e & 3] *= r; } }
            asm volatile("" ::: "memory"); }
    }
    __device__ __forceinline__ void operator()(const Acc& acc, const Unit& u, int wr, int wc, int fr, int fq) const {
        const int lrow0 = ltile(u.pm, hb) * 256 + wr * 64 + fr, row0 = u.pm * 256 + wr * 64 + fr, col0 = u.pn * 256 + wc * 32 + 8 * fq;
#pragma unroll
        for (int ai = 0; ai < 2; ++ai) {
            u32x4 wg[4][2];
#pragma unroll
            for (int m = 0; m < 4; ++m)
#pragma unroll
                for (int bj = 0; bj < 2; ++bj) wg[m][bj] = *(const u32x4*)(G + (size_t)(lrow0 + ai * 128 + m * 16) * 3072 + 2 * D + col0 + bj * 128);
            __builtin_amdgcn_sched_barrier(0);
#pragma unroll
            for (int m = 0; m < 4; ++m) { bf16* yp = Y + (size_t)(row0 + ai * 128 + m * 16) * D + col0;
#pragma unroll
                for (int bj = 0; bj < 2; ++bj) { float fg[8]; UNPK8(wg[m][bj], fg);
                    const f32x4 v0 = acc[ai][bj][m][0], v1 = acc[ai][bj][m][1];
                    u32x4 w; w.x = pk2(v0[0] * __builtin_fmaxf(fg[0], 1e-12f), v0[1] * __builtin_fmaxf(fg[1], 1e-12f)); w.y = pk2(v0[2] * __builtin_fmaxf(fg[2], 1e-12f), v0[3] * __builtin_fmaxf(fg[3], 1e-12f));
                    w.z = pk2(v1[0] * __builtin_fmaxf(fg[4], 1e-12f), v1[1] * __builtin_fmaxf(fg[5], 1e-12f)); w.w = pk2(v1[2] * __builtin_fmaxf(fg[6], 1e-12f), v1[3] * __builtin_fmaxf(fg[7], 1e-12f));
                    *(u32x4*)(yp + bj * 128) = w; } } }
    }
};
__device__ __forceinline__ int rope_logical(int p) { return 16 * ((p >> 3) & 1) + 8 * (p >> 4) + (p & 7); }
constexpr int PREP_PER_LAYER = 2 * (16 * 176) + 2 * (44 * 32) + 16 * 160 + 4 * 16 + 2 * 16 + 4 * 32 + 8 * 32 + 4 * 32 + 16 * 32, PREP_ADA = 2 * 16 * 288, PREP_TOTAL = PREP_ADA + 2 * PREP_PER_LAYER;
struct TrDesc { const float* srcp; bf16* dstp; int sstep, dstep; };
__device__ __forceinline__ TrDesc tr_decode(const Params& p, unsigned char* ws, int it, int lane) {
    const float* W0; const float* W1 = nullptr; bf16* dst; int K, ldw, ldd, koff = 0, nrows, kind = 0;
    int r = it;
    if (r < PREP_ADA) { const int L = r / (PREP_ADA / 2); r -= L * (PREP_ADA / 2);
        W0 = p.w_ada + (size_t)L * D * MODW; dst = (bf16*)(ws + WS_WADA) + (size_t)L * MODW * D; K = D; ldw = MODW; ldd = D; nrows = MODW; }
    else { r -= PREP_ADA; const int L = r / PREP_PER_LAYER; r -= L * PREP_PER_LAYER;
        unsigned char* wl = ws + WS_W + (size_t)L * LW_SIZE; bool found = false;
        W0 = nullptr; dst = nullptr; K = 64; ldw = 0; ldd = 0; nrows = 32;
#define TRY_JOB(KIND_, W0_, W1_, K_, LDW_, DST_, LDD_, KOFF_, NROWS_) if (!found) { const int cnt = ((K_) / 64) * ((NROWS_) / 32); if (r < cnt) { found = true; kind = KIND_; W0 = W0_; W1 = W1_; K = K_; ldw = LDW_; dst = (bf16*)(DST_); ldd = LDD_; koff = KOFF_; nrows = NROWS_; } else r -= cnt; }
        TRY_JOB(1, p.f1_wg + (size_t)L * D * DFF, p.f1_wu + (size_t)L * D * DFF, D, DFF, wl + LW_U1, D, 0, 2 * DFF)
        TRY_JOB(0, p.f1_wd + (size_t)L * DFF * D, nullptr, DFF, D, wl + LW_D1, DFF, 0, D)
        TRY_JOB(1, p.f2_wg + (size_t)L * D * DFF, p.f2_wu + (size_t)L * D * DFF, D, DFF, wl + LW_U2, D, 0, 2 * DFF)
        TRY_JOB(0, p.f2_wd + (size_t)L * DFF * D, nullptr, DFF, D, wl + LW_D2, DFF, 0, D)
        TRY_JOB(2, p.w_in + (size_t)L * D * INW, nullptr, D, INW, wl + LW_IN, D, 0, INWP)
        TRY_JOB(3, p.w_uq + (size_t)L * 256 * 384, nullptr, 256, 384, wl + LW_UQ, 256, 0, 512)
        TRY_JOB(0, p.w_ukv + (size_t)L * 128 * 512, nullptr, 128, 512, wl + LW_UKV, 128, 0, 512)
        TRY_JOB(0, p.w_ba + (size_t)L * 256 * D, nullptr, 256, D, wl + LW_BR, D, 0, D)
        TRY_JOB(0, p.w_bb + (size_t)L * 512 * D, nullptr, 512, D, wl + LW_BR, D, 256, D)
        TRY_JOB(0, p.w_bc + (size_t)L * 256 * D, nullptr, 256, D, wl + LW_BR, D, 768, D)
        TRY_JOB(0, p.w_out + (size_t)L * D * D, nullptr, D, D, wl + LW_OUT, D, 0, D)
#undef TRY_JOB
    }
    (void)K;
    const int nblk = nrows / 32, kb = r / nblk, nb = r % nblk, k0 = 64 * kb, n0 = 32 * nb, np = n0 + (lane & 31);
    const float* src = W0; int col = np;
    if (kind == 1) { const int pn = np >> 8, j = np & 255; src = j < 128 ? W0 : W1; col = 128 * pn + (j & 127); }
    else if (kind == 2) { if (np < 1920) col = np; else if (np < 1952) col = 1920 + rope_logical(np - 1920); else if (np < 2048) col = -1; else col = np - 96; }
    else if (kind == 3) { if (np < 384) { const int h = np / 96, j = np % 96; col = j < 64 ? np : 96 * h + 64 + rope_logical(j - 64); } else col = -1; }
    TrDesc d; d.srcp = col >= 0 ? src + (size_t)(k0 + (lane >> 5)) * ldw + col : nullptr; d.sstep = 2 * ldw;
    d.dstp = dst + (size_t)(n0 + (lane >> 3)) * ldd + koff + k0 + 8 * (lane & 7); d.dstep = 8 * ldd;
    return d;
}
#define TR_LOAD(DESC, V) do { _Pragma("unroll") for (int i = 0; i < 32; ++i) V[i] = (DESC).srcp ? (DESC).srcp[(size_t)i * (DESC).sstep] : 0.f; } while (0)
__device__ __forceinline__ void tr_finish(const TrDesc& d, const float (&v)[32], LAS float* scr, int lane) {
#pragma unroll
    for (int i = 0; i < 32; ++i) scr[(2 * i + (lane >> 5)) * 33 + (lane & 31)] = v[i];
    asm volatile("s_waitcnt lgkmcnt(0)" ::: "memory");
    const int c = lane & 7;
#pragma unroll
    for (int j = 0; j < 4; ++j) { const int n = (lane >> 3) + 8 * j; const LAS float* s = scr + (8 * c) * 33 + n;
        u32x4 o; o.x = pk2(s[0 * 33], s[1 * 33]); o.y = pk2(s[2 * 33], s[3 * 33]); o.z = pk2(s[4 * 33], s[5 * 33]); o.w = pk2(s[6 * 33], s[7 * 33]);
        *(u32x4*)(d.dstp + (size_t)j * d.dstep) = o; }
    asm volatile("s_waitcnt lgkmcnt(0)" ::: "memory");
}
__device__ __forceinline__ void prep_phase(const Params& p, LAS unsigned char* lds, int tid, int bid, int nbk, int item_lo, int item_hi, int wg0, bool misc) {
    asm volatile("" : "+v"(tid)); const int lane = tid & 63, wave = __builtin_amdgcn_readfirstlane(tid >> 6);
    LAS float* scr = (LAS float*)(lds + wave * 16384);
    const int gw = (bid - wg0) * 8 + wave, NGW = (nbk - wg0) * 8;
    unsigned char* ws = p.ws;
    if (bid >= wg0 && item_lo + gw < item_hi) {
        TrDesc dc = tr_decode(p, ws, item_lo + gw, lane); float vc[32]; TR_LOAD(dc, vc);
        for (int it = item_lo + gw; it < item_hi; it += NGW) {
            const bool more = it + NGW < item_hi;
            TrDesc dn = dc; float vn[32];
            if (more) { dn = tr_decode(p, ws, it + NGW, lane); TR_LOAD(dn, vn); }
            tr_finish(dc, vc, scr, lane);
            if (more) { dc = dn;
#pragma unroll
                for (int i = 0; i < 32; ++i) vc[i] = vn[i]; }
        }
    }
    bf16* SC = (bf16*)(ws + WS_SC);
    if (misc) for (int i = bid * 512 + tid; i < 256 * D; i += nbk * 512) { const int row = i >> 10, col = i & 1023;
        float v = 0.f; if (row < 32) v = fsilu(p.c[row * D + col]); else if (row == 32) v = fsilu(p.c_ctx[col]);
        SC[i] = (bf16)(pk2(v, 0.f) & 0xffffu); }
}

__device__ __forceinline__ void normmod_phase(const float* xlat, const float* xctx, const float* gain, const float* modl, int sidx, bf16* NBp, int nrows, int tid, int bid, int nbk) {
    asm volatile("" : "+v"(tid)); const int lane = tid & 63, wave = __builtin_amdgcn_readfirstlane(tid >> 6);
    const int gw = bid * 8 + wave, NGW = nbk * 8;
    f32x4 gv[4];
#pragma unroll
    for (int j = 0; j < 4; ++j) gv[j] = *(const f32x4*)(gain + 4 * lane + 256 * j);
    constexpr int R = 3;
    for (int row0 = gw; row0 < nrows; row0 += R * NGW) {
        f32x4 v[R][4]; f32x4 sh[R][4], sc[R][4];
#pragma unroll
        for (int q = 0; q < R; ++q) { const int row = row0 + q * NGW; if (row < nrows) {
            const float* xr = row < ML ? xlat + (size_t)row * D : xctx + (size_t)(row - ML) * D;
#pragma unroll
            for (int j = 0; j < 4; ++j) v[q][j] = *(const f32x4*)(xr + 4 * lane + 256 * j); } }
#pragma unroll
        for (int q = 0; q < R; ++q) { const int row = row0 + q * NGW; if (row < nrows) {
            const float* mr = modl + (size_t)(row < ML ? (row >> 11) : 32) * MODW + sidx * D;
#pragma unroll
            for (int j = 0; j < 4; ++j) { sh[q][j] = *(const f32x4*)(mr + 4 * lane + 256 * j); sc[q][j] = *(const f32x4*)(mr + D + 4 * lane + 256 * j); } } }
#pragma unroll
        for (int q = 0; q < R; ++q) { const int row = row0 + q * NGW; if (row < nrows) {
            float ss = 0.f;
#pragma unroll
            for (int j = 0; j < 4; ++j) ss += (v[q][j].x * v[q][j].x + v[q][j].y * v[q][j].y) + (v[q][j].z * v[q][j].z + v[q][j].w * v[q][j].w);
            const float rstd = 1.0f / sqrtf(wave_sum(ss) * (1.f / D) + EPS);
            u32x2* o = (u32x2*)(NBp + (size_t)row * D) + lane;
#pragma unroll
            for (int j = 0; j < 4; ++j) { const f32x4 n = (v[q][j] * rstd) * gv[j] * (sc[q][j] + 1.0f) + sh[q][j];
                u32x2 w; w.x = pk2(n.x, n.y); w.y = pk2(n.z, n.w); o[64 * j] = w; } } }
    }
}
__device__ __forceinline__ void final_phase(float* out, const float* gain, int tid, int bid, int nbk) {
    asm volatile("" : "+v"(tid)); const int lane = tid & 63, wave = __builtin_amdgcn_readfirstlane(tid >> 6);
    const int gw = bid * 8 + wave, NGW = nbk * 8;
    f32x4 gv[4];
#pragma unroll
    for (int j = 0; j < 4; ++j) gv[j] = *(const f32x4*)(gain + 4 * lane + 256 * j);
    constexpr int R = 3;
    for (int row0 = gw; row0 < ML; row0 += R * NGW) {
        f32x4 v[R][4];
#pragma unroll
        for (int q = 0; q < R; ++q) { const int row = row0 + q * NGW; if (row < ML) {
#pragma unroll
            for (int j = 0; j < 4; ++j) v[q][j] = *(const f32x4*)(out + (size_t)row * D + 4 * lane + 256 * j); } }
#pragma unroll
        for (int q = 0; q < R; ++q) { const int row = row0 + q * NGW; if (row < ML) {
            float ss = 0.f;
#pragma unroll
            for (int j = 0; j < 4; ++j) ss += (v[q][j].x * v[q][j].x + v[q][j].y * v[q][j].y) + (v[q][j].z * v[q][j].z + v[q][j].w * v[q][j].w);
            const float rstd = 1.0f / sqrtf(wave_sum(ss) * (1.f / D) + EPS);
#pragma unroll
            for (int j = 0; j < 4; ++j) *(f32x4*)(out + (size_t)row * D + 4 * lane + 256 * j) = (v[q][j] * rstd) * gv[j]; } }
    }
}

__device__ __forceinline__ void post_phase(bf16* bB, bf16* bC, const float* k_norm, const float* mq_norm, const float* mkv_norm, int tid, int bid, int nbk) {
    asm volatile("" : "+v"(tid)); const int lane = tid & 63, wave = __builtin_amdgcn_readfirstlane(tid >> 6);
    const int gw = bid * 8 + wave, NGW = nbk * 8;
    for (int row = gw; row < HM; row += NGW) {
        const bool lat = row < HL; const int t = row & (SEQ - 1); const float prow = (float)(t >> 6), pcol = (float)(t & 63);
        { bf16* kp = bB + (size_t)row * 768 + 512; const int hd = lane >> 5, a = (lane >> 4) & 1, f = lane & 15; const int d0 = 32 * a + f;
          float x0 = bf2f(kp[hd * 64 + d0]), x1 = bf2f(kp[hd * 64 + d0 + 16]);
          float ss = x0 * x0 + x1 * x1;
          ss = sum32(ss);
          const float rstd = 1.0f / sqrtf(ss * (1.f / 64.f) + EPS);
          x0 = x0 * rstd * k_norm[d0]; x1 = x1 * rstd * k_norm[d0 + 16];
          if (lat) { const float ang = (a ? pcol : prow) * __builtin_amdgcn_exp2f(-(float)f * (13.287712379549449f / 16.f)); const float cs = __cosf(ang), sn = __sinf(ang);
              const float y0 = x0 * cs - x1 * sn, y1 = x1 * cs + x0 * sn; x0 = y0; x1 = y1; }
          kp[hd * 64 + d0] = (bf16)(pk2(x0, 0.f) & 0xffffu); kp[hd * 64 + d0 + 16] = (bf16)(pk2(x1, 0.f) & 0xffffu); }
        { bf16* cp = bC + (size_t)row * 512; const u32x2 w = *(const u32x2*)(cp + 4 * lane);
          float x[4] = {bf2f(w.x & 0xffffu), __uint_as_float(w.x & 0xffff0000u), bf2f(w.y & 0xffffu), __uint_as_float(w.y & 0xffff0000u)};
          const float rstd = 1.0f / sqrtf(wave_sum((x[0] * x[0] + x[1] * x[1]) + (x[2] * x[2] + x[3] * x[3])) * (1.f / 256.f) + EPS);
          const f32x4 g = *(const f32x4*)(mq_norm + 4 * lane);
          u32x2 o; o.x = pk2(x[0] * rstd * g.x, x[1] * rstd * g.y); o.y = pk2(x[2] * rstd * g.z, x[3] * rstd * g.w); *(u32x2*)(cp + 4 * lane) = o; }
        { bf16* cp = bC + (size_t)row * 512 + 256; const unsigned w = *(const unsigned*)(cp + 2 * lane);
          const float x0 = bf2f(w & 0xffffu), x1 = __uint_as_float(w & 0xffff0000u);
          const float rstd = 1.0f / sqrtf(wave_sum(x0 * x0 + x1 * x1) * (1.f / 128.f) + EPS);
          *(unsigned*)(cp + 2 * lane) = pk2(x0 * rstd * mkv_norm[2 * lane], x1 * rstd * mkv_norm[2 * lane + 1]); }
        if (lat && lane < 16) { bf16* rp = bC + (size_t)row * 512 + 384; const int a = lane >> 3, f = lane & 7;
          const float x0 = bf2f(rp[8 * a + f]), x1 = bf2f(rp[16 + 8 * a + f]);
          const float ang = (a ? pcol : prow) * __builtin_amdgcn_exp2f(-(float)f * (13.287712379549449f / 8.f)); const float cs = __cosf(ang), sn = __sinf(ang);
          rp[8 * a + f] = (bf16)(pk2(x0 * cs - x1 * sn, 0.f) & 0xffffu); rp[16 + 8 * a + f] = (bf16)(pk2(x1 * cs + x0 * sn, 0.f) & 0xffffu); }
    }
}
constexpr int KTP = 208, KTB = 64 * KTP, VTP = 144, VTB = 64 * VTP;
constexpr int A_KT = 0, A_VT = 2 * KTB, A_BIAS = A_VT + 3 * VTB, A_END = A_BIAS + 480 * 4;
struct AttnArgs { const bf16* bA; const bf16* bB; const bf16* bC; const bf16* MQ; const bf16* MKV; bf16* OB; const float* q_norm; const float* na_bias; int hb; int with_ctx_q; };
__device__ __forceinline__ int crow(int r, int hi) { return (r & 3) + 8 * (r >> 2) + 4 * hi; }
__device__ __forceinline__ int na_r0(int r) { const int v = r - 4; return v < 0 ? 0 : (v > 24 ? 24 : v); }


template <int QD> __device__ __forceinline__ void attn_tile(const bf16x8 (&qf)[QD], bool& fresh, f32x16& negm, float& m2, float& lsum, f32x16& o0, f32x16& o1, const LAS unsigned char* kb, const LAS unsigned char* vb,
                                                           bool local, const LAS float* bt, int c0, int hi) {
    bf16x8 k0[QD], k1[QD];
#pragma unroll
    for (int d0 = 0; d0 < QD; ++d0) { k0[d0] = *(const LAS bf16x8*)(kb + d0 * 32); k1[d0] = *(const LAS bf16x8*)(kb + 32 * KTP + d0 * 32); }
    bf16x8 vfa[4], vfc[4];
#pragma unroll
    for (int j4 = 0; j4 < 4; ++j4) { vfa[j4] = *(const LAS bf16x8*)(vb + j4 * 32); vfc[j4] = *(const LAS bf16x8*)(vb + 32 * VTP + j4 * 32); }
    __builtin_amdgcn_sched_barrier(0);
    f32x16 s0, s1;
    s0 = __builtin_amdgcn_mfma_f32_32x32x16_bf16(k0[0], qf[0], negm, 0, 0, 0); s1 = __builtin_amdgcn_mfma_f32_32x32x16_bf16(k1[0], qf[0], negm, 0, 0, 0);
#pragma unroll
    for (int d0 = 1; d0 < QD; ++d0) { s0 = __builtin_amdgcn_mfma_f32_32x32x16_bf16(k0[d0], qf[d0], s0, 0, 0, 0); s1 = __builtin_amdgcn_mfma_f32_32x32x16_bf16(k1[d0], qf[d0], s1, 0, 0, 0); }
    if (local) {
        int base = 4 * hi - c0; asm volatile("" : "+v"(base));
        const LAS float* btl = bt + 4 * hi;
#pragma unroll
        for (int r = 0; r < 16; ++r) { const int cr = (r & 3) + 8 * (r >> 2);
            s0[r] = ((unsigned)(cr + base) < 16u) ? s0[r] + btl[cr] : -1e30f;
            s1[r] = ((unsigned)(cr + 32 + base) < 16u) ? s1[r] + btl[cr + 32] : -1e30f; }
    }
    float tmax;
    { float a = __builtin_fmaxf(s0[0], s1[0]), b = __builtin_fmaxf(s0[1], s1[1]);
#pragma unroll
      for (int r = 2; r < 16; r += 2) { a = __builtin_fmaxf(__builtin_fmaxf(a, s0[r]), s1[r]); b = __builtin_fmaxf(__builtin_fmaxf(b, s0[r + 1]), s1[r + 1]); }
      tmax = half_max(__builtin_fmaxf(a, b)); }
    if (fresh || __any(tmax > 8.0f)) {
        const float dl = fresh ? tmax : __builtin_fmaxf(tmax, 0.f); m2 += dl; fresh = false;
#pragma unroll
        for (int r = 0; r < 16; ++r) { s0[r] -= dl; s1[r] -= dl; negm[r] = -m2; }
        const float al = __builtin_amdgcn_exp2f(-dl); lsum *= al;
#pragma unroll
        for (int r = 0; r < 16; ++r) { o0[r] *= al; o1[r] *= al; } }
    float ps0 = 0.f, ps1 = 0.f;
#pragma unroll
    for (int r = 0; r < 16; ++r) { s0[r] = __builtin_amdgcn_exp2f(s0[r]); s1[r] = __builtin_amdgcn_exp2f(s1[r]); ps0 += s0[r]; ps1 += s1[r]; }
    lsum += ps0 + ps1;
    bf16x8 pb[4];
    { u32x4 w;
      w.x = pk2(s0[0], s0[1]); w.y = pk2(s0[2], s0[3]); w.z = pk2(s0[4], s0[5]); w.w = pk2(s0[6], s0[7]); pb[0] = __builtin_bit_cast(bf16x8, w);
      w.x = pk2(s0[8], s0[9]); w.y = pk2(s0[10], s0[11]); w.z = pk2(s0[12], s0[13]); w.w = pk2(s0[14], s0[15]); pb[1] = __builtin_bit_cast(bf16x8, w);
      w.x = pk2(s1[0], s1[1]); w.y = pk2(s1[2], s1[3]); w.z = pk2(s1[4], s1[5]); w.w = pk2(s1[6], s1[7]); pb[2] = __builtin_bit_cast(bf16x8, w);
      w.x = pk2(s1[8], s1[9]); w.y = pk2(s1[10], s1[11]); w.z = pk2(s1[12], s1[13]); w.w = pk2(s1[14], s1[15]); pb[3] = __builtin_bit_cast(bf16x8, w); }
#pragma unroll
    for (int j4 = 0; j4 < 4; ++j4) {
        o0 = __builtin_amdgcn_mfma_f32_32x32x16_bf16(vfa[j4], pb[j4], o0, 0, 0, 0);
        o1 = __builtin_amdgcn_mfma_f32_32x32x16_bf16(vfc[j4], pb[j4], o1, 0, 0, 0); }
}

template <int TYPE  >
__device__ __forceinline__ void attn_unit(const AttnArgs& a, int bl, int head, int qb  , LAS unsigned char* lds, int tid) {
    constexpr int QD = TYPE == 2 ? 6 : 4;
    asm volatile("" : "+v"(tid));
    const int lane = tid & 63, wid = __builtin_amdgcn_readfirstlane(tid >> 6), q32 = lane & 31, hi = lane >> 5;
    const bool isctx = qb < 0;
    const int lat_row0 = bl * SEQ, ctx_row0 = HL + bl * CTXL;
    const bf16* Qb; const bf16* Kb; const bf16* Vb; int qp, kp, vp, ocol; float scale;
    if (TYPE == 0) { Qb = a.bA + 64 * head; Kb = a.bA + 256 + 64 * head; Vb = a.bA + 512 + 64 * head; qp = kp = vp = 768; ocol = 64 * head; scale = 0.125f; }
    else if (TYPE == 1) { Qb = a.bB + 64 * head; Kb = a.bB + 512 + 64 * (head >> 2); Vb = a.bB + 640 + 64 * (head >> 2); qp = kp = vp = 768; ocol = 256 + 64 * head; scale = 0.125f; }
    else { Qb = a.MQ + 96 * head; Kb = a.MKV + 128 * head; Vb = a.MKV + 128 * head + 64; qp = kp = vp = 512; ocol = 768 + 64 * head; scale = 0.10206207261596575f; }
    const float sc2 = scale * LOG2E;
    int nfirst, first_base, kr_lo = 0;
    if (isctx) { nfirst = 0; first_base = 0; }
    else if (TYPE == 0) { kr_lo = na_r0(4 * qb); const int kr_hi = na_r0(4 * qb + 3) + 7; nfirst = kr_hi - kr_lo + 1; first_base = lat_row0 + 64 * kr_lo; }
    else { nfirst = 32; first_base = lat_row0; }
    const int NT = nfirst + 4;
#define TILE_ROW(j) ((j) < nfirst ? first_base + 64 * (j) : ctx_row0 + 64 * ((j) - nfirst))
    const int krow = tid >> 3, kc = tid & 7, k2row = tid >> 2, k2c = tid & 3;
    u32x4 kA, vA, k2A = (u32x4){0u, 0u, 0u, 0u}, kB, vB, k2B = (u32x4){0u, 0u, 0u, 0u};
#define LOAD_TILE(j, kreg, vreg, k2reg) do { const int rb_ = TILE_ROW(j); kreg = *(const u32x4*)(Kb + (size_t)(rb_ + krow) * kp + 8 * kc); vreg = *(const u32x4*)(Vb + (size_t)(rb_ + krow) * vp + 8 * kc); \
        if (TYPE == 2 && tid < 256) k2reg = *(const u32x4*)(a.bC + (size_t)(rb_ + k2row) * 512 + 384 + 8 * k2c); } while (0)
#define STORE_TILE(buf, vbuf, kreg, vreg, k2reg) do { *(LAS u32x4*)(lds + A_KT + (buf) * KTB + krow * KTP + kc * 16) = kreg; \
        if (TYPE == 2 && tid < 256) *(LAS u32x4*)(lds + A_KT + (buf) * KTB + k2row * KTP + 128 + k2c * 16) = k2reg; \
          \
        { const bool odd_ = krow & 1; \
          const unsigned snd0_ = odd_ ? vreg.x : vreg.z, snd1_ = odd_ ? vreg.y : vreg.w;             \
          const unsigned rcv0_ = (unsigned)__builtin_amdgcn_ds_swizzle((int)snd0_, (8 << 10) | 0x1f), rcv1_ = (unsigned)__builtin_amdgcn_ds_swizzle((int)snd1_, (8 << 10) | 0x1f); \
          const unsigned ev0_ = odd_ ? rcv0_ : vreg.x, ev1_ = odd_ ? rcv1_ : vreg.y, od0_ = odd_ ? vreg.z : rcv0_, od1_ = odd_ ? vreg.w : rcv1_;     \
          const int kvp_ = (krow & 0x30) | ((krow & 4) << 1) | ((krow & 8) >> 1) | (krow & 2);        \
          LAS unsigned* vt_ = (LAS unsigned*)(lds + A_VT + (vbuf) * VTB + (8 * kc + 4 * (krow & 1)) * VTP + kvp_ * 2); \
          vt_[0 * (VTP / 4)] = __builtin_amdgcn_perm(od0_, ev0_, 0x05040100u); vt_[1 * (VTP / 4)] = __builtin_amdgcn_perm(od0_, ev0_, 0x07060302u); \
          vt_[2 * (VTP / 4)] = __builtin_amdgcn_perm(od1_, ev1_, 0x05040100u); vt_[3 * (VTP / 4)] = __builtin_amdgcn_perm(od1_, ev1_, 0x07060302u); } } while (0)
    LOAD_TILE(0, kA, vA, k2A);
    if (TYPE == 0 && !isctx) { if (tid < 465) ((LAS float*)(lds + A_BIAS))[tid] = a.na_bias[head * 465 + tid] * LOG2E; }
    const int qloc = 32 * wid + q32;
    const int qrow_l = isctx ? ctx_row0 + qloc : lat_row0 + 256 * qb + qloc;
    const size_t orow_p = isctx ? (size_t)ML + (size_t)(a.hb * BPH + bl) * CTXL + qloc : (size_t)(a.hb * BPH + bl) * SEQ + 256 * qb + qloc;
    bf16x8 qf[QD];
    {
        u32x4 qw[QD];
#pragma unroll
        for (int d0 = 0; d0 < QD; ++d0) qw[d0] = *(const u32x4*)(Qb + (size_t)qrow_l * qp + 16 * d0 + 8 * hi);
        if (TYPE == 1) {
            float x[4][8]; float ss = 0.f;
#pragma unroll
            for (int d0 = 0; d0 < 4; ++d0) { UNPK8(qw[d0], x[d0]);
#pragma unroll
                for (int i = 0; i < 8; ++i) ss += x[d0][i] * x[d0][i]; }
            ss = half_sum(ss);
            const float rstd = sc2 / sqrtf(ss * (1.f / 64.f) + EPS);
#pragma unroll
            for (int d0 = 0; d0 < 4; ++d0) { const f32x4 g0 = *(const f32x4*)(a.q_norm + 16 * d0 + 8 * hi), g1 = *(const f32x4*)(a.q_norm + 16 * d0 + 8 * hi + 4);
#pragma unroll
                for (int i = 0; i < 4; ++i) { x[d0][i] *= rstd * g0[i]; x[d0][4 + i] *= rstd * g1[i]; } }
            if (!isctx) { const int t = 256 * qb + qloc; const float prow = (float)(t >> 6), pcol = (float)(t & 63);
#pragma unroll
                for (int i = 0; i < 8; ++i) { const float fr_ = __builtin_amdgcn_exp2f(-(float)(8 * hi + i) * (13.287712379549449f / 16.f));
                    { const float ang = prow * fr_, cs = __cosf(ang), sn = __sinf(ang), y0 = x[0][i] * cs - x[1][i] * sn, y1 = x[1][i] * cs + x[0][i] * sn; x[0][i] = y0; x[1][i] = y1; }
                    { const float ang = pcol * fr_, cs = __cosf(ang), sn = __sinf(ang), y0 = x[2][i] * cs - x[3][i] * sn, y1 = x[3][i] * cs + x[2][i] * sn; x[2][i] = y0; x[3][i] = y1; } } }
#pragma unroll
            for (int d0 = 0; d0 < 4; ++d0) { qw[d0].x = pk2(x[d0][0], x[d0][1]); qw[d0].y = pk2(x[d0][2], x[d0][3]); qw[d0].z = pk2(x[d0][4], x[d0][5]); qw[d0].w = pk2(x[d0][6], x[d0][7]); }
        }
        if (TYPE == 2 && !isctx) {
            float x0[8], x1[8]; UNPK8(qw[4], x0); UNPK8(qw[5], x1);
            const int t = 256 * qb + qloc; const float pos = hi ? (float)(t & 63) : (float)(t >> 6);
#pragma unroll
            for (int i = 0; i < 8; ++i) { const float ang = pos * __builtin_amdgcn_exp2f(-(float)i * (13.287712379549449f / 8.f)), cs = __cosf(ang), sn = __sinf(ang);
                const float y0 = x0[i] * cs - x1[i] * sn, y1 = x1[i] * cs + x0[i] * sn; x0[i] = y0; x1[i] = y1; }
            qw[4].x = pk2(x0[0], x0[1]); qw[4].y = pk2(x0[2], x0[3]); qw[4].z = pk2(x0[4], x0[5]); qw[4].w = pk2(x0[6], x0[7]);
            qw[5].x = pk2(x1[0], x1[1]); qw[5].y = pk2(x1[2], x1[3]); qw[5].z = pk2(x1[4], x1[5]); qw[5].w = pk2(x1[6], x1[7]);
        }
#pragma unroll
        for (int d0 = 0; d0 < QD; ++d0) qf[d0] = __builtin_bit_cast(bf16x8, qw[d0]);
    }
    STORE_TILE(0, 0, kA, vA, k2A);
    if (NT > 1) LOAD_TILE(1, kA, vA, k2A);
    if (NT > 2) LOAD_TILE(2, kB, vB, k2B);
    __syncthreads();
    const int na_r = 4 * qb + (wid >> 1), na_w0 = na_r0(na_r), qc = 32 * (wid & 1) + q32;
    const int c0 = (qc - 8) < 0 ? 0 : ((qc - 8) > 48 ? 48 : (qc - 8));
    bool fresh = true; float m2 = 0.f, lsum = 0.f; f32x16 o0 = {}, o1 = {}, negm = {};
#define ATT_COMPUTE(IT) do { bool act_c = true; const bool local = (TYPE == 0) && ((IT) < nfirst); \
        if (local) { const int kr = kr_lo + (IT); act_c = (kr >= na_w0) && (kr < na_w0 + 8); } \
        if (act_c) attn_tile<QD>(qf, fresh, negm, m2, lsum, o0, o1, lds + A_KT + ((IT) & 1) * KTB + q32 * KTP + hi * 16, lds + A_VT + ((IT) & 1) * VTB + q32 * VTP + hi * 16, \
                                 local, (const LAS float*)(lds + A_BIAS) + (kr_lo + (IT) - na_r + 7) * 31 + 15 - qc, c0, hi); } while (0)
    for (int it = 0; it < NT; it += 2) {
        ATT_COMPUTE(it);
        if (it + 1 < NT) STORE_TILE(1, 1, kA, vA, k2A);
        if (it + 3 < NT) LOAD_TILE(it + 3, kA, vA, k2A);
        __syncthreads();
        if (it + 1 < NT) {
            ATT_COMPUTE(it + 1);
            if (it + 2 < NT) STORE_TILE(0, 0, kB, vB, k2B);
            if (it + 4 < NT) LOAD_TILE(it + 4, kB, vB, k2B);
            __syncthreads();
        }
    }
#undef ATT_COMPUTE
    lsum = half_sum(lsum);
    const float inv = 1.0f / lsum;
    bf16* op = a.OB + orow_p * D + ocol + 4 * hi;
#pragma unroll
    for (int g = 0; g < 4; ++g) { u32x2 w;
        w.x = pk2(o0[4 * g] * inv, o0[4 * g + 1] * inv); w.y = pk2(o0[4 * g + 2] * inv, o0[4 * g + 3] * inv); *(u32x2*)(op + 8 * g) = w;
        w.x = pk2(o1[4 * g] * inv, o1[4 * g + 1] * inv); w.y = pk2(o1[4 * g + 2] * inv, o1[4 * g + 3] * inv); *(u32x2*)(op + 32 + 8 * g) = w; }
#undef TILE_ROW
#undef LOAD_TILE
#undef STORE_TILE
}
__device__ __forceinline__ void attn_phase(const AttnArgs& a, LAS unsigned char* lds, int tid, int bid, int nbk) {
    const int nunits = 2048 + (a.with_ctx_q ? 256 : 0);
    for (int u = bid; u < nunits; u += nbk) {
        const int rnd = u >> 8, blk = u & 255, x = blk & 7, y = blk >> 3;
        int type, bl, head, qb;
        if (rnd < 4) { const int g = 4 * x + rnd; type = 1; bl = g >> 1; head = 4 * (g & 1) + (y >> 3); qb = y & 7; }
        else if (rnd < 8) { const int g = ((rnd - 4) & 1) * 32 + 4 * x + (y >> 3); type = rnd < 6 ? 2 : 0; bl = g >> 2; head = g & 3; qb = y & 7; }
        else { const int h16 = blk & 15; bl = blk >> 4; qb = -1; if (h16 < 4) { type = 0; head = h16; } else if (h16 < 12) { type = 1; head = h16 - 4; } else { type = 2; head = h16 - 12; } }
        if (type == 1) attn_unit<1>(a, bl, head, qb, lds, tid); else if (type == 2) attn_unit<2>(a, bl, head, qb, lds, tid); else attn_unit<0>(a, bl, head, qb, lds, tid);
    }
}
constexpr size_t WS_CTL = 0, CTL_ZERO_BYTES = 16384;
#define XB_TMO      128
#define XB_XCNT(j)  (256  + 64 * (j))
#define XB_XSUB(j)  (1280 + 64 * (j))
#define XB_XGEN(j)  (2304 + 64 * (j))
#define XB_TOP      3328
#define XB_TOPGEN   3392
#define XCD_BAR_WORDS 3456
#define XB_SPIN_CAP (1u << 18)

__device__ __forceinline__ unsigned xb_ld(unsigned* p)              { return __hip_atomic_load(p, __ATOMIC_RELAXED, __HIP_MEMORY_SCOPE_AGENT); }
__device__ __forceinline__ unsigned xb_add(unsigned* p, unsigned v) { return __hip_atomic_fetch_add(p, v, __ATOMIC_RELAXED, __HIP_MEMORY_SCOPE_AGENT); }
__device__ __forceinline__ unsigned xb_xcc_id() { return (unsigned)__builtin_amdgcn_s_getreg((3 << 11) | 20) & 0xFu; }
#define XB_SPIN(cond, bar) do { unsigned _sp = 0; while (cond) { __builtin_amdgcn_s_sleep(1); \
    if ((++_sp & 255u) == 0u) { if (xb_ld(&(bar)[XB_TMO])) break; if (_sp > XB_SPIN_CAP) { atomicAdd(&(bar)[XB_TMO], 1u); break; } } } } while (0)

struct XcdBarrier {
    unsigned* bar; unsigned x;
    volatile LAS unsigned* st;
};

__device__ __forceinline__ XcdBarrier xcd_barrier_post(unsigned* bar, volatile LAS unsigned* st) {
    XcdBarrier b; b.bar = bar; b.x = xb_xcc_id(); b.st = st;
    if (threadIdx.x == 0) (void)xb_add(&bar[XB_XCNT(b.x)], 1u);
    return b;
}
__device__ __forceinline__ void xcd_barrier_complete(unsigned* bar, unsigned x, unsigned& nloc, unsigned& nx) {
    const unsigned G = gridDim.x * gridDim.y * gridDim.z;
    unsigned sum, cnt, mine, sp = 0u;
    for (;;) {
        sum = 0u; cnt = 0u; mine = 0u;
#pragma unroll
        for (unsigned j = 0; j < 16; ++j) { const unsigned c = xb_ld(&bar[XB_XCNT(j)]); sum += c; cnt += (c > 0u) ? 1u : 0u; mine = (j == x) ? c : mine; }
        if (sum == G) break;
        __builtin_amdgcn_s_sleep(1);
        if ((++sp & 255u) == 0u) { if (xb_ld(&bar[XB_TMO])) break; if (sp > XB_SPIN_CAP) { atomicAdd(&bar[XB_TMO], 1u); break; } }
    }
    nloc = mine > 0u ? mine : 1u; nx = cnt > 0u ? cnt : 1u;
}

__device__ __forceinline__ void xcd_barrier(const XcdBarrier& b) {
    asm volatile("s_waitcnt vmcnt(0)" ::: "memory");
    __syncthreads();
    if (threadIdx.x == 0) {
        unsigned* bar = b.bar;
        __builtin_amdgcn_s_waitcnt(0);
        unsigned nloc = b.st[0], nx = b.st[1];
        if (nloc == 0u) { xcd_barrier_complete(bar, b.x, nloc, nx); b.st[0] = nloc; b.st[1] = nx; }
        const unsigned old = xb_add(&bar[XB_XSUB(b.x)], 1u);
        const unsigned gen = old / nloc;
        if (old + 1u == (gen + 1u) * nloc) {
            __builtin_amdgcn_fence(__ATOMIC_RELEASE, "agent");
            asm volatile("s_waitcnt vmcnt(0)" ::: "memory");
            const unsigned og = xb_add(&bar[XB_TOP], 1u);
            const unsigned tg = og / nx;
            if (og + 1u == (tg + 1u) * nx) xb_add(&bar[XB_TOPGEN], 1u);
            else XB_SPIN(xb_ld(&bar[XB_TOPGEN]) == tg, bar);
            __builtin_amdgcn_fence(__ATOMIC_ACQUIRE, "agent");
            xb_add(&bar[XB_XGEN(b.x)], 1u);
            asm volatile("s_waitcnt vmcnt(0)" ::: "memory");
        } else {
            XB_SPIN(xb_ld(&bar[XB_XGEN(b.x)]) == gen, bar);
            __builtin_amdgcn_fence(__ATOMIC_ACQUIRE, "agent");
            asm volatile("s_waitcnt vmcnt(0)" ::: "memory");
        }
    }
    __syncthreads();
}
constexpr int XB_LDS_OFF = pg8::STAGE_BYTES, LDS_BYTES = pg8::STAGE_BYTES + 64;
static_assert(A_END <= pg8::STAGE_BYTES && XCD_BAR_WORDS * 4 <= (int)CTL_ZERO_BYTES && CTL_ZERO_BYTES <= WS_SC, "LDS / ctl map");
#define GEMM_RUN(EPI_T, E, APTR, LDA, BPTR, LDB, KK, NN, NL, NC, LAT0, CTX0) do { const pg8::Gemm g_{(const bf16*)(APTR), (const bf16*)(BPTR), (LDA), (LDB), (KK)}; \
    MapOrder S_; S_.init((NL), (NC), (LAT0), (CTX0), (NN), nbk, bid); pg8::gemm_phase<EPI_T, MapOrder, EPI_T::ALIGN, true>(lds, g_, S_, E, tid); } while (0)
constexpr int PH_PER_LAYER = 4 + 5 * NCH + 4, PH_TOTAL = 2 + DEPTH * PH_PER_LAYER + 1;

__global__ void __launch_bounds__(512, 2) mega_fwd(Params p_unused) {
#if defined(__HIP_DEVICE_COMPILE__)
    extern __shared__ __attribute__((aligned(16))) unsigned char lds_raw[];
    LAS unsigned char* lds = (LAS unsigned char*)lds_raw;
    cg::grid_group grid = cg::this_grid();
    typedef const __attribute__((address_space(4))) Params* KP;
    const int wave_s = __builtin_amdgcn_readfirstlane(threadIdx.x >> 6);
    if (threadIdx.x < 16) ((LAS unsigned*)(lds + XB_LDS_OFF))[threadIdx.x] = 0u;
    __syncthreads();
    { KP pp0 = (KP)__builtin_amdgcn_kernarg_segment_ptr(); (void)xcd_barrier_post((unsigned*)(pp0->ws + WS_CTL), (volatile LAS unsigned*)(lds + XB_LDS_OFF)); }
#ifndef PROBE_KIND
#define PROBE_KIND -1
#endif
#ifndef PROBE_SYNCS
#define PROBE_SYNCS 0
#endif
    for (int ph2 = 0; ph2 < PH_TOTAL * 2; ++ph2) {
        const int ph = ph2 >> 1;
        if (ph2 & 1) { bool rep = false;
            if (PROBE_KIND >= 0 && ph >= 2 && ph < PH_TOTAL - 1) { const int st_ = (ph - 2) % PH_PER_LAYER; int k_;
                if (st_ < 3) k_ = st_; else if (st_ == 3) k_ = 0; else if (st_ < 4 + 5 * NCH) k_ = 3 + (st_ - 4) % 5; else if (st_ == 4 + 5 * NCH) k_ = 8; else k_ = st_ - (5 + 5 * NCH);
                rep = (k_ == PROBE_KIND); }
            if (PROBE_KIND == 12) rep = (ph == 4);
            if (PROBE_KIND == 13) rep = (ph == 0);
            if (!rep) continue; }
        int lane_, wv_ = wave_s, bid = blockIdx.x, nbk = gridDim.x; KP pp = (KP)__builtin_amdgcn_kernarg_segment_ptr();
        asm volatile("v_mbcnt_lo_u32_b32 %0, -1, 0\n\tv_mbcnt_hi_u32_b32 %0, -1, %0" : "=v"(lane_));
        asm volatile("" : "+s"(wv_), "+s"(bid), "+s"(nbk), "+s"(pp));
        int tid = wv_ * 64 + lane_; asm volatile("" : "+v"(tid));
        unsigned char* ws = pp->ws;
        float* MOD = (float*)(ws + WS_MOD); float* CTXRES = (float*)(ws + WS_CTXRES);
        bf16* NBp = (bf16*)(ws + WS_NB);
        if (ph == 0) { { const Params p = *pp; prep_phase(p, lds, tid, bid, nbk, 0, PREP_ADA + PREP_PER_LAYER, 0, true); } __syncthreads(); }
        else if (ph == 1) { EpiAda E; E.MOD = MOD; E.b_ada = pp->b_ada; GEMM_RUN(EpiAda, E, ws + WS_SC, D, ws + WS_WADA, D, D, 2 * MODW, 1, 0, 0, 0); }
        else if (ph == PH_TOTAL - 1) { final_phase(pp->out, pp->final_norm, tid, bid, nbk); }
        else {
            const int L = (ph - 2) / PH_PER_LAYER, st = (ph - 2) % PH_PER_LAYER;
            const bool last = (L == DEPTH - 1);
            const float* modl = MOD + (size_t)L * 33 * MODW;
            const unsigned char* wl = ws + WS_W + (size_t)L * LW_SIZE;
            int kind, which = 0, hb = 0;
            if (st < 3) { kind = st; which = 0; }
            else if (st == 3) { kind = 0; which = 1; }
            else if (st < 4 + 5 * NCH) { hb = (st - 4) / 5; kind = 3 + (st - 4) % 5; }
            else if (st == 4 + 5 * NCH) { kind = 8; }
            else { kind = st - (5 + 5 * NCH); which = 2; }
            const bool first_in = (L == 0 && which == 0);
            const float* xl = first_in ? pp->x : pp->out; const float* xc = first_in ? pp->ctx : CTXRES;
            const int nctx = (last && (which == 2 || kind >= 7)) ? 0 : 32;
            if (kind == 0) {
                const float* gain = (which == 0 ? pp->f1_norm : which == 1 ? pp->mix_norm : pp->f2_norm) + L * D;
                normmod_phase(xl, xc, gain, modl, 3 * which, NBp, nctx ? MT : ML, tid, bid, nbk);
            } else if (kind == 1) {
                EpiSwiGLU E; E.H = (bf16*)(ws + WS_H);
                GEMM_RUN(EpiSwiGLU, E, NBp, D, wl + (which == 0 ? LW_U1 : LW_U2), D, D, 2 * DFF, 256, nctx, 0, 256);
            } else if (kind == 2) {
                EpiResid E; E.src_lat = xl; E.src_ctx = xc; E.dst_lat = pp->out; E.dst_ctx = CTXRES; E.modl = modl; E.gidx = which == 0 ? 2 : 8; E.coef = 0.5f;
                GEMM_RUN(EpiResid, E, ws + WS_H, DFF, wl + (which == 0 ? LW_D1 : LW_D2), DFF, DFF, D, 256, nctx, 0, 256);
                if (L == 0 && DEPTH > 1) { const int lo_ = PREP_ADA + PREP_PER_LAYER + (which == 0 ? 0 : PREP_PER_LAYER / 2), hi_ = PREP_ADA + PREP_PER_LAYER + (which == 0 ? PREP_PER_LAYER / 2 : PREP_PER_LAYER);
                    __syncthreads(); const Params p = *pp; prep_phase(p, lds, tid, bid, nbk, lo_, hi_, nbk / 2, false); __syncthreads(); }
            } else if (kind == 8) {
                EpiResid E; E.src_lat = pp->out; E.src_ctx = CTXRES; E.dst_lat = pp->out; E.dst_ctx = CTXRES; E.modl = modl; E.gidx = 5; E.coef = 1.0f;
                GEMM_RUN(EpiResid, E, ws + WS_Y, D, wl + LW_OUT, D, D, D, 256, nctx, 0, 256);
            } else if (kind == 3) {
                EpiWin E; E.bA = (bf16*)(ws + WS_BA); E.bB = (bf16*)(ws + WS_BB); E.bC = (bf16*)(ws + WS_BC); E.G = (bf16*)(ws + WS_G); E.hb = hb;
                if (!last) { GEMM_RUN(EpiWin, E, NBp, D, wl + LW_IN, D, D, INWP, HL / 256, HC / 256, (HL / 256) * hb, 256 + (HC / 256) * hb); }
                else {
                    GEMM_RUN(EpiWin, E, NBp, D, wl + LW_IN, D, D, INWP, HL / 256, 0, (HL / 256) * hb, 0);
                    { const pg8::Gemm g_{(const bf16*)NBp, (const bf16*)(wl + LW_IN), D, D, D}; MapOrder S_; S_.init(0, HC / 256, 0, 256 + (HC / 256) * hb, 4 * 256, nbk, (bid + nbk / 2) % nbk); S_.cmap = 0x7521ull;
                      pg8::gemm_phase<EpiWin, MapOrder, EpiWin::ALIGN, true>(lds, g_, S_, E, tid); } }
            } else if (kind == 4) {
                post_phase((bf16*)(ws + WS_BB), (bf16*)(ws + WS_BC), pp->k_norm + L * 64, pp->mq_norm + L * 256, pp->mkv_norm + L * 128, tid, bid, nbk);
            } else if (kind == 5) {
                for (int s = 0; s < 2; ++s) { EpiPlain E; E.O = (bf16*)(ws + (s ? WS_MKV : WS_MQ)); E.ldc = 512; E.scale = s ? 1.0f : 0.10206207261596575f * LOG2E;
                    GEMM_RUN(EpiPlain, E, (bf16*)(ws + WS_BC) + (s ? 256 : 0), 512, wl + (s ? LW_UKV : LW_UQ), s ? 128 : 256, s ? 128 : 256, 512, HM / 256, 0, 0, 0); }
            } else if (kind == 6) {
                AttnArgs a; a.bA = (const bf16*)(ws + WS_BA); a.bB = (const bf16*)(ws + WS_BB); a.bC = (const bf16*)(ws + WS_BC); a.MQ = (const bf16*)(ws + WS_MQ); a.MKV = (const bf16*)(ws + WS_MKV); a.OB = NBp;
                a.q_norm = pp->q_norm + L * 64; a.na_bias = pp->na_bias + (size_t)L * 4 * 465; a.hb = hb; a.with_ctx_q = last ? 0 : 1;
                attn_phase(a, lds, tid, bid, nbk);
            } else {
                EpiBranch E; E.G = (const bf16*)(ws + WS_G); E.Y = (bf16*)(ws + WS_Y); E.hb = hb;
                GEMM_RUN(EpiBranch, E, NBp, D, wl + LW_BR, D, D, D, HL / 256, nctx ? HC / 256 : 0, (HL / 256) * hb, 256 + (HC / 256) * hb);
            }
        }
        if (ph + 1 < PH_TOTAL) {
            if (ph == 0) grid.sync();
            else { XcdBarrier xb_; xb_.bar = (unsigned*)(pp->ws + WS_CTL); xb_.x = xb_xcc_id(); xb_.st = (volatile LAS unsigned*)(lds + XB_LDS_OFF); xcd_barrier(xb_); }
            for (int e_ = 0; e_ < PROBE_SYNCS; ++e_) grid.sync(); }
    }
#endif
}

extern "C" void kernel_launch(void* const* d_in, const int* in_sizes, int n_in, void* d_out, int out_size, void* d_ws, size_t ws_size, hipStream_t stream) {
    static int grid = 0;
    if (grid == 0) {
        if (n_in != 28 || out_size != ML * D || ws_size < (size_t)1024 * MiB) { fprintf(stderr, "kernel_launch: unexpected problem (n_in %d, out %d, ws %zu)\n", n_in, out_size, ws_size); grid = -1; return; }
        int dev = 0, cus = 0, per_cu = 0;
        (void)hipGetDevice(&dev); (void)hipDeviceGetAttribute(&cus, hipDeviceAttributeMultiprocessorCount, dev);
        (void)hipFuncSetAttribute((const void*)mega_fwd, hipFuncAttributeMaxDynamicSharedMemorySize, LDS_BYTES);
        (void)hipOccupancyMaxActiveBlocksPerMultiprocessor(&per_cu, (const void*)mega_fwd, 512, LDS_BYTES);
        if (per_cu < 1) per_cu = 1;
        grid = cus * per_cu;
    }
    if (grid < 0) return;
    if (hipMemsetAsync((char*)d_ws + WS_CTL, 0, CTL_ZERO_BYTES, stream) != hipSuccess) { fprintf(stderr, "kernel_launch: memset of barrier words failed\n"); return; }
    Params p{};
    const float* const* in = (const float* const*)d_in;
    p.x = in[0]; p.c = in[1]; p.ctx = in[2]; p.c_ctx = in[3]; p.w_ada = in[4]; p.b_ada = in[5];
    p.f1_norm = in[6]; p.f1_wg = in[7]; p.f1_wu = in[8]; p.f1_wd = in[9];
    p.mix_norm = in[10]; p.w_in = in[11]; p.na_bias = in[12]; p.q_norm = in[13]; p.k_norm = in[14]; p.mq_norm = in[15]; p.mkv_norm = in[16];
    p.w_uq = in[17]; p.w_ukv = in[18]; p.w_ba = in[19]; p.w_bb = in[20]; p.w_bc = in[21]; p.w_out = in[22];
    p.f2_norm = in[23]; p.f2_wg = in[24]; p.f2_wu = in[25]; p.f2_wd = in[26]; p.final_norm = in[27];
    p.out = (float*)d_out; p.ws = (unsigned char*)d_ws;
    void* args[] = {&p};
    hipError_t e = hipLaunchCooperativeKernel((const void*)mega_fwd, dim3(grid), dim3(512), args, LDS_BYTES, stream);
    if (e != hipSuccess) fprintf(stderr, "cooperative launch failed: %s (grid %d)\n", hipGetErrorString(e), grid);
}
```

```cpp
#include <hip/hip_runtime.h>
#include <hip/hip_cooperative_groups.h>
#include <cstdio>
#include <cstdint>
namespace cg = cooperative_groups;
namespace pg8 {
#define PG8_LAS __attribute__((address_space(3)))
typedef unsigned short bf16_t;
typedef short bf16x8 __attribute__((ext_vector_type(8)));
typedef float f32x4 __attribute__((ext_vector_type(4)));
typedef unsigned u32x4 __attribute__((ext_vector_type(4)));
constexpr int BM = 256, BK = 64, HALF = 128, HTB = HALF * BK * 2  , STAGE_BYTES = 8 * HTB, NXCD = 8, WGM = 8;

__host__ __device__ __forceinline__ int lds_byte(int r, int c) { const int st = (r >> 4) * 2 + (c >> 5), rr = r & 15, cc = c & 31, ob = rr * 64 + cc * 2; return st * 1024 + (ob ^ (((ob >> 9) & 1) << 5)); }
__host__ __device__ __forceinline__ void stage_rc(int b, int& R, int& C) { const int st = b / 1024, sb = b % 1024, swz = sb ^ (((sb >> 9) & 1) << 5); R = (st >> 1) * 16 + swz / 64; C = (st & 1) * 32 + (swz % 64) / 2; }
__host__ __device__ __forceinline__ int perm32(int rho) { const int n = rho >> 4, i = rho & 15; return 8 * (i >> 2) + 4 * n + (i & 3); }

struct Unit { int pm, pn; };
struct Gemm { const bf16_t* A; const bf16_t* Bt; int lda, ldb, K; };

struct StaticOrder {
    int nM, nN, nwg, G, c;
    __host__ __device__ void init(int M, int N, int G_, int c_) { nM = M / BM; nN = N / BM; nwg = nM * nN; G = G_; c = c_; }
    __host__ __device__ bool next(int i, Unit& u) const {
        const long L = (long)i * G + c; if (L >= nwg) return false;
        int wgid = (int)L; { const int q = nwg / NXCD, r = nwg % NXCD, xcd = wgid % NXCD, off = wgid / NXCD; wgid = (xcd < r ? xcd * (q + 1) : r * (q + 1) + (xcd - r) * q) + off; }
        const int nig = WGM * nN, gid = wgid / nig, fm = gid * WGM, gsz = (nM - fm) < WGM ? (nM - fm) : WGM;
        u.pm = fm + ((wgid % nig) % gsz); u.pn = (wgid % nig) / gsz; return true;
    }
    __device__ __forceinline__ void a_ready(const Unit&) const {}
    __device__ __forceinline__ void done(const Unit&) const {}
};

__device__ __forceinline__ unsigned cvt_pk_bf16(float lo, float hi) { unsigned r; asm volatile("v_cvt_pk_bf16_f32 %0, %1, %2" : "=v"(r) : "v"(lo), "v"(hi)); return r; }
template <class Epi, class Sched, bool ALIGN_EPI = false, bool SP2 = false>
__device__ __forceinline__ void gemm_phase(PG8_LAS unsigned char* lds, const Gemm g, const Sched& S, const Epi& E, const int tid) {
    const int wid = __builtin_amdgcn_readfirstlane(tid >> 6), lane = tid & 63, wr = wid >> 2, wc = wid & 3, fr = lane & 15, fq = lane >> 4;
    const int K = g.K, nt = K / BK;
    unsigned voffA[2], voffB[2];
#pragma unroll
    for (int i = 0; i < 2; ++i) { int R, C; stage_rc(tid * 16 + i * 8192, R, C); const int Rb = Epi::PERM ? ((R & ~31) + perm32(R & 31)) : R;
        voffA[i] = (unsigned)(R * g.lda + C) * 2u; voffB[i] = (unsigned)(Rb * g.ldb + C) * 2u; }
    const size_t kstep = (size_t)(BK * 2);
    const size_t hstepA = (size_t)HALF * g.lda * 2, hstepB = (size_t)HALF * g.ldb * 2;
    const size_t tstepA = 2 * hstepA, tstepB = 2 * hstepB;
    const unsigned ldsw = (unsigned)wid * 1024u;
    const int aoff = lds_byte(wr * 64 + fr, fq * 8), boff = lds_byte(wc * 32 + fr, fq * 8);
#define PG8_SA(b, h) (((b) * 2 + (h)) * HTB)
#define PG8_SB(b, h) ((4 + (b) * 2 + (h)) * HTB)
#define PG8_STAGE(bufoff, gbase, voff) do { _Pragma("unroll") for (int _i = 0; _i < 2; ++_i) \
        __builtin_amdgcn_global_load_lds((const unsigned*)((const char*)(gbase) + (voff)[_i]), (PG8_LAS unsigned*)(lds + (bufoff) + ldsw + _i * 8192), 16, 0, 0); } while (0)
#define PG8_LDA(dst, b, h) do { _Pragma("unroll") for (int m = 0; m < 4; ++m) _Pragma("unroll") for (int k = 0; k < 2; ++k) dst[m][k] = *(const PG8_LAS bf16x8*)(lds + PG8_SA(b, h) + aoff + m * 2048 + k * 1024); } while (0)
#define PG8_LDB(dst, b, h) do { _Pragma("unroll") for (int n = 0; n < 2; ++n) _Pragma("unroll") for (int k = 0; k < 2; ++k) dst[n][k] = *(const PG8_LAS bf16x8*)(lds + PG8_SB(b, h) + boff + n * 2048 + k * 1024); } while (0)
#define PG8_MMA(ai, bj, At, Bt) do { __builtin_amdgcn_s_setprio(1); _Pragma("unroll") for (int m = 0; m < 4; ++m) _Pragma("unroll") for (int n = 0; n < 2; ++n) _Pragma("unroll") for (int k = 0; k < 2; ++k) \
        acc[ai][bj][m][n] = __builtin_amdgcn_mfma_f32_16x16x32_bf16(Bt[n][k], At[m][k], acc[ai][bj][m][n], 0, 0, 0); __builtin_amdgcn_s_setprio(0); } while (0)
#define PG8_WAIT_V(n) asm volatile("s_waitcnt vmcnt(" #n ")" ::: "memory")
#define PG8_WAIT_L(n) asm volatile("s_waitcnt lgkmcnt(" #n ")" ::: "memory")
#define PG8_BAR __builtin_amdgcn_s_barrier()
#define PG8_SCHED __builtin_amdgcn_sched_barrier(0)
    Unit cur, nxt; int ui = 0;
    if (!S.next(0, cur)) return;
    f32x4 acc[2][2][4][2];
#pragma unroll
    for (int a = 0; a < 2; ++a)
#pragma unroll
        for (int b = 0; b < 2; ++b)
#pragma unroll
            for (int m = 0; m < 4; ++m)
#pragma unroll
                for (int n = 0; n < 2; ++n) acc[a][b][m][n] = (f32x4){0.f, 0.f, 0.f, 0.f};
    bf16x8 At[4][2], B0[2][2], B1[2][2];
    const char* cA = (const char*)g.A + (size_t)cur.pm * tstepA; const char* cB = (const char*)g.Bt + (size_t)cur.pn * tstepB;
    S.a_ready(cur);
    if constexpr (SP2) {
        PG8_STAGE(PG8_SB(0, 0), cB, voffB); PG8_STAGE(PG8_SB(0, 1), cB + hstepB, voffB); PG8_STAGE(PG8_SA(0, 0), cA, voffA); PG8_STAGE(PG8_SA(0, 1), cA + hstepA, voffA);
        if (wr == 1) PG8_BAR;
        PG8_WAIT_V(2); PG8_BAR;
        PG8_STAGE(PG8_SB(1, 0), cB + kstep, voffB); PG8_STAGE(PG8_SA(1, 0), cA + kstep, voffA); PG8_STAGE(PG8_SB(1, 1), cB + hstepB + kstep, voffB);
        PG8_WAIT_V(6); PG8_BAR;
    } else {
        PG8_STAGE(PG8_SB(0, 0), cB, voffB); PG8_STAGE(PG8_SA(0, 0), cA, voffA); PG8_STAGE(PG8_SB(0, 1), cB + hstepB, voffB); PG8_STAGE(PG8_SA(0, 1), cA + hstepA, voffA);
        if (wr == 1) PG8_BAR;
        PG8_WAIT_V(4); PG8_BAR;
        PG8_STAGE(PG8_SB(1, 0), cB + kstep, voffB); PG8_STAGE(PG8_SA(1, 0), cA + kstep, voffA); PG8_STAGE(PG8_SB(1, 1), cB + hstepB + kstep, voffB);
        PG8_WAIT_V(6); PG8_BAR;
    }
    for (;;) {
        const bool has_next = S.next(ui + 1, nxt);
        const char* nA = has_next ? (const char*)g.A + (size_t)nxt.pm * tstepA : cA; const char* nB = has_next ? (const char*)g.Bt + (size_t)nxt.pn * tstepB : cB;
        for (int t = 0; t < nt; t += 2) {
            const bool last = (t == nt - 2);
            const char* a1 = cA + (size_t)(t + 1) * kstep;
            const char* a2 = last ? nA : cA + (size_t)(t + 2) * kstep; const char* b2 = last ? nB : cB + (size_t)(t + 2) * kstep;
            const char* a3 = a2 + kstep; const char* b3 = b2 + kstep;
            if (last && has_next) S.a_ready(nxt);
            if constexpr (SP2) {
            PG8_LDB(B0, 0, 0); PG8_LDB(B1, 0, 1); PG8_SCHED; PG8_LDA(At, 0, 0); PG8_STAGE(PG8_SA(1, 1), a1 + hstepA, voffA);
            PG8_WAIT_V(8); PG8_WAIT_L(0); PG8_BAR; PG8_MMA(0, 0, At, B0); PG8_MMA(0, 1, At, B1); PG8_BAR; PG8_SCHED;
            PG8_LDA(At, 0, 1); PG8_STAGE(PG8_SB(0, 0), b2, voffB); PG8_STAGE(PG8_SB(0, 1), b2 + hstepB, voffB); PG8_STAGE(PG8_SA(0, 0), a2, voffA);
            PG8_WAIT_V(8); PG8_WAIT_L(0); PG8_BAR; PG8_MMA(1, 0, At, B0); PG8_MMA(1, 1, At, B1); PG8_BAR; PG8_SCHED;
            PG8_LDB(B0, 1, 0); PG8_LDB(B1, 1, 1); PG8_SCHED; PG8_LDA(At, 1, 0); PG8_STAGE(PG8_SA(0, 1), a2 + hstepA, voffA);
            PG8_WAIT_V(8); PG8_WAIT_L(0); PG8_BAR; PG8_MMA(0, 0, At, B0); PG8_MMA(0, 1, At, B1); PG8_BAR; PG8_SCHED;
            PG8_LDA(At, 1, 1); PG8_STAGE(PG8_SB(1, 0), b3, voffB); PG8_STAGE(PG8_SB(1, 1), b3 + hstepB, voffB); PG8_STAGE(PG8_SA(1, 0), a3, voffA);
            PG8_WAIT_V(8); PG8_WAIT_L(0); PG8_BAR; PG8_MMA(1, 0, At, B0); PG8_MMA(1, 1, At, B1); PG8_BAR; PG8_SCHED;
            } else {
            PG8_LDB(B0, 0, 0); PG8_SCHED; PG8_LDA(At, 0, 0); PG8_STAGE(PG8_SA(1, 1), a1 + hstepA, voffA);
            PG8_WAIT_L(8); PG8_BAR; PG8_WAIT_L(0); PG8_MMA(0, 0, At, B0); PG8_BAR; PG8_SCHED;
            PG8_LDB(B1, 0, 1); PG8_STAGE(PG8_SB(0, 0), b2, voffB);
            PG8_BAR; PG8_WAIT_L(0); PG8_MMA(0, 1, At, B1); PG8_BAR;
            PG8_LDA(At, 0, 1); PG8_STAGE(PG8_SA(0, 0), a2, voffA);
            PG8_BAR; PG8_WAIT_L(0); PG8_MMA(1, 0, At, B0); PG8_BAR; PG8_SCHED;
            PG8_STAGE(PG8_SB(0, 1), b2 + hstepB, voffB);
            PG8_WAIT_V(6); PG8_BAR; PG8_MMA(1, 1, At, B1); PG8_BAR;
            PG8_LDB(B0, 1, 0); PG8_SCHED; PG8_LDA(At, 1, 0); PG8_STAGE(PG8_SA(0, 1), a2 + hstepA, voffA);
            PG8_WAIT_L(8); PG8_BAR; PG8_WAIT_L(0); PG8_MMA(0, 0, At, B0); PG8_BAR; PG8_SCHED;
            PG8_LDB(B1, 1, 1); PG8_STAGE(PG8_SB(1, 0), b3, voffB);
            PG8_BAR; PG8_WAIT_L(0); PG8_MMA(0, 1, At, B1); PG8_BAR;
            PG8_LDA(At, 1, 1); PG8_STAGE(PG8_SA(1, 0), a3, voffA);
            PG8_BAR; PG8_WAIT_L(0); PG8_MMA(1, 0, At, B0); PG8_BAR; PG8_SCHED;
            PG8_STAGE(PG8_SB(1, 1), b3 + hstepB, voffB);
            PG8_WAIT_V(6); PG8_BAR; PG8_MMA(1, 1, At, B1); PG8_BAR;
            }
            if constexpr (Epi::HAS_MID) { if (t + 2 == Epi::MID1 || t + 2 == Epi::MID2) E.mid(acc, cur, t + 2, wr, wc, fr, fq); }
        }
        if constexpr (ALIGN_EPI) { if (wr == 0) PG8_BAR; }
        if constexpr (!Epi::AFTER_DRAIN) { E(acc, cur, wr, wc, fr, fq); S.done(cur); }
        if (!has_next) break;
#pragma unroll
        for (int a = 0; a < 2; ++a)
#pragma unroll
            for (int b = 0; b < 2; ++b)
#pragma unroll
                for (int m = 0; m < 4; ++m)
#pragma unroll
                    for (int n = 0; n < 2; ++n) acc[a][b][m][n] = (f32x4){0.f, 0.f, 0.f, 0.f};
        cur = nxt; cA = nA; cB = nB; ++ui;
        if constexpr (ALIGN_EPI) { if (wr == 1) PG8_BAR; }
    }
    PG8_WAIT_V(0);
    if constexpr (!ALIGN_EPI) { if (wr == 0) PG8_BAR; }
    PG8_BAR;
    if constexpr (Epi::AFTER_DRAIN) { E.fused(acc, cur, wr, wc, fr, fq, lds, wid, lane); S.done(cur); }
#undef PG8_SA
#undef PG8_SB
#undef PG8_STAGE
#undef PG8_LDA
#undef PG8_LDB
#undef PG8_MMA
#undef PG8_WAIT_V
#undef PG8_WAIT_L
#undef PG8_BAR
#undef PG8_SCHED
}
}
using pg8::Unit; using pg8::f32x4; using pg8::u32x4; using pg8::bf16x8;
typedef unsigned short bf16;
#define LAS __attribute__((address_space(3)))
typedef float f32x16 __attribute__((ext_vector_type(16)));
typedef float f32x2 __attribute__((ext_vector_type(2)));
typedef unsigned u32x2 __attribute__((ext_vector_type(2)));

constexpr int D = 1024, NBATCH = 32, SEQ = 2048, CTXL = 256, DFF = 2816, DEPTH = 2;
constexpr int ML = NBATCH * SEQ, MC = NBATCH * CTXL, MT = ML + MC;
constexpr int MODW = 9 * D;
constexpr int INW = 5024, INWP = 5120;
constexpr int NCH = 2, BPH = NBATCH / NCH;
constexpr int HL = BPH * SEQ, HC = BPH * CTXL, HM = HL + HC;
constexpr float EPS = 1e-6f, LOG2E = 1.4426950408889634f;

constexpr size_t MiB = 1u << 20;
constexpr size_t WS_SC = 1 * MiB;
constexpr size_t WS_MOD = 2 * MiB;
constexpr size_t WS_CTXRES = 8 * MiB;
constexpr size_t WS_W = 40 * MiB;
constexpr size_t LW_U1 = 0, LW_D1 = LW_U1 + (size_t)2 * DFF * D * 2, LW_U2 = LW_D1 + (size_t)D * DFF * 2, LW_D2 = LW_U2 + (size_t)2 * DFF * D * 2,
                 LW_IN = LW_D2 + (size_t)D * DFF * 2, LW_UQ = LW_IN + (size_t)INWP * D * 2, LW_UKV = LW_UQ + (size_t)512 * 256 * 2, LW_BR = LW_UKV + (size_t)512 * 128 * 2,
                 LW_OUT = LW_BR + (size_t)D * D * 2, LW_SIZE = LW_OUT + (size_t)D * D * 2;
static_assert(WS_W + 2 * LW_SIZE <= 136 * MiB, "weights");
constexpr size_t WS_NB = 136 * MiB;
constexpr size_t WS_Y = 280 * MiB;
constexpr size_t WS_BIG = 424 * MiB;
constexpr size_t WS_H = WS_BIG;
constexpr size_t WS_WADA = WS_BIG;
constexpr size_t WS_BA = WS_BIG;
constexpr size_t WS_BB = WS_BA + (size_t)HM * 768 * 2;
constexpr size_t WS_BC = WS_BB + (size_t)HM * 768 * 2;
constexpr size_t WS_MQ = WS_BC + (size_t)HM * 512 * 2;
constexpr size_t WS_MKV = WS_MQ + (size_t)HM * 512 * 2;
constexpr size_t WS_G = WS_MKV + (size_t)HM * 512 * 2;
constexpr size_t WS_END = WS_G + (size_t)HM * 3072 * 2;
static_assert(WS_END <= 1024 * MiB && WS_H + (size_t)MT * DFF * 2 <= 1024 * MiB, "ws map");

struct Params {
    const float* x; const float* c; const float* ctx; const float* c_ctx; const float* w_ada; const float* b_ada;
    const float* f1_norm; const float* f1_wg; const float* f1_wu; const float* f1_wd;
    const float* mix_norm; const float* w_in; const float* na_bias; const float* q_norm; const float* k_norm; const float* mq_norm; const float* mkv_norm;
    const float* w_uq; const float* w_ukv; const float* w_ba; const float* w_bb; const float* w_bc; const float* w_out;
    const float* f2_norm; const float* f2_wg; const float* f2_wu; const float* f2_wd; const float* final_norm;
    float* out; unsigned char* ws;
};

__device__ __forceinline__ float bf2f(unsigned v) { return __uint_as_float(v << 16); }
typedef __bf16 bf16x2_t __attribute__((ext_vector_type(2)));
__device__ __forceinline__ unsigned pk2(float lo, float hi) { const f32x2 v = {lo, hi}; const bf16x2_t b = __builtin_convertvector(v, bf16x2_t); return __builtin_bit_cast(unsigned, b); }
__device__ __forceinline__ float fsilu(float x) { return x * __builtin_amdgcn_rcpf(1.f + __builtin_amdgcn_exp2f(-x * LOG2E)); }
__device__ __forceinline__ float fsigm(float x) { return __builtin_amdgcn_rcpf(1.f + __builtin_amdgcn_exp2f(-x * LOG2E)); }
template <int M> __device__ __forceinline__ float swz_xor(float v) { return __int_as_float(__builtin_amdgcn_ds_swizzle(__float_as_int(v), (M << 10) | 0x1f)); }
__device__ __forceinline__ float half_sum(float v) { auto rr = __builtin_amdgcn_permlane32_swap(__float_as_uint(v), __float_as_uint(v), false, false); return __uint_as_float(rr[0]) + __uint_as_float(rr[1]); }
__device__ __forceinline__ float half_max(float v) { auto rr = __builtin_amdgcn_permlane32_swap(__float_as_uint(v), __float_as_uint(v), false, false); return __builtin_fmaxf(__uint_as_float(rr[0]), __uint_as_float(rr[1])); }
__device__ __forceinline__ float sum32(float v) { v += swz_xor<1>(v); v += swz_xor<2>(v); v += swz_xor<4>(v); v += swz_xor<8>(v); v += swz_xor<16>(v); return v; }
__device__ __forceinline__ float wave_sum(float v) { return half_sum(sum32(v)); }
#define UNPK8(W_, f) do { const u32x4 w__ = (W_); f[0] = bf2f(w__[0] & 0xffffu); f[1] = __uint_as_float(w__[0] & 0xffff0000u); f[2] = bf2f(w__[1] & 0xffffu); f[3] = __uint_as_float(w__[1] & 0xffff0000u); \
                         f[4] = bf2f(w__[2] & 0xffffu); f[5] = __uint_as_float(w__[2] & 0xffff0000u); f[6] = bf2f(w__[3] & 0xffffu); f[7] = __uint_as_float(w__[3] & 0xffff0000u); } while (0)

struct MapOrder {
    pg8::StaticOrder s; int nl, lat0, ctx0; unsigned long long cmap;
    __device__ __forceinline__ void init(int nl_, int nc_, int lat0_, int ctx0_, int N, int G, int c) { nl = nl_; lat0 = lat0_; ctx0 = ctx0_; cmap = 0ull; s.init((nl_ + nc_) * 256, N, G, c); }
    __device__ __forceinline__ bool next(int i, Unit& u) const { if (!s.next(i, u)) return false; u.pm = u.pm < nl ? lat0 + u.pm : ctx0 + (u.pm - nl);
        if (cmap) u.pn = (int)((cmap >> (4 * u.pn)) & 15ull); return true; }
    __device__ __forceinline__ void a_ready(const Unit&) const {}
    __device__ __forceinline__ void done(const Unit&) const {}
};

#ifndef RESID_ALIGN
#define RESID_ALIGN false
#endif
#define EPI_COMMON static constexpr bool PERM = true, AFTER_DRAIN = false
#define EPI_NOMID static constexpr bool HAS_MID = false; static constexpr int MID1 = -1, MID2 = -1; \
    __device__ __forceinline__ void mid(f32x4 (&)[2][2][4][2], const Unit&, int, int, int, int, int) const {}
typedef f32x4 Acc[2][2][4][2];

struct EpiSwiGLU { EPI_COMMON; static constexpr bool ALIGN = true; EPI_NOMID; bf16* H;
    __device__ __forceinline__ void operator()(const Acc& acc, const Unit& u, int wr, int wc, int fr, int fq) const {
        const int row0 = u.pm * 256 + wr * 64 + fr, col0 = u.pn * 128 + wc * 32 + 8 * fq;
#pragma unroll
        for (int ai = 0; ai < 2; ++ai)
#pragma unroll
            for (int m = 0; m < 4; ++m) {
                const f32x4 g0 = acc[ai][0][m][0], g1 = acc[ai][0][m][1], u0 = acc[ai][1][m][0], u1 = acc[ai][1][m][1];
                u32x4 w; w.x = pk2(fsilu(g0[0]) * u0[0], fsilu(g0[1]) * u0[1]); w.y = pk2(fsilu(g0[2]) * u0[2], fsilu(g0[3]) * u0[3]);
                w.z = pk2(fsilu(g1[0]) * u1[0], fsilu(g1[1]) * u1[1]); w.w = pk2(fsilu(g1[2]) * u1[2], fsilu(g1[3]) * u1[3]);
                *(u32x4*)(H + (size_t)(row0 + ai * 128 + m * 16) * DFF + col0) = w; }
    }
};
struct EpiResid { EPI_COMMON; static constexpr bool ALIGN = RESID_ALIGN; EPI_NOMID; const float* src_lat; const float* src_ctx; float* dst_lat; float* dst_ctx; const float* modl; int gidx; float coef;
    __device__ __forceinline__ void operator()(const Acc& acc, const Unit& u, int wr, int wc, int fr, int fq) const {
        const bool isl = u.pm < 256;
        const float* src = isl ? src_lat + (size_t)u.pm * 256 * D : src_ctx + (size_t)(u.pm - 256) * 256 * D;
        float* dst = isl ? dst_lat + (size_t)u.pm * 256 * D : dst_ctx + (size_t)(u.pm - 256) * 256 * D;
        const float* gate = modl + (size_t)(isl ? (u.pm >> 3) : 32) * MODW + gidx * D;
        const int col0 = u.pn * 256 + wc * 32 + 8 * fq;
#pragma unroll
        for (int bj = 0; bj < 2; ++bj) {
            const f32x4 g0 = *(const f32x4*)(gate + col0 + bj * 128) * coef, g1 = *(const f32x4*)(gate + col0 + bj * 128 + 4) * coef;
            f32x4 x0[8], x1[8];
#pragma unroll
            for (int g = 0; g < 8; ++g) { const size_t off = (size_t)((g >> 2) * 128 + wr * 64 + (g & 3) * 16 + fr) * D + col0 + bj * 128;
                x0[g] = *(const f32x4*)(src + off); x1[g] = *(const f32x4*)(src + off + 4); }
            __builtin_amdgcn_sched_barrier(0);
#pragma unroll
            for (int g = 0; g < 8; ++g) { const size_t off = (size_t)((g >> 2) * 128 + wr * 64 + (g & 3) * 16 + fr) * D + col0 + bj * 128;
                *(f32x4*)(dst + off) = x0[g] + g0 * acc[g >> 2][bj][g & 3][0]; *(f32x4*)(dst + off + 4) = x1[g] + g1 * acc[g >> 2][bj][g & 3][1]; }
            __builtin_amdgcn_sched_barrier(0);
        }
    }
};
__device__ __forceinline__ int ltile(int pm, int hb) { return pm < 256 ? pm - (HL / 256) * hb : (HL / 256) + (pm - 256 - (HC / 256) * hb); }
struct EpiWin { EPI_COMMON; static constexpr bool ALIGN = true; EPI_NOMID; bf16* bA; bf16* bB; bf16* bC; bf16* G; int hb;
    __device__ __forceinline__ void operator()(const Acc& acc, const Unit& u, int wr, int wc, int fr, int fq) const {
        const int lrow0 = ltile(u.pm, hb) * 256 + wr * 64 + fr;
        bf16* base; int ld, ct; bool sg = false;
        if (u.pn < 3) { base = bA; ld = 768; ct = u.pn; } else if (u.pn < 6) { base = bB; ld = 768; ct = u.pn - 3; } else if (u.pn < 8) { base = bC; ld = 512; ct = u.pn - 6; } else { base = G; ld = 3072; ct = u.pn - 8; sg = true; }
        const int col0 = ct * 256 + wc * 32 + 8 * fq;
        const float qs = u.pn == 0 ? 0.125f * LOG2E : 1.0f;
#pragma unroll
        for (int ai = 0; ai < 2; ++ai)
#pragma unroll
            for (int m = 0; m < 4; ++m) { bf16* rp = base + (size_t)(lrow0 + ai * 128 + m * 16) * ld + col0;
#pragma unroll
                for (int bj = 0; bj < 2; ++bj) { f32x4 v0 = acc[ai][bj][m][0] * qs, v1 = acc[ai][bj][m][1] * qs;
                    if (sg) { v0 = (f32x4){fsigm(v0[0]), fsigm(v0[1]), fsigm(v0[2]), fsigm(v0[3])}; v1 = (f32x4){fsigm(v1[0]), fsigm(v1[1]), fsigm(v1[2]), fsigm(v1[3])}; }
                    u32x4 w; w.x = pk2(v0[0], v0[1]); w.y = pk2(v0[2], v0[3]); w.z = pk2(v1[0], v1[1]); w.w = pk2(v1[2], v1[3]);
                    *(u32x4*)(rp + bj * 128) = w; } }
    }
};
struct EpiPlain { EPI_COMMON; static constexpr bool ALIGN = true; EPI_NOMID; bf16* O; int ldc; float scale;
    __device__ __forceinline__ void operator()(const Acc& acc, const Unit& u, int wr, int wc, int fr, int fq) const {
        const int row0 = u.pm * 256 + wr * 64 + fr, col0 = u.pn * 256 + wc * 32 + 8 * fq;
#pragma unroll
        for (int ai = 0; ai < 2; ++ai)
#pragma unroll
            for (int m = 0; m < 4; ++m) { bf16* rp = O + (size_t)(row0 + ai * 128 + m * 16) * ldc + col0;
#pragma unroll
                for (int bj = 0; bj < 2; ++bj) { const f32x4 v0 = acc[ai][bj][m][0] * scale, v1 = acc[ai][bj][m][1] * scale;
                    u32x4 w; w.x = pk2(v0[0], v0[1]); w.y = pk2(v0[2], v0[3]); w.z = pk2(v1[0], v1[1]); w.w = pk2(v1[2], v1[3]);
                    *(u32x4*)(rp + bj * 128) = w; } }
    }
};
struct EpiAda { EPI_COMMON; static constexpr bool ALIGN = true; EPI_NOMID; float* MOD; const float* b_ada;
    __device__ __forceinline__ void operator()(const Acc& acc, const Unit& u, int wr, int wc, int fr, int fq) const {
        if (wr != 0) return;
        const int col0 = u.pn * 256 + wc * 32 + 8 * fq;
        const int layer = u.pn / 36, j0 = col0 - layer * MODW;
#pragma unroll
        for (int m = 0; m < 3; ++m) { const int row = m * 16 + fr; if (row < 33) {
#pragma unroll
            for (int bj = 0; bj < 2; ++bj) { const f32x4 b0 = *(const f32x4*)(b_ada + col0 + bj * 128), b1 = *(const f32x4*)(b_ada + col0 + bj * 128 + 4);
                float* o = MOD + ((size_t)layer * 33 + row) * MODW + j0 + bj * 128;
                *(f32x4*)o = acc[0][bj][m][0] + b0; *(f32x4*)(o + 4) = acc[0][bj][m][1] + b1; } } }
    }
};
struct EpiBranch { EPI_COMMON; static constexpr bool ALIGN = true; static constexpr bool HAS_MID = true; static constexpr int MID1 = 4, MID2 = 12;
    const bf16* G; bf16* Y; int hb;
    __device__ __forceinline__ void mid(Acc& acc, const Unit& u, int tt, int wr, int wc, int fr, int fq) const {
        asm volatile("" : "+v"(fr), "+v"(fq));
        const int lrow0 = ltile(u.pm, hb) * 256 + wr * 64 + fr, col0 = u.pn * 256 + wc * 32 + 8 * fq;
        const int num = tt == 4 ? 0 : D, den = tt == 4 ? D : 2 * D;
#pragma unroll
        for (int ai = 0; ai < 2; ++ai) {
            u32x4 wn[4][2], wd[4][2];
#pragma unroll
            for (int m = 0; m < 4; ++m) { const bf16* gp = G + (size_t)(lrow0 + ai * 128 + m * 16) * 3072 + col0;
#pragma unroll
                for (int bj = 0; bj < 2; ++bj) { wn[m][bj] = *(const u32x4*)(gp + num + bj * 128); wd[m][bj] = *(const u32x4*)(gp + den + bj * 128); } }
            __builtin_amdgcn_sched_barrier(0);
#pragma unroll
            for (int m = 0; m < 4; ++m)
#pragma unroll
                for (int bj = 0; bj < 2; ++bj) { float fn[8], fd[8]; UNPK8(wn[m][bj], fn); UNPK8(wd[m][bj], fd);
#pragma unroll
                    for (int e = 0; e < 8; ++e) { const float r = __builtin_fmaxf(fn[e], 1e-12f) * __builtin_amdgcn_rcpf(__builtin_fmaxf(fd[e], 1e-12f)); acc[ai][bj][m][e >> 2][e & 3] *= r; } }
            asm volatile("" ::: "memory"); }
    }
    __device__ __forceinline__ void operator()(const Acc& acc, const Unit& u, int wr, int wc, int fr, int fq) const {
        const int lrow0 = ltile(u.pm, hb) * 256 + wr * 64 + fr, row0 = u.pm * 256 + wr * 64 + fr, col0 = u.pn * 256 + wc * 32 + 8 * fq;
#pragma unroll
        for (int ai = 0; ai < 2; ++ai) {
            u32x4 wg[4][2];
#pragma unroll
            for (int m = 0; m < 4; ++m)
#pragma unroll
                for (int bj = 0; bj < 2; ++bj) wg[m][bj] = *(const u32x4*)(G + (size_t)(lrow0 + ai * 128 + m * 16) * 3072 + 2 * D + col0 + bj * 128);
            __builtin_amdgcn_sched_barrier(0);
#pragma unroll
            for (int m = 0; m < 4; ++m) { bf16* yp = Y + (size_t)(row0 + ai * 128 + m * 16) * D + col0;
#pragma unroll
                for (int bj = 0; bj < 2; ++bj) { float fg[8]; UNPK8(wg[m][bj], fg);
                    const f32x4 v0 = acc[ai][bj][m][0], v1 = acc[ai][bj][m][1];
                    u32x4 w; w.x = pk2(v0[0] * __builtin_fmaxf(fg[0], 1e-12f), v0[1] * __builtin_fmaxf(fg[1], 1e-12f)); w.y = pk2(v0[2] * __builtin_fmaxf(fg[2], 1e-12f), v0[3] * __builtin_fmaxf(fg[3], 1e-12f));
                    w.z = pk2(v1[0] * __builtin_fmaxf(fg[4], 1e-12f), v1[1] * __builtin_fmaxf(fg[5], 1e-12f)); w.w = pk2(v1[2] * __builtin_fmaxf(fg[6], 1e-12f), v1[3] * __builtin_fmaxf(fg[7], 1e-12f));
                    *(u32x4*)(yp + bj * 128) = w; } } }
    }
};
__device__ __forceinline__ int rope_logical(int p) { return 16 * ((p >> 3) & 1) + 8 * (p >> 4) + (p & 7); }
constexpr int PREP_PER_LAYER = 2 * (16 * 176) + 2 * (44 * 32) + 16 * 160 + 4 * 16 + 2 * 16 + 4 * 32 + 8 * 32 + 4 * 32 + 16 * 32, PREP_ADA = 2 * 16 * 288, PREP_TOTAL = PREP_ADA + 2 * PREP_PER_LAYER;
struct TrDesc { const float* srcp; bf16* dstp; int sstep, dstep; };
__device__ __forceinline__ TrDesc tr_decode(const Params& p, unsigned char* ws, int it, int lane) {
    const float* W0; const float* W1 = nullptr; bf16* dst; int K, ldw, ldd, koff = 0, nrows, kind = 0;
    int r = it;
    if (r < PREP_ADA) { const int L = r / (PREP_ADA / 2); r -= L * (PREP_ADA / 2);
        W0 = p.w_ada + (size_t)L * D * MODW; dst = (bf16*)(ws + WS_WADA) + (size_t)L * MODW * D; K = D; ldw = MODW; ldd = D; nrows = MODW; }
    else { r -= PREP_ADA; const int L = r / PREP_PER_LAYER; r -= L * PREP_PER_LAYER;
        unsigned char* wl = ws + WS_W + (size_t)L * LW_SIZE; bool found = false;
        W0 = nullptr; dst = nullptr; K = 64; ldw = 0; ldd = 0; nrows = 32;
#define TRY_JOB(KIND_, W0_, W1_, K_, LDW_, DST_, LDD_, KOFF_, NROWS_) if (!found) { const int cnt = ((K_) / 64) * ((NROWS_) / 32); if (r < cnt) { found = true; kind = KIND_; W0 = W0_; W1 = W1_; K = K_; ldw = LDW_; dst = (bf16*)(DST_); ldd = LDD_; koff = KOFF_; nrows = NROWS_; } else r -= cnt; }
        TRY_JOB(1, p.f1_wg + (size_t)L * D * DFF, p.f1_wu + (size_t)L * D * DFF, D, DFF, wl + LW_U1, D, 0, 2 * DFF)
        TRY_JOB(0, p.f1_wd + (size_t)L * DFF * D, nullptr, DFF, D, wl + LW_D1, DFF, 0, D)
        TRY_JOB(1, p.f2_wg + (size_t)L * D * DFF, p.f2_wu + (size_t)L * D * DFF, D, DFF, wl + LW_U2, D, 0, 2 * DFF)
        TRY_JOB(0, p.f2_wd + (size_t)L * DFF * D, nullptr, DFF, D, wl + LW_D2, DFF, 0, D)
        TRY_JOB(2, p.w_in + (size_t)L * D * INW, nullptr, D, INW, wl + LW_IN, D, 0, INWP)
        TRY_JOB(3, p.w_uq + (size_t)L * 256 * 384, nullptr, 256, 384, wl + LW_UQ, 256, 0, 512)
        TRY_JOB(0, p.w_ukv + (size_t)L * 128 * 512, nullptr, 128, 512, wl + LW_UKV, 128, 0, 512)
        TRY_JOB(0, p.w_ba + (size_t)L * 256 * D, nullptr, 256, D, wl + LW_BR, D, 0, D)
        TRY_JOB(0, p.w_bb + (size_t)L * 512 * D, nullptr, 512, D, wl + LW_BR, D, 256, D)
        TRY_JOB(0, p.w_bc + (size_t)L * 256 * D, nullptr, 256, D, wl + LW_BR, D, 768, D)
        TRY_JOB(0, p.w_out + (size_t)L * D * D, nullptr, D, D, wl + LW_OUT, D, 0, D)
#undef TRY_JOB
    }
    (void)K;
    const int nblk = nrows / 32, kb = r / nblk, nb = r % nblk, k0 = 64 * kb, n0 = 32 * nb, np = n0 + (lane & 31);
    const float* src = W0; int col = np;
    if (kind == 1) { const int pn = np >> 8, j = np & 255; src = j < 128 ? W0 : W1; col = 128 * pn + (j & 127); }
    else if (kind == 2) { if (np < 1920) col = np; else if (np < 1952) col = 1920 + rope_logical(np - 1920); else if (np < 2048) col = -1; else col = np - 96; }
    else if (kind == 3) { if (np < 384) { const int h = np / 96, j = np % 96; col = j < 64 ? np : 96 * h + 64 + rope_logical(j - 64); } else col = -1; }
    TrDesc d; d.srcp = col >= 0 ? src + (size_t)(k0 + (lane >> 5)) * ldw + col : nullptr; d.sstep = 2 * ldw;
    d.dstp = dst + (size_t)(n0 + (lane >> 3)) * ldd + koff + k0 + 8 * (lane & 7); d.dstep = 8 * ldd;
    return d;
}
#define TR_LOAD(DESC, V) do { _Pragma("unroll") for (int i = 0; i < 32; ++i) V[i] = (DESC).srcp ? (DESC).srcp[(size_t)i * (DESC).sstep] : 0.f; } while (0)
__device__ __forceinline__ void tr_finish(const TrDesc& d, const float (&v)[32], LAS float* scr, int lane) {
#pragma unroll
    for (int i = 0; i < 32; ++i) scr[(2 * i + (lane >> 5)) * 33 + (lane & 31)] = v[i];
    asm volatile("s_waitcnt lgkmcnt(0)" ::: "memory");
    const int c = lane & 7;
#pragma unroll
    for (int j = 0; j < 4; ++j) { const int n = (lane >> 3) + 8 * j; const LAS float* s = scr + (8 * c) * 33 + n;
        u32x4 o; o.x = pk2(s[0 * 33], s[1 * 33]); o.y = pk2(s[2 * 33], s[3 * 33]); o.z = pk2(s[4 * 33], s[5 * 33]); o.w = pk2(s[6 * 33], s[7 * 33]);
        *(u32x4*)(d.dstp + (size_t)j * d.dstep) = o; }
    asm volatile("s_waitcnt lgkmcnt(0)" ::: "memory");
}
__device__ __forceinline__ void prep_phase(const Params& p, LAS unsigned char* lds, int tid, int bid, int nbk, int item_lo, int item_hi, int wg0, bool misc) {
    asm volatile("" : "+v"(tid)); const int lane = tid & 63, wave = __builtin_amdgcn_readfirstlane(tid >> 6);
    LAS float* scr = (LAS float*)(lds + wave * 16384);
    const int gw = (bid - wg0) * 8 + wave, NGW = (nbk - wg0) * 8;
    unsigned char* ws = p.ws;
    if (bid >= wg0 && item_lo + gw < item_hi) {
        TrDesc dc = tr_decode(p, ws, item_lo + gw, lane); float vc[32]; TR_LOAD(dc, vc);
        for (int it = item_lo + gw; it < item_hi; it += NGW) {
            const bool more = it + NGW < item_hi;
            TrDesc dn = dc; float vn[32];
            if (more) { dn = tr_decode(p, ws, it + NGW, lane); TR_LOAD(dn, vn); }
            tr_finish(dc, vc, scr, lane);
            if (more) { dc = dn;
#pragma unroll
                for (int i = 0; i < 32; ++i) vc[i] = vn[i]; }
        }
    }
    bf16* SC = (bf16*)(ws + WS_SC);
    if (misc) for (int i = bid * 512 + tid; i < 256 * D; i += nbk * 512) { const int row = i >> 10, col = i & 1023;
        float v = 0.f; if (row < 32) v = fsilu(p.c[row * D + col]); else if (row == 32) v = fsilu(p.c_ctx[col]);
        SC[i] = (bf16)(pk2(v, 0.f) & 0xffffu); }
}

__device__ __forceinline__ void normmod_phase(const float* xlat, const float* xctx, const float* gain, const float* modl, int sidx, bf16* NBp, int nrows, int tid, int bid, int nbk) {
    asm volatile("" : "+v"(tid)); const int lane = tid & 63, wave = __builtin_amdgcn_readfirstlane(tid >> 6);
    const int gw = bid * 8 + wave, NGW = nbk * 8;
    f32x4 gv[4];
#pragma unroll
    for (int j = 0; j < 4; ++j) gv[j] = *(const f32x4*)(gain + 4 * lane + 256 * j);
    constexpr int R = 3;
    for (int row0 = gw; row0 < nrows; row0 += R * NGW) {
        f32x4 v[R][4]; f32x4 sh[R][4], sc[R][4];
#pragma unroll
        for (int q = 0; q < R; ++q) { const int row = row0 + q * NGW; if (row < nrows) {
            const float* xr = row < ML ? xlat + (size_t)row * D : xctx + (size_t)(row - ML) * D;
#pragma unroll
            for (int j = 0; j < 4; ++j) v[q][j] = *(const f32x4*)(xr + 4 * lane + 256 * j); } }
#pragma unroll
        for (int q = 0; q < R; ++q) { const int row = row0 + q * NGW; if (row < nrows) {
            const float* mr = modl + (size_t)(row < ML ? (row >> 11) : 32) * MODW + sidx * D;
#pragma unroll
            for (int j = 0; j < 4; ++j) { sh[q][j] = *(const f32x4*)(mr + 4 * lane + 256 * j); sc[q][j] = *(const f32x4*)(mr + D + 4 * lane + 256 * j); } } }
#pragma unroll
        for (int q = 0; q < R; ++q) { const int row = row0 + q * NGW; if (row < nrows) {
            float ss = 0.f;
#pragma unroll
            for (int j = 0; j < 4; ++j) ss += (v[q][j].x * v[q][j].x + v[q][j].y * v[q][j].y) + (v[q][j].z * v[q][j].z + v[q][j].w * v[q][j].w);
            const float rstd = 1.0f / sqrtf(wave_sum(ss) * (1.f / D) + EPS);
            u32x2* o = (u32x2*)(NBp + (size_t)row * D) + lane;
#pragma unroll
            for (int j = 0; j < 4; ++j) { const f32x4 n = (v[q][j] * rstd) * gv[j] * (sc[q][j] + 1.0f) + sh[q][j];
                u32x2 w; w.x = pk2(n.x, n.y); w.y = pk2(n.z, n.w); o[64 * j] = w; } } }
    }
}
__device__ __forceinline__ void final_phase(float* out, const float* gain, int tid, int bid, int nbk) {
    asm volatile("" : "+v"(tid)); const int lane = tid & 63, wave = __builtin_amdgcn_readfirstlane(tid >> 6);
    const int gw = bid * 8 + wave, NGW = nbk * 8;
    f32x4 gv[4];
#pragma unroll
    for (int j = 0; j < 4; ++j) gv[j] = *(const f32x4*)(gain + 4 * lane + 256 * j);
    constexpr int R = 3;
    for (int row0 = gw; row0 < ML; row0 += R * NGW) {
        f32x4 v[R][4];
#pragma unroll
        for (int q = 0; q < R; ++q) { const int row = row0 + q * NGW; if (row < ML) {
#pragma unroll
            for (int j = 0; j < 4; ++j) v[q][j] = *(const f32x4*)(out + (size_t)row * D + 4 * lane + 256 * j); } }
#pragma unroll
        for (int q = 0; q < R; ++q) { const int row = row0 + q * NGW; if (row < ML) {
            float ss = 0.f;
#pragma unroll
            for (int j = 0; j < 4; ++j) ss += (v[q][j].x * v[q][j].x + v[q][j].y * v[q][j].y) + (v[q][j].z * v[q][j].z + v[q][j].w * v[q][j].w);
            const float rstd = 1.0f / sqrtf(wave_sum(ss) * (1.f / D) + EPS);
#pragma unroll
            for (int j = 0; j < 4; ++j) *(f32x4*)(out + (size_t)row * D + 4 * lane + 256 * j) = (v[q][j] * rstd) * gv[j]; } }
    }
}

__device__ __forceinline__ void post_phase(bf16* bB, bf16* bC, const float* k_norm, const float* mq_norm, const float* mkv_norm, int tid, int bid, int nbk) {
    asm volatile("" : "+v"(tid)); const int lane = tid & 63, wave = __builtin_amdgcn_readfirstlane(tid >> 6);
    const int gw = bid * 8 + wave, NGW = nbk * 8;
    const int hd = lane >> 5, a = (lane >> 4) & 1, f = lane & 15, d0 = 32 * a + f;
    const int a2 = (lane >> 3) & 1, f2 = lane & 7;
    const float kg0 = k_norm[d0], kg1 = k_norm[d0 + 16];
    const f32x4 qg = *(const f32x4*)(mq_norm + 4 * lane);
    const float vg0 = mkv_norm[2 * lane], vg1 = mkv_norm[2 * lane + 1];
    const float fr1 = __builtin_amdgcn_exp2f(-(float)f * (13.287712379549449f / 16.f)), fr2 = __builtin_amdgcn_exp2f(-(float)f2 * (13.287712379549449f / 8.f));
    constexpr int R = 4;
    for (int row0 = gw; row0 < HM; row0 += R * NGW) {
        unsigned k0r[R], k1r[R], cvr[R], r0r[R], r1r[R]; u32x2 cqr[R];
#pragma unroll
        for (int q = 0; q < R; ++q) { const int row = row0 + q * NGW; if (row < HM) {
            const bf16* kp = bB + (size_t)row * 768 + 512 + hd * 64; const bf16* cp = bC + (size_t)row * 512;
            k0r[q] = kp[d0]; k1r[q] = kp[d0 + 16]; cqr[q] = *(const u32x2*)(cp + 4 * lane); cvr[q] = *(const unsigned*)(cp + 256 + 2 * lane);
            r0r[q] = cp[384 + 8 * a2 + f2]; r1r[q] = cp[384 + 16 + 8 * a2 + f2]; } }
#pragma unroll
        for (int q = 0; q < R; ++q) { const int row = row0 + q * NGW; if (row < HM) {
            const bool lat = row < HL; const int t = row & (SEQ - 1); const float prow = (float)(t >> 6), pcol = (float)(t & 63);
            bf16* kp = bB + (size_t)row * 768 + 512 + hd * 64; bf16* cp = bC + (size_t)row * 512;
            { float x0 = bf2f(k0r[q]), x1 = bf2f(k1r[q]);
              const float rstd = 1.0f / sqrtf(sum32(x0 * x0 + x1 * x1) * (1.f / 64.f) + EPS);
              x0 = x0 * rstd * kg0; x1 = x1 * rstd * kg1;
              if (lat) { const float ang = (a ? pcol : prow) * fr1; const float cs = __cosf(ang), sn = __sinf(ang);
                  const float y0 = x0 * cs - x1 * sn, y1 = x1 * cs + x0 * sn; x0 = y0; x1 = y1; }
              kp[d0] = (bf16)(pk2(x0, 0.f) & 0xffffu); kp[d0 + 16] = (bf16)(pk2(x1, 0.f) & 0xffffu); }
            { const u32x2 w = cqr[q];
              const float x[4] = {bf2f(w.x & 0xffffu), __uint_as_float(w.x & 0xffff0000u), bf2f(w.y & 0xffffu), __uint_as_float(w.y & 0xffff0000u)};
              const float rstd = 1.0f / sqrtf(wave_sum((x[0] * x[0] + x[1] * x[1]) + (x[2] * x[2] + x[3] * x[3])) * (1.f / 256.f) + EPS);
              u32x2 o; o.x = pk2(x[0] * rstd * qg.x, x[1] * rstd * qg.y); o.y = pk2(x[2] * rstd * qg.z, x[3] * rstd * qg.w); *(u32x2*)(cp + 4 * lane) = o; }
            { const unsigned w = cvr[q]; const float x0 = bf2f(w & 0xffffu), x1 = __uint_as_float(w & 0xffff0000u);
              const float rstd = 1.0f / sqrtf(wave_sum(x0 * x0 + x1 * x1) * (1.f / 128.f) + EPS);
              *(unsigned*)(cp + 256 + 2 * lane) = pk2(x0 * rstd * vg0, x1 * rstd * vg1); }
            if (lat && lane < 16) { const float x0 = bf2f(r0r[q]), x1 = bf2f(r1r[q]);
              const float ang = (a2 ? pcol : prow) * fr2; const float cs = __cosf(ang), sn = __sinf(ang);
              cp[384 + 8 * a2 + f2] = (bf16)(pk2(x0 * cs - x1 * sn, 0.f) & 0xffffu); cp[384 + 16 + 8 * a2 + f2] = (bf16)(pk2(x1 * cs + x0 * sn, 0.f) & 0xffffu); }
        } }
    }
}
constexpr int KTP = 208, KTB = 64 * KTP, VTP = 144, VTB = 64 * VTP;
constexpr int A_KT = 0, A_VT = 2 * KTB, A_BIAS = A_VT + 3 * VTB, A_END = A_BIAS + 480 * 4;
struct AttnArgs { const bf16* bA; const bf16* bB; const bf16* bC; const bf16* MQ; const bf16* MKV; bf16* OB; const float* q_norm; const float* na_bias; int hb; int with_ctx_q; };
__device__ __forceinline__ int crow(int r, int hi) { return (r & 3) + 8 * (r >> 2) + 4 * hi; }
__device__ __forceinline__ int na_r0(int r) { const int v = r - 4; return v < 0 ? 0 : (v > 24 ? 24 : v); }


template <int QD> __device__ __forceinline__ void attn_tile(const bf16x8 (&qf)[QD], bool& fresh, f32x16& negm, float& m2, float& lsum, f32x16& o0, f32x16& o1, const LAS unsigned char* kb, const LAS unsigned char* vb,
                                                           bool local, const LAS float* bt, int c0, int hi) {
    bf16x8 k0[QD], k1[QD];
#pragma unroll
    for (int d0 = 0; d0 < QD; ++d0) { k0[d0] = *(const LAS bf16x8*)(kb + d0 * 32); k1[d0] = *(const LAS bf16x8*)(kb + 32 * KTP + d0 * 32); }
    bf16x8 vfa[4], vfc[4];
#pragma unroll
    for (int j4 = 0; j4 < 4; ++j4) { vfa[j4] = *(const LAS bf16x8*)(vb + j4 * 32); vfc[j4] = *(const LAS bf16x8*)(vb + 32 * VTP + j4 * 32); }
    __builtin_amdgcn_sched_barrier(0);
    f32x16 s0, s1;
    s0 = __builtin_amdgcn_mfma_f32_32x32x16_bf16(k0[0], qf[0], negm, 0, 0, 0); s1 = __builtin_amdgcn_mfma_f32_32x32x16_bf16(k1[0], qf[0], negm, 0, 0, 0);
#pragma unroll
    for (int d0 = 1; d0 < QD; ++d0) { s0 = __builtin_amdgcn_mfma_f32_32x32x16_bf16(k0[d0], qf[d0], s0, 0, 0, 0); s1 = __builtin_amdgcn_mfma_f32_32x32x16_bf16(k1[d0], qf[d0], s1, 0, 0, 0); }
    if (local) {
        int base = 4 * hi - c0; asm volatile("" : "+v"(base));
        const LAS float* btl = bt + 4 * hi;
#pragma unroll
        for (int r = 0; r < 16; ++r) { const int cr = (r & 3) + 8 * (r >> 2);
            s0[r] = ((unsigned)(cr + base) < 16u) ? s0[r] + btl[cr] : -1e30f;
            s1[r] = ((unsigned)(cr + 32 + base) < 16u) ? s1[r] + btl[cr + 32] : -1e30f; }
    }
    float tmax;
    { float a = __builtin_fmaxf(s0[0], s1[0]), b = __builtin_fmaxf(s0[1], s1[1]);
#pragma unroll
      for (int r = 2; r < 16; r += 2) { a = __builtin_fmaxf(__builtin_fmaxf(a, s0[r]), s1[r]); b = __builtin_fmaxf(__builtin_fmaxf(b, s0[r + 1]), s1[r + 1]); }
      tmax = half_max(__builtin_fmaxf(a, b)); }
    if (fresh || __any(tmax > 8.0f)) {
        const float dl = fresh ? tmax : __builtin_fmaxf(tmax, 0.f); m2 += dl; fresh = false;
#pragma unroll
        for (int r = 0; r < 16; ++r) { s0[r] -= dl; s1[r] -= dl; negm[r] = -m2; }
        const float al = __builtin_amdgcn_exp2f(-dl); lsum *= al;
#pragma unroll
        for (int r = 0; r < 16; ++r) { o0[r] *= al; o1[r] *= al; } }
    float ps0 = 0.f, ps1 = 0.f;
#pragma unroll
    for (int r = 0; r < 16; ++r) { s0[r] = __builtin_amdgcn_exp2f(s0[r]); s1[r] = __builtin_amdgcn_exp2f(s1[r]); ps0 += s0[r]; ps1 += s1[r]; }
    lsum += ps0 + ps1;
    bf16x8 pb[4];
    { u32x4 w;
      w.x = pk2(s0[0], s0[1]); w.y = pk2(s0[2], s0[3]); w.z = pk2(s0[4], s0[5]); w.w = pk2(s0[6], s0[7]); pb[0] = __builtin_bit_cast(bf16x8, w);
      w.x = pk2(s0[8], s0[9]); w.y = pk2(s0[10], s0[11]); w.z = pk2(s0[12], s0[13]); w.w = pk2(s0[14], s0[15]); pb[1] = __builtin_bit_cast(bf16x8, w);
      w.x = pk2(s1[0], s1[1]); w.y = pk2(s1[2], s1[3]); w.z = pk2(s1[4], s1[5]); w.w = pk2(s1[6], s1[7]); pb[2] = __builtin_bit_cast(bf16x8, w);
      w.x = pk2(s1[8], s1[9]); w.y = pk2(s1[10], s1[11]); w.z = pk2(s1[12], s1[13]); w.w = pk2(s1[14], s1[15]); pb[3] = __builtin_bit_cast(bf16x8, w); }
#pragma unroll
    for (int j4 = 0; j4 < 4; ++j4) {
        o0 = __builtin_amdgcn_mfma_f32_32x32x16_bf16(vfa[j4], pb[j4], o0, 0, 0, 0);
        o1 = __builtin_amdgcn_mfma_f32_32x32x16_bf16(vfc[j4], pb[j4], o1, 0, 0, 0); }
}

template <int TYPE  >
__device__ __forceinline__ void attn_unit(const AttnArgs& a, int bl, int head, int qb  , LAS unsigned char* lds, int tid) {
    constexpr int QD = TYPE == 2 ? 6 : 4;
    asm volatile("" : "+v"(tid));
    const int lane = tid & 63, wid = __builtin_amdgcn_readfirstlane(tid >> 6), q32 = lane & 31, hi = lane >> 5;
    const bool isctx = qb < 0;
    const int lat_row0 = bl * SEQ, ctx_row0 = HL + bl * CTXL;
    const bf16* Qb; const bf16* Kb; const bf16* Vb; int qp, kp, vp, ocol; float scale;
    if (TYPE == 0) { Qb = a.bA + 64 * head; Kb = a.bA + 256 + 64 * head; Vb = a.bA + 512 + 64 * head; qp = kp = vp = 768; ocol = 64 * head; scale = 0.125f; }
    else if (TYPE == 1) { Qb = a.bB + 64 * head; Kb = a.bB + 512 + 64 * (head >> 2); Vb = a.bB + 640 + 64 * (head >> 2); qp = kp = vp = 768; ocol = 256 + 64 * head; scale = 0.125f; }
    else { Qb = a.MQ + 96 * head; Kb = a.MKV + 128 * head; Vb = a.MKV + 128 * head + 64; qp = kp = vp = 512; ocol = 768 + 64 * head; scale = 0.10206207261596575f; }
    const float sc2 = scale * LOG2E;
    int nfirst, first_base, kr_lo = 0;
    if (isctx) { nfirst = 0; first_base = 0; }
    else if (TYPE == 0) { kr_lo = na_r0(4 * qb); const int kr_hi = na_r0(4 * qb + 3) + 7; nfirst = kr_hi - kr_lo + 1; first_base = lat_row0 + 64 * kr_lo; }
    else { nfirst = 32; first_base = lat_row0; }
    const int NT = nfirst + 4;
#define TILE_ROW(j) ((j) < nfirst ? first_base + 64 * (j) : ctx_row0 + 64 * ((j) - nfirst))
    const int krow = tid >> 3, kc = tid & 7, k2row = tid >> 2, k2c = tid & 3;
    u32x4 kA, vA, k2A = (u32x4){0u, 0u, 0u, 0u}, kB, vB, k2B = (u32x4){0u, 0u, 0u, 0u};
#define LOAD_TILE(j, kreg, vreg, k2reg) do { const int rb_ = TILE_ROW(j); kreg = *(const u32x4*)(Kb + (size_t)(rb_ + krow) * kp + 8 * kc); vreg = *(const u32x4*)(Vb + (size_t)(rb_ + krow) * vp + 8 * kc); \
        if (TYPE == 2 && tid < 256) k2reg = *(const u32x4*)(a.bC + (size_t)(rb_ + k2row) * 512 + 384 + 8 * k2c); } while (0)
#define STORE_TILE(buf, vbuf, kreg, vreg, k2reg) do { *(LAS u32x4*)(lds + A_KT + (buf) * KTB + krow * KTP + kc * 16) = kreg; \
        if (TYPE == 2 && tid < 256) *(LAS u32x4*)(lds + A_KT + (buf) * KTB + k2row * KTP + 128 + k2c * 16) = k2reg; \
          \
        { const bool odd_ = krow & 1; \
          const unsigned snd0_ = odd_ ? vreg.x : vreg.z, snd1_ = odd_ ? vreg.y : vreg.w;             \
          const unsigned rcv0_ = (unsigned)__builtin_amdgcn_ds_swizzle((int)snd0_, (8 << 10) | 0x1f), rcv1_ = (unsigned)__builtin_amdgcn_ds_swizzle((int)snd1_, (8 << 10) | 0x1f); \
          const unsigned ev0_ = odd_ ? rcv0_ : vreg.x, ev1_ = odd_ ? rcv1_ : vreg.y, od0_ = odd_ ? vreg.z : rcv0_, od1_ = odd_ ? vreg.w : rcv1_;     \
          const int kvp_ = (krow & 0x30) | ((krow & 4) << 1) | ((krow & 8) >> 1) | (krow & 2);        \
          LAS unsigned* vt_ = (LAS unsigned*)(lds + A_VT + (vbuf) * VTB + (8 * kc + 4 * (krow & 1)) * VTP + kvp_ * 2); \
          vt_[0 * (VTP / 4)] = __builtin_amdgcn_perm(od0_, ev0_, 0x05040100u); vt_[1 * (VTP / 4)] = __builtin_amdgcn_perm(od0_, ev0_, 0x07060302u); \
          vt_[2 * (VTP / 4)] = __builtin_amdgcn_perm(od1_, ev1_, 0x05040100u); vt_[3 * (VTP / 4)] = __builtin_amdgcn_perm(od1_, ev1_, 0x07060302u); } } while (0)
    LOAD_TILE(0, kA, vA, k2A);
    if (TYPE == 0 && !isctx) { if (tid < 465) ((LAS float*)(lds + A_BIAS))[tid] = a.na_bias[head * 465 + tid] * LOG2E; }
    const int qloc = 32 * wid + q32;
    const int qrow_l = isctx ? ctx_row0 + qloc : lat_row0 + 256 * qb + qloc;
    const size_t orow_p = isctx ? (size_t)ML + (size_t)(a.hb * BPH + bl) * CTXL + qloc : (size_t)(a.hb * BPH + bl) * SEQ + 256 * qb + qloc;
    bf16x8 qf[QD];
    {
        u32x4 qw[QD];
#pragma unroll
        for (int d0 = 0; d0 < QD; ++d0) qw[d0] = *(const u32x4*)(Qb + (size_t)qrow_l * qp + 16 * d0 + 8 * hi);
        if (TYPE == 1) {
            float x[4][8]; float ss = 0.f;
#pragma unroll
            for (int d0 = 0; d0 < 4; ++d0) { UNPK8(qw[d0], x[d0]);
#pragma unroll
                for (int i = 0; i < 8; ++i) ss += x[d0][i] * x[d0][i]; }
            ss = half_sum(ss);
            const float rstd = sc2 / sqrtf(ss * (1.f / 64.f) + EPS);
#pragma unroll
            for (int d0 = 0; d0 < 4; ++d0) { const f32x4 g0 = *(const f32x4*)(a.q_norm + 16 * d0 + 8 * hi), g1 = *(const f32x4*)(a.q_norm + 16 * d0 + 8 * hi + 4);
#pragma unroll
                for (int i = 0; i < 4; ++i) { x[d0][i] *= rstd * g0[i]; x[d0][4 + i] *= rstd * g1[i]; } }
            if (!isctx) { const int t = 256 * qb + qloc; const float prow = (float)(t >> 6), pcol = (float)(t & 63);
#pragma unroll
                for (int i = 0; i < 8; ++i) { const float fr_ = __builtin_amdgcn_exp2f(-(float)(8 * hi + i) * (13.287712379549449f / 16.f));
                    { const float ang = prow * fr_, cs = __cosf(ang), sn = __sinf(ang), y0 = x[0][i] * cs - x[1][i] * sn, y1 = x[1][i] * cs + x[0][i] * sn; x[0][i] = y0; x[1][i] = y1; }
                    { const float ang = pcol * fr_, cs = __cosf(ang), sn = __sinf(ang), y0 = x[2][i] * cs - x[3][i] * sn, y1 = x[3][i] * cs + x[2][i] * sn; x[2][i] = y0; x[3][i] = y1; } } }
#pragma unroll
            for (int d0 = 0; d0 < 4; ++d0) { qw[d0].x = pk2(x[d0][0], x[d0][1]); qw[d0].y = pk2(x[d0][2], x[d0][3]); qw[d0].z = pk2(x[d0][4], x[d0][5]); qw[d0].w = pk2(x[d0][6], x[d0][7]); }
        }
        if (TYPE == 2 && !isctx) {
            float x0[8], x1[8]; UNPK8(qw[4], x0); UNPK8(qw[5], x1);
            const int t = 256 * qb + qloc; const float pos = hi ? (float)(t & 63) : (float)(t >> 6);
#pragma unroll
            for (int i = 0; i < 8; ++i) { const float ang = pos * __builtin_amdgcn_exp2f(-(float)i * (13.287712379549449f / 8.f)), cs = __cosf(ang), sn = __sinf(ang);
                const float y0 = x0[i] * cs - x1[i] * sn, y1 = x1[i] * cs + x0[i] * sn; x0[i] = y0; x1[i] = y1; }
            qw[4].x = pk2(x0[0], x0[1]); qw[4].y = pk2(x0[2], x0[3]); qw[4].z = pk2(x0[4], x0[5]); qw[4].w = pk2(x0[6], x0[7]);
            qw[5].x = pk2(x1[0], x1[1]); qw[5].y = pk2(x1[2], x1[3]); qw[5].z = pk2(x1[4], x1[5]); qw[5].w = pk2(x1[6], x1[7]);
        }
#pragma unroll
        for (int d0 = 0; d0 < QD; ++d0) qf[d0] = __builtin_bit_cast(bf16x8, qw[d0]);
    }
    STORE_TILE(0, 0, kA, vA, k2A);
    if (NT > 1) LOAD_TILE(1, kA, vA, k2A);
    if (NT > 2) LOAD_TILE(2, kB, vB, k2B);
    __syncthreads();
    const int na_r = 4 * qb + (wid >> 1), na_w0 = na_r0(na_r), qc = 32 * (wid & 1) + q32;
    const int c0 = (qc - 8) < 0 ? 0 : ((qc - 8) > 48 ? 48 : (qc - 8));
    bool fresh = true; float m2 = 0.f, lsum = 0.f; f32x16 o0 = {}, o1 = {}, negm = {};
#define ATT_COMPUTE(IT) do { bool act_c = true; const bool local = (TYPE == 0) && ((IT) < nfirst); \
        if (local) { const int kr = kr_lo + (IT); act_c = (kr >= na_w0) && (kr < na_w0 + 8); } \
        if (act_c) attn_tile<QD>(qf, fresh, negm, m2, lsum, o0, o1, lds + A_KT + ((IT) & 1) * KTB + q32 * KTP + hi * 16, lds + A_VT + ((IT) & 1) * VTB + q32 * VTP + hi * 16, \
                                 local, (const LAS float*)(lds + A_BIAS) + (kr_lo + (IT) - na_r + 7) * 31 + 15 - qc, c0, hi); } while (0)
    for (int it = 0; it < NT; it += 2) {
        ATT_COMPUTE(it);
        if (it + 1 < NT) STORE_TILE(1, 1, kA, vA, k2A);
        if (it + 3 < NT) LOAD_TILE(it + 3, kA, vA, k2A);
        __syncthreads();
        if (it + 1 < NT) {
            ATT_COMPUTE(it + 1);
            if (it + 2 < NT) STORE_TILE(0, 0, kB, vB, k2B);
            if (it + 4 < NT) LOAD_TILE(it + 4, kB, vB, k2B);
            __syncthreads();
        }
    }
#undef ATT_COMPUTE
    lsum = half_sum(lsum);
    const float inv = 1.0f / lsum;
    bf16* op = a.OB + orow_p * D + ocol + 4 * hi;
#pragma unroll
    for (int g = 0; g < 4; ++g) { u32x2 w;
        w.x = pk2(o0[4 * g] * inv, o0[4 * g + 1] * inv); w.y = pk2(o0[4 * g + 2] * inv, o0[4 * g + 3] * inv); *(u32x2*)(op + 8 * g) = w;
        w.x = pk2(o1[4 * g] * inv, o1[4 * g + 1] * inv); w.y = pk2(o1[4 * g + 2] * inv, o1[4 * g + 3] * inv); *(u32x2*)(op + 32 + 8 * g) = w; }
#undef TILE_ROW
#undef LOAD_TILE
#undef STORE_TILE
}
__device__ __forceinline__ void attn_phase(const AttnArgs& a, LAS unsigned char* lds, int tid, int bid, int nbk) {
    const int nunits = 2048 + (a.with_ctx_q ? 256 : 0);
    for (int u = bid; u < nunits; u += nbk) {
        const int rnd = u >> 8, blk = u & 255, x = blk & 7, y = blk >> 3;
        int type, bl, head, qb;
        if (rnd < 4) { const int g = 4 * x + rnd; type = 1; bl = g >> 1; head = 4 * (g & 1) + (y >> 3); qb = y & 7; }
        else if (rnd < 8) { const int g = ((rnd - 4) & 1) * 32 + 4 * x + (y >> 3); type = rnd < 6 ? 2 : 0; bl = g >> 2; head = g & 3; qb = y & 7; }
        else { const int h16 = blk & 15; bl = blk >> 4; qb = -1; if (h16 < 4) { type = 0; head = h16; } else if (h16 < 12) { type = 1; head = h16 - 4; } else { type = 2; head = h16 - 12; } }
        if (type == 1) attn_unit<1>(a, bl, head, qb, lds, tid); else if (type == 2) attn_unit<2>(a, bl, head, qb, lds, tid); else attn_unit<0>(a, bl, head, qb, lds, tid);
    }
}
constexpr size_t WS_CTL = 0, CTL_ZERO_BYTES = 16384;
#define XB_TMO      128
#define XB_XCNT(j)  (256  + 64 * (j))
#define XB_XSUB(j)  (1280 + 64 * (j))
#define XB_XGEN(j)  (2304 + 64 * (j))
#define XB_TOP      3328
#define XB_TOPGEN   3392
#define XCD_BAR_WORDS 3456
#define XB_SPIN_CAP (1u << 18)

__device__ __forceinline__ unsigned xb_ld(unsigned* p)              { return __hip_atomic_load(p, __ATOMIC_RELAXED, __HIP_MEMORY_SCOPE_AGENT); }
__device__ __forceinline__ unsigned xb_add(unsigned* p, unsigned v) { return __hip_atomic_fetch_add(p, v, __ATOMIC_RELAXED, __HIP_MEMORY_SCOPE_AGENT); }
__device__ __forceinline__ unsigned xb_xcc_id() { return (unsigned)__builtin_amdgcn_s_getreg((3 << 11) | 20) & 0xFu; }
#define XB_SPIN(cond, bar) do { unsigned _sp = 0; while (cond) { __builtin_amdgcn_s_sleep(1); \
    if ((++_sp & 255u) == 0u) { if (xb_ld(&(bar)[XB_TMO])) break; if (_sp > XB_SPIN_CAP) { atomicAdd(&(bar)[XB_TMO], 1u); break; } } } } while (0)

struct XcdBarrier {
    unsigned* bar; unsigned x;
    volatile LAS unsigned* st;
};

__device__ __forceinline__ XcdBarrier xcd_barrier_post(unsigned* bar, volatile LAS unsigned* st) {
    XcdBarrier b; b.bar = bar; b.x = xb_xcc_id(); b.st = st;
    if (threadIdx.x == 0) (void)xb_add(&bar[XB_XCNT(b.x)], 1u);
    return b;
}
__device__ __forceinline__ void xcd_barrier_complete(unsigned* bar, unsigned x, unsigned& nloc, unsigned& nx) {
    const unsigned G = gridDim.x * gridDim.y * gridDim.z;
    unsigned sum, cnt, mine, sp = 0u;
    for (;;) {
        sum = 0u; cnt = 0u; mine = 0u;
#pragma unroll
        for (unsigned j = 0; j < 16; ++j) { const unsigned c = xb_ld(&bar[XB_XCNT(j)]); sum += c; cnt += (c > 0u) ? 1u : 0u; mine = (j == x) ? c : mine; }
        if (sum == G) break;
        __builtin_amdgcn_s_sleep(1);
        if ((++sp & 255u) == 0u) { if (xb_ld(&bar[XB_TMO])) break; if (sp > XB_SPIN_CAP) { atomicAdd(&bar[XB_TMO], 1u); break; } }
    }
    nloc = mine > 0u ? mine : 1u; nx = cnt > 0u ? cnt : 1u;
}

__device__ __forceinline__ void xcd_barrier(const XcdBarrier& b) {
    asm volatile("s_waitcnt vmcnt(0)" ::: "memory");
    __syncthreads();
    if (threadIdx.x == 0) {
        unsigned* bar = b.bar;
        __builtin_amdgcn_s_waitcnt(0);
        unsigned nloc = b.st[0], nx = b.st[1];
        if (nloc == 0u) { xcd_barrier_complete(bar, b.x, nloc, nx); b.st[0] = nloc; b.st[1] = nx; }
        const unsigned old = xb_add(&bar[XB_XSUB(b.x)], 1u);
        const unsigned gen = old / nloc;
        if (old + 1u == (gen + 1u) * nloc) {
            __builtin_amdgcn_fence(__ATOMIC_RELEASE, "agent");
            asm volatile("s_waitcnt vmcnt(0)" ::: "memory");
            const unsigned og = xb_add(&bar[XB_TOP], 1u);
            const unsigned tg = og / nx;
            if (og + 1u == (tg + 1u) * nx) xb_add(&bar[XB_TOPGEN], 1u);
            else XB_SPIN(xb_ld(&bar[XB_TOPGEN]) == tg, bar);
            __builtin_amdgcn_fence(__ATOMIC_ACQUIRE, "agent");
            xb_add(&bar[XB_XGEN(b.x)], 1u);
            asm volatile("s_waitcnt vmcnt(0)" ::: "memory");
        } else {
            XB_SPIN(xb_ld(&bar[XB_XGEN(b.x)]) == gen, bar);
            __builtin_amdgcn_fence(__ATOMIC_ACQUIRE, "agent");
            asm volatile("s_waitcnt vmcnt(0)" ::: "memory");
        }
    }
    __syncthreads();
}
constexpr int XB_LDS_OFF = pg8::STAGE_BYTES, LDS_BYTES = pg8::STAGE_BYTES + 64;
static_assert(A_END <= pg8::STAGE_BYTES && XCD_BAR_WORDS * 4 <= (int)CTL_ZERO_BYTES && CTL_ZERO_BYTES <= WS_SC, "LDS / ctl map");
#define GEMM_RUN(EPI_T, E, APTR, LDA, BPTR, LDB, KK, NN, NL, NC, LAT0, CTX0) do { const pg8::Gemm g_{(const bf16*)(APTR), (const bf16*)(BPTR), (LDA), (LDB), (KK)}; \
    MapOrder S_; S_.init((NL), (NC), (LAT0), (CTX0), (NN), nbk, bid); pg8::gemm_phase<EPI_T, MapOrder, EPI_T::ALIGN, true>(lds, g_, S_, E, tid); } while (0)
constexpr int PH_PER_LAYER = 4 + 5 * NCH + 4, PH_TOTAL = 2 + DEPTH * PH_PER_LAYER + 1;

__global__ void __launch_bounds__(512, 2) mega_fwd(Params p_unused) {
#if defined(__HIP_DEVICE_COMPILE__)
    extern __shared__ __attribute__((aligned(16))) unsigned char lds_raw[];
    LAS unsigned char* lds = (LAS unsigned char*)lds_raw;
    cg::grid_group grid = cg::this_grid();
    typedef const __attribute__((address_space(4))) Params* KP;
    const int wave_s = __builtin_amdgcn_readfirstlane(threadIdx.x >> 6);
    if (threadIdx.x < 16) ((LAS unsigned*)(lds + XB_LDS_OFF))[threadIdx.x] = 0u;
    __syncthreads();
    { KP pp0 = (KP)__builtin_amdgcn_kernarg_segment_ptr(); (void)xcd_barrier_post((unsigned*)(pp0->ws + WS_CTL), (volatile LAS unsigned*)(lds + XB_LDS_OFF)); }
#ifndef PROBE_KIND
#define PROBE_KIND -1
#endif
#ifndef PROBE_SYNCS
#define PROBE_SYNCS 0
#endif
    for (int ph2 = 0; ph2 < PH_TOTAL * 2; ++ph2) {
        const int ph = ph2 >> 1;
        if (ph2 & 1) { bool rep = false;
            if (PROBE_KIND >= 0 && ph >= 2 && ph < PH_TOTAL - 1) { const int st_ = (ph - 2) % PH_PER_LAYER; int k_;
                if (st_ < 3) k_ = st_; else if (st_ == 3) k_ = 0; else if (st_ < 4 + 5 * NCH) k_ = 3 + (st_ - 4) % 5; else if (st_ == 4 + 5 * NCH) k_ = 8; else k_ = st_ - (5 + 5 * NCH);
                rep = (k_ == PROBE_KIND); }
            if (PROBE_KIND == 12) rep = (ph == 4);
            if (PROBE_KIND == 13) rep = (ph == 0);
            if (!rep) continue; }
        int lane_, wv_ = wave_s, bid = blockIdx.x, nbk = gridDim.x; KP pp = (KP)__builtin_amdgcn_kernarg_segment_ptr();
        asm volatile("v_mbcnt_lo_u32_b32 %0, -1, 0\n\tv_mbcnt_hi_u32_b32 %0, -1, %0" : "=v"(lane_));
        asm volatile("" : "+s"(wv_), "+s"(bid), "+s"(nbk), "+s"(pp));
        int tid = wv_ * 64 + lane_; asm volatile("" : "+v"(tid));
        unsigned char* ws = pp->ws;
        float* MOD = (float*)(ws + WS_MOD); float* CTXRES = (float*)(ws + WS_CTXRES);
        bf16* NBp = (bf16*)(ws + WS_NB);
        if (ph == 0) { { const Params p = *pp; prep_phase(p, lds, tid, bid, nbk, 0, PREP_ADA + PREP_PER_LAYER, 0, true); } __syncthreads(); }
        else if (ph == 1) { EpiAda E; E.MOD = MOD; E.b_ada = pp->b_ada; GEMM_RUN(EpiAda, E, ws + WS_SC, D, ws + WS_WADA, D, D, 2 * MODW, 1, 0, 0, 0); }
        else if (ph == PH_TOTAL - 1) { final_phase(pp->out, pp->final_norm, tid, bid, nbk); }
        else {
            const int L = (ph - 2) / PH_PER_LAYER, st = (ph - 2) % PH_PER_LAYER;
            const bool last = (L == DEPTH - 1);
            const float* modl = MOD + (size_t)L * 33 * MODW;
            const unsigned char* wl = ws + WS_W + (size_t)L * LW_SIZE;
            int kind, which = 0, hb = 0;
            if (st < 3) { kind = st; which = 0; }
            else if (st == 3) { kind = 0; which = 1; }
            else if (st < 4 + 5 * NCH) { hb = (st - 4) / 5; kind = 3 + (st - 4) % 5; }
            else if (st == 4 + 5 * NCH) { kind = 8; }
            else { kind = st - (5 + 5 * NCH); which = 2; }
            const bool first_in = (L == 0 && which == 0);
            const float* xl = first_in ? pp->x : pp->out; const float* xc = first_in ? pp->ctx : CTXRES;
            const int nctx = (last && (which == 2 || kind >= 7)) ? 0 : 32;
            if (kind == 0) {
                const float* gain = (which == 0 ? pp->f1_norm : which == 1 ? pp->mix_norm : pp->f2_norm) + L * D;
                normmod_phase(xl, xc, gain, modl, 3 * which, NBp, nctx ? MT : ML, tid, bid, nbk);
            } else if (kind == 1) {
                EpiSwiGLU E; E.H = (bf16*)(ws + WS_H);
                GEMM_RUN(EpiSwiGLU, E, NBp, D, wl + (which == 0 ? LW_U1 : LW_U2), D, D, 2 * DFF, 256, nctx, 0, 256);
            } else if (kind == 2) {
                EpiResid E; E.src_lat = xl; E.src_ctx = xc; E.dst_lat = pp->out; E.dst_ctx = CTXRES; E.modl = modl; E.gidx = which == 0 ? 2 : 8; E.coef = 0.5f;
                GEMM_RUN(EpiResid, E, ws + WS_H, DFF, wl + (which == 0 ? LW_D1 : LW_D2), DFF, DFF, D, 256, nctx, 0, 256);
                if (L == 0 && DEPTH > 1) { const int lo_ = PREP_ADA + PREP_PER_LAYER + (which == 0 ? 0 : PREP_PER_LAYER / 2), hi_ = PREP_ADA + PREP_PER_LAYER + (which == 0 ? PREP_PER_LAYER / 2 : PREP_PER_LAYER);
                    __syncthreads(); const Params p = *pp; prep_phase(p, lds, tid, bid, nbk, lo_, hi_, nbk / 2, false); __syncthreads(); }
            } else if (kind == 8) {
                EpiResid E; E.src_lat = pp->out; E.src_ctx = CTXRES; E.dst_lat = pp->out; E.dst_ctx = CTXRES; E.modl = modl; E.gidx = 5; E.coef = 1.0f;
                GEMM_RUN(EpiResid, E, ws + WS_Y, D, wl + LW_OUT, D, D, D, 256, nctx, 0, 256);
            } else if (kind == 3) {
                EpiWin E; E.bA = (bf16*)(ws + WS_BA); E.bB = (bf16*)(ws + WS_BB); E.bC = (bf16*)(ws + WS_BC); E.G = (bf16*)(ws + WS_G); E.hb = hb;
                if (!last) { GEMM_RUN(EpiWin, E, NBp, D, wl + LW_IN, D, D, INWP, HL / 256, HC / 256, (HL / 256) * hb, 256 + (HC / 256) * hb); }
                else {
                    GEMM_RUN(EpiWin, E, NBp, D, wl + LW_IN, D, D, INWP, HL / 256, 0, (HL / 256) * hb, 0);
                    { const pg8::Gemm g_{(const bf16*)NBp, (const bf16*)(wl + LW_IN), D, D, D}; MapOrder S_; S_.init(0, HC / 256, 0, 256 + (HC / 256) * hb, 4 * 256, nbk, (bid + nbk / 2) % nbk); S_.cmap = 0x7521ull;
                      pg8::gemm_phase<EpiWin, MapOrder, EpiWin::ALIGN, true>(lds, g_, S_, E, tid); } }
            } else if (kind == 4) {
                post_phase((bf16*)(ws + WS_BB), (bf16*)(ws + WS_BC), pp->k_norm + L * 64, pp->mq_norm + L * 256, pp->mkv_norm + L * 128, tid, bid, nbk);
            } else if (kind == 5) {
                for (int s = 0; s < 2; ++s) { EpiPlain E; E.O = (bf16*)(ws + (s ? WS_MKV : WS_MQ)); E.ldc = 512; E.scale = s ? 1.0f : 0.10206207261596575f * LOG2E;
                    GEMM_RUN(EpiPlain, E, (bf16*)(ws + WS_BC) + (s ? 256 : 0), 512, wl + (s ? LW_UKV : LW_UQ), s ? 128 : 256, s ? 128 : 256, 512, HM / 256, 0, 0, 0); }
            } else if (kind == 6) {
                AttnArgs a; a.bA = (const bf16*)(ws + WS_BA); a.bB = (const bf16*)(ws + WS_BB); a.bC = (const bf16*)(ws + WS_BC); a.MQ = (const bf16*)(ws + WS_MQ); a.MKV = (const bf16*)(ws + WS_MKV); a.OB = NBp;
                a.q_norm = pp->q_norm + L * 64; a.na_bias = pp->na_bias + (size_t)L * 4 * 465; a.hb = hb; a.with_ctx_q = last ? 0 : 1;
                attn_phase(a, lds, tid, bid, nbk);
            } else {
                EpiBranch E; E.G = (const bf16*)(ws + WS_G); E.Y = (bf16*)(ws + WS_Y); E.hb = hb;
                GEMM_RUN(EpiBranch, E, NBp, D, wl + LW_BR, D, D, D, HL / 256, nctx ? HC / 256 : 0, (HL / 256) * hb, 256 + (HC / 256) * hb);
            }
        }
        if (ph + 1 < PH_TOTAL) {
            if (ph == 0) grid.sync();
            else { XcdBarrier xb_; xb_.bar = (unsigned*)(pp->ws + WS_CTL); xb_.x = xb_xcc_id(); xb_.st = (volatile LAS unsigned*)(lds + XB_LDS_OFF); xcd_barrier(xb_); }
            for (int e_ = 0; e_ < PROBE_SYNCS; ++e_) grid.sync(); }
    }
#endif
}

extern "C" void kernel_launch(void* const* d_in, const int* in_sizes, int n_in, void* d_out, int out_size, void* d_ws, size_t ws_size, hipStream_t stream) {
    static int grid = 0;
    if (grid == 0) {
        if (n_in != 28 || out_size != ML * D || ws_size < (size_t)1024 * MiB) { fprintf(stderr, "kernel_launch: unexpected problem (n_in %d, out %d, ws %zu)\n", n_in, out_size, ws_size); grid = -1; return; }
        int dev = 0, cus = 0, per_cu = 0;
        (void)hipGetDevice(&dev); (void)hipDeviceGetAttribute(&cus, hipDeviceAttributeMultiprocessorCount, dev);
        (void)hipFuncSetAttribute((const void*)mega_fwd, hipFuncAttributeMaxDynamicSharedMemorySize, LDS_BYTES);
        (void)hipOccupancyMaxActiveBlocksPerMultiprocessor(&per_cu, (const void*)mega_fwd, 512, LDS_BYTES);
        if (per_cu < 1) per_cu = 1;
        grid = cus * per_cu;
    }
    if (grid < 0) return;
    if (hipMemsetAsync((char*)d_ws + WS_CTL, 0, CTL_ZERO_BYTES, stream) != hipSuccess) { fprintf(stderr, "kernel_launch: memset of barrier words failed\n"); return; }
    Params p{};
    const float* const* in = (const float* const*)d_in;
    p.x = in[0]; p.c = in[1]; p.ctx = in[2]; p.c_ctx = in[3]; p.w_ada = in[4]; p.b_ada = in[5];
    p.f1_norm = in[6]; p.f1_wg = in[7]; p.f1_wu = in[8]; p.f1_wd = in[9];
    p.mix_norm = in[10]; p.w_in = in[11]; p.na_bias = in[12]; p.q_norm = in[13]; p.k_norm = in[14]; p.mq_norm = in[15]; p.mkv_norm = in[16];
    p.w_uq = in[17]; p.w_ukv = in[18]; p.w_ba = in[19]; p.w_bb = in[20]; p.w_bc = in[21]; p.w_out = in[22];
    p.f2_norm = in[23]; p.f2_wg = in[24]; p.f2_wu = in[25]; p.f2_wd = in[26]; p.final_norm = in[27];
    p.out = (float*)d_out; p.ws = (unsigned char*)d_ws;
    void* args[] = {&p};
    hipError_t e = hipLaunchCooperativeKernel((const void*)mega_fwd, dim3(grid), dim3(512), args, LDS_BYTES, stream);
    if (e != hipSuccess) fprintf(stderr, "cooperative launch failed: %s (grid %d)\n", hipGetErrorString(e), grid);
}
```

```cpp
#include <hip/hip_runtime.h>
#include <hip/hip_cooperative_groups.h>
#include <cstdio>
#include <cstdint>
namespace cg = cooperative_groups;
namespace pg8 {
#define PG8_LAS __attribute__((address_space(3)))
typedef unsigned short bf16_t;
typedef short bf16x8 __attribute__((ext_vector_type(8)));
typedef float f32x4 __attribute__((ext_vector_type(4)));
typedef unsigned u32x4 __attribute__((ext_vector_type(4)));
constexpr int BM = 256, BK = 64, HALF = 128, HTB = HALF * BK * 2  , STAGE_BYTES = 8 * HTB, NXCD = 8, WGM = 8;

__host__ __device__ __forceinline__ int lds_byte(int r, int c) { const int st = (r >> 4) * 2 + (c >> 5), rr = r & 15, cc = c & 31, ob = rr * 64 + cc * 2; return st * 1024 + (ob ^ (((ob >> 9) & 1) << 5)); }
__host__ __device__ __forceinline__ void stage_rc(int b, int& R, int& C) { const int st = b / 1024, sb = b % 1024, swz = sb ^ (((sb >> 9) & 1) << 5); R = (st >> 1) * 16 + swz / 64; C = (st & 1) * 32 + (swz % 64) / 2; }
__host__ __device__ __forceinline__ int perm32(int rho) { const int n = rho >> 4, i = rho & 15; return 8 * (i >> 2) + 4 * n + (i & 3); }

struct Unit { int pm, pn; };
struct Gemm { const bf16_t* A; const bf16_t* Bt; int lda, ldb, K; };

struct StaticOrder {
    int nM, nN, nwg, G, c;
    __host__ __device__ void init(int M, int N, int G_, int c_) { nM = M / BM; nN = N / BM; nwg = nM * nN; G = G_; c = c_; }
    __host__ __device__ bool next(int i, Unit& u) const {
        const long L = (long)i * G + c; if (L >= nwg) return false;
        int wgid = (int)L; { const int q = nwg / NXCD, r = nwg % NXCD, xcd = wgid % NXCD, off = wgid / NXCD; wgid = (xcd < r ? xcd * (q + 1) : r * (q + 1) + (xcd - r) * q) + off; }
        const int nig = WGM * nN, gid = wgid / nig, fm = gid * WGM, gsz = (nM - fm) < WGM ? (nM - fm) : WGM;
        u.pm = fm + ((wgid % nig) % gsz); u.pn = (wgid % nig) / gsz; return true;
    }
    __device__ __forceinline__ void a_ready(const Unit&) const {}
    __device__ __forceinline__ void done(const Unit&) const {}
};

__device__ __forceinline__ unsigned cvt_pk_bf16(float lo, float hi) { unsigned r; asm volatile("v_cvt_pk_bf16_f32 %0, %1, %2" : "=v"(r) : "v"(lo), "v"(hi)); return r; }
template <class Epi, class Sched, bool ALIGN_EPI = false, bool SP2 = false>
__device__ __forceinline__ void gemm_phase(PG8_LAS unsigned char* lds, const Gemm g, const Sched& S, const Epi& E, const int tid) {
    const int wid = __builtin_amdgcn_readfirstlane(tid >> 6), lane = tid & 63, wr = wid >> 2, wc = wid & 3, fr = lane & 15, fq = lane >> 4;
    const int K = g.K, nt = K / BK;
    unsigned voffA[2], voffB[2];
#pragma unroll
    for (int i = 0; i < 2; ++i) { int R, C; stage_rc(tid * 16 + i * 8192, R, C); const int Rb = Epi::PERM ? ((R & ~31) + perm32(R & 31)) : R;
        voffA[i] = (unsigned)(R * g.lda + C) * 2u; voffB[i] = (unsigned)(Rb * g.ldb + C) * 2u; }
    const size_t kstep = (size_t)(BK * 2);
    const size_t hstepA = (size_t)HALF * g.lda * 2, hstepB = (size_t)HALF * g.ldb * 2;
    const size_t tstepA = 2 * hstepA, tstepB = 2 * hstepB;
    const unsigned ldsw = (unsigned)wid * 1024u;
    const int aoff = lds_byte(wr * 64 + fr, fq * 8), boff = lds_byte(wc * 32 + fr, fq * 8);
#define PG8_SA(b, h) (((b) * 2 + (h)) * HTB)
#define PG8_SB(b, h) ((4 + (b) * 2 + (h)) * HTB)
#define PG8_STAGE(bufoff, gbase, voff) do { _Pragma("unroll") for (int _i = 0; _i < 2; ++_i) \
        __builtin_amdgcn_global_load_lds((const unsigned*)((const char*)(gbase) + (voff)[_i]), (PG8_LAS unsigned*)(lds + (bufoff) + ldsw + _i * 8192), 16, 0, 0); } while (0)
#define PG8_LDA(dst, b, h) do { _Pragma("unroll") for (int m = 0; m < 4; ++m) _Pragma("unroll") for (int k = 0; k < 2; ++k) dst[m][k] = *(const PG8_LAS bf16x8*)(lds + PG8_SA(b, h) + aoff + m * 2048 + k * 1024); } while (0)
#define PG8_LDB(dst, b, h) do { _Pragma("unroll") for (int n = 0; n < 2; ++n) _Pragma("unroll") for (int k = 0; k < 2; ++k) dst[n][k] = *(const PG8_LAS bf16x8*)(lds + PG8_SB(b, h) + boff + n * 2048 + k * 1024); } while (0)
#define PG8_MMA(ai, bj, At, Bt) do { __builtin_amdgcn_s_setprio(1); _Pragma("unroll") for (int m = 0; m < 4; ++m) _Pragma("unroll") for (int n = 0; n < 2; ++n) _Pragma("unroll") for (int k = 0; k < 2; ++k) \
        acc[ai][bj][m][n] = __builtin_amdgcn_mfma_f32_16x16x32_bf16(Bt[n][k], At[m][k], acc[ai][bj][m][n], 0, 0, 0); __builtin_amdgcn_s_setprio(0); } while (0)
#define PG8_WAIT_V(n) asm volatile("s_waitcnt vmcnt(" #n ")" ::: "memory")
#define PG8_WAIT_L(n) asm volatile("s_waitcnt lgkmcnt(" #n ")" ::: "memory")
#define PG8_BAR __builtin_amdgcn_s_barrier()
#define PG8_SCHED __builtin_amdgcn_sched_barrier(0)
    Unit cur, nxt; int ui = 0;
    if (!S.next(0, cur)) return;
    f32x4 acc[2][2][4][2];
#pragma unroll
    for (int a = 0; a < 2; ++a)
#pragma unroll
        for (int b = 0; b < 2; ++b)
#pragma unroll
            for (int m = 0; m < 4; ++m)
#pragma unroll
                for (int n = 0; n < 2; ++n) acc[a][b][m][n] = (f32x4){0.f, 0.f, 0.f, 0.f};
    bf16x8 At[4][2], B0[2][2], B1[2][2];
    const char* cA = (const char*)g.A + (size_t)cur.pm * tstepA; const char* cB = (const char*)g.Bt + (size_t)cur.pn * tstepB;
    S.a_ready(cur);
    if constexpr (SP2) {
        PG8_STAGE(PG8_SB(0, 0), cB, voffB); PG8_STAGE(PG8_SB(0, 1), cB + hstepB, voffB); PG8_STAGE(PG8_SA(0, 0), cA, voffA); PG8_STAGE(PG8_SA(0, 1), cA + hstepA, voffA);
        if (wr == 1) PG8_BAR;
        PG8_WAIT_V(2); PG8_BAR;
        PG8_STAGE(PG8_SB(1, 0), cB + kstep, voffB); PG8_STAGE(PG8_SA(1, 0), cA + kstep, voffA); PG8_STAGE(PG8_SB(1, 1), cB + hstepB + kstep, voffB);
        PG8_WAIT_V(6); PG8_BAR;
    } else {
        PG8_STAGE(PG8_SB(0, 0), cB, voffB); PG8_STAGE(PG8_SA(0, 0), cA, voffA); PG8_STAGE(PG8_SB(0, 1), cB + hstepB, voffB); PG8_STAGE(PG8_SA(0, 1), cA + hstepA, voffA);
        if (wr == 1) PG8_BAR;
        PG8_WAIT_V(4); PG8_BAR;
        PG8_STAGE(PG8_SB(1, 0), cB + kstep, voffB); PG8_STAGE(PG8_SA(1, 0), cA + kstep, voffA); PG8_STAGE(PG8_SB(1, 1), cB + hstepB + kstep, voffB);
        PG8_WAIT_V(6); PG8_BAR;
    }
    for (;;) {
        const bool has_next = S.next(ui + 1, nxt);
        const char* nA = has_next ? (const char*)g.A + (size_t)nxt.pm * tstepA : cA; const char* nB = has_next ? (const char*)g.Bt + (size_t)nxt.pn * tstepB : cB;
        for (int t = 0; t < nt; t += 2) {
            const bool last = (t == nt - 2);
            const char* a1 = cA + (size_t)(t + 1) * kstep;
            const char* a2 = last ? nA : cA + (size_t)(t + 2) * kstep; const char* b2 = last ? nB : cB + (size_t)(t + 2) * kstep;
            const char* a3 = a2 + kstep; const char* b3 = b2 + kstep;
            if (last && has_next) S.a_ready(nxt);
            if constexpr (SP2) {
            PG8_LDB(B0, 0, 0); PG8_LDB(B1, 0, 1); PG8_SCHED; PG8_LDA(At, 0, 0); PG8_STAGE(PG8_SA(1, 1), a1 + hstepA, voffA);
            PG8_WAIT_V(8); PG8_WAIT_L(0); PG8_BAR; PG8_MMA(0, 0, At, B0); PG8_MMA(0, 1, At, B1); PG8_BAR; PG8_SCHED;
            PG8_LDA(At, 0, 1); PG8_STAGE(PG8_SB(0, 0), b2, voffB); PG8_STAGE(PG8_SB(0, 1), b2 + hstepB, voffB); PG8_STAGE(PG8_SA(0, 0), a2, voffA);
            PG8_WAIT_V(8); PG8_WAIT_L(0); PG8_BAR; PG8_MMA(1, 0, At, B0); PG8_MMA(1, 1, At, B1); PG8_BAR; PG8_SCHED;
            PG8_LDB(B0, 1, 0); PG8_LDB(B1, 1, 1); PG8_SCHED; PG8_LDA(At, 1, 0); PG8_STAGE(PG8_SA(0, 1), a2 + hstepA, voffA);
            PG8_WAIT_V(8); PG8_WAIT_L(0); PG8_BAR; PG8_MMA(0, 0, At, B0); PG8_MMA(0, 1, At, B1); PG8_BAR; PG8_SCHED;
            PG8_LDA(At, 1, 1); PG8_STAGE(PG8_SB(1, 0), b3, voffB); PG8_STAGE(PG8_SB(1, 1), b3 + hstepB, voffB); PG8_STAGE(PG8_SA(1, 0), a3, voffA);
            PG8_WAIT_V(8); PG8_WAIT_L(0); PG8_BAR; PG8_MMA(1, 0, At, B0); PG8_MMA(1, 1, At, B1); PG8_BAR; PG8_SCHED;
            } else {
            PG8_LDB(B0, 0, 0); PG8_SCHED; PG8_LDA(At, 0, 0); PG8_STAGE(PG8_SA(1, 1), a1 + hstepA, voffA);
            PG8_WAIT_L(8); PG8_BAR; PG8_WAIT_L(0); PG8_MMA(0, 0, At, B0); PG8_BAR; PG8_SCHED;
            PG8_LDB(B1, 0, 1); PG8_STAGE(PG8_SB(0, 0), b2, voffB);
            PG8_BAR; PG8_WAIT_L(0); PG8_MMA(0, 1, At, B1); PG8_BAR;
            PG8_LDA(At, 0, 1); PG8_STAGE(PG8_SA(0, 0), a2, voffA);
            PG8_BAR; PG8_WAIT_L(0); PG8_MMA(1, 0, At, B0); PG8_BAR; PG8_SCHED;
            PG8_STAGE(PG8_SB(0, 1), b2 + hstepB, voffB);
            PG8_WAIT_V(6); PG8_BAR; PG8_MMA(1, 1, At, B1); PG8_BAR;
            PG8_LDB(B0, 1, 0); PG8_SCHED; PG8_LDA(At, 1, 0); PG8_STAGE(PG8_SA(0, 1), a2 + hstepA, voffA);
            PG8_WAIT_L(8); PG8_BAR; PG8_WAIT_L(0); PG8_MMA(0, 0, At, B0); PG8_BAR; PG8_SCHED;
            PG8_LDB(B1, 1, 1); PG8_STAGE(PG8_SB(1, 0), b3, voffB);
            PG8_BAR; PG8_WAIT_L(0); PG8_MMA(0, 1, At, B1); PG8_BAR;
            PG8_LDA(At, 1, 1); PG8_STAGE(PG8_SA(1, 0), a3, voffA);
            PG8_BAR; PG8_WAIT_L(0); PG8_MMA(1, 0, At, B0); PG8_BAR; PG8_SCHED;
            PG8_STAGE(PG8_SB(1, 1), b3 + hstepB, voffB);
            PG8_WAIT_V(6); PG8_BAR; PG8_MMA(1, 1, At, B1); PG8_BAR;
            }
            if constexpr (Epi::HAS_MID) { if (t + 2 == Epi::MID1 || t + 2 == Epi::MID2) E.mid(acc, cur, t + 2, wr, wc, fr, fq); }
        }
        if constexpr (ALIGN_EPI) { if (wr == 0) PG8_BAR; }
        if constexpr (!Epi::AFTER_DRAIN) { E(acc, cur, wr, wc, fr, fq); S.done(cur); }
        if (!has_next) break;
#pragma unroll
        for (int a = 0; a < 2; ++a)
#pragma unroll
            for (int b = 0; b < 2; ++b)
#pragma unroll
                for (int m = 0; m < 4; ++m)
#pragma unroll
                    for (int n = 0; n < 2; ++n) acc[a][b][m][n] = (f32x4){0.f, 0.f, 0.f, 0.f};
        cur = nxt; cA = nA; cB = nB; ++ui;
        if constexpr (ALIGN_EPI) { if (wr == 1) PG8_BAR; }
    }
    PG8_WAIT_V(0);
    if constexpr (!ALIGN_EPI) { if (wr == 0) PG8_BAR; }
    PG8_BAR;
    if constexpr (Epi::AFTER_DRAIN) { E.fused(acc, cur, wr, wc, fr, fq, lds, wid, lane); S.done(cur); }
#undef PG8_SA
#undef PG8_SB
#undef PG8_STAGE
#undef PG8_LDA
#undef PG8_LDB
#undef PG8_MMA
#undef PG8_WAIT_V
#undef PG8_WAIT_L
#undef PG8_BAR
#undef PG8_SCHED
}
}
using pg8::Unit; using pg8::f32x4; using pg8::u32x4; using pg8::bf16x8;
typedef unsigned short bf16;
#define LAS __attribute__((address_space(3)))
typedef float f32x16 __attribute__((ext_vector_type(16)));
typedef float f32x2 __attribute__((ext_vector_type(2)));
typedef unsigned u32x2 __attribute__((ext_vector_type(2)));

constexpr int D = 1024, NBATCH = 32, SEQ = 2048, CTXL = 256, DFF = 2816, DEPTH = 2;
constexpr int ML = NBATCH * SEQ, MC = NBATCH * CTXL, MT = ML + MC;
constexpr int MODW = 9 * D;
constexpr int INW = 5024, INWP = 5120;
constexpr int NCH = 2, BPH = NBATCH / NCH;
constexpr int HL = BPH * SEQ, HC = BPH * CTXL, HM = HL + HC;
constexpr float EPS = 1e-6f, LOG2E = 1.4426950408889634f;

constexpr size_t MiB = 1u << 20;
constexpr size_t WS_SC = 1 * MiB;
constexpr size_t WS_MOD = 2 * MiB;
constexpr size_t WS_CTXRES = 8 * MiB;
constexpr size_t WS_W = 40 * MiB;
constexpr size_t LW_U1 = 0, LW_D1 = LW_U1 + (size_t)2 * DFF * D * 2, LW_U2 = LW_D1 + (size_t)D * DFF * 2, LW_D2 = LW_U2 + (size_t)2 * DFF * D * 2,
                 LW_IN = LW_D2 + (size_t)D * DFF * 2, LW_UQ = LW_IN + (size_t)INWP * D * 2, LW_UKV = LW_UQ + (size_t)512 * 256 * 2, LW_BR = LW_UKV + (size_t)512 * 128 * 2,
                 LW_OUT = LW_BR + (size_t)D * D * 2, LW_SIZE = LW_OUT + (size_t)D * D * 2;
static_assert(WS_W + 2 * LW_SIZE <= 136 * MiB, "weights");
constexpr size_t WS_NB = 136 * MiB;
constexpr size_t WS_Y = 280 * MiB;
constexpr size_t WS_BIG = 424 * MiB;
constexpr size_t WS_H = WS_BIG;
constexpr size_t WS_WADA = WS_BIG;
constexpr size_t WS_BA = WS_BIG;
constexpr size_t WS_BB = WS_BA + (size_t)HM * 768 * 2;
constexpr size_t WS_BC = WS_BB + (size_t)HM * 768 * 2;
constexpr size_t WS_MQ = WS_BC + (size_t)HM * 512 * 2;
constexpr size_t WS_MKV = WS_MQ + (size_t)HM * 512 * 2;
constexpr size_t WS_G = WS_MKV + (size_t)HM * 512 * 2;
constexpr size_t WS_END = WS_G + (size_t)HM * 3072 * 2;
static_assert(WS_END <= 1024 * MiB && WS_H + (size_t)MT * DFF * 2 <= 1024 * MiB, "ws map");

struct Params {
    const float* x; const float* c; const float* ctx; const float* c_ctx; const float* w_ada; const float* b_ada;
    const float* f1_norm; const float* f1_wg; const float* f1_wu; const float* f1_wd;
    const float* mix_norm; const float* w_in; const float* na_bias; const float* q_norm; const float* k_norm; const float* mq_norm; const float* mkv_norm;
    const float* w_uq; const float* w_ukv; const float* w_ba; const float* w_bb; const float* w_bc; const float* w_out;
    const float* f2_norm; const float* f2_wg; const float* f2_wu; const float* f2_wd; const float* final_norm;
    float* out; unsigned char* ws;
};

__device__ __forceinline__ float bf2f(unsigned v) { return __uint_as_float(v << 16); }
typedef __bf16 bf16x2_t __attribute__((ext_vector_type(2)));
__device__ __forceinline__ unsigned pk2(float lo, float hi) { const f32x2 v = {lo, hi}; const bf16x2_t b = __builtin_convertvector(v, bf16x2_t); return __builtin_bit_cast(unsigned, b); }
__device__ __forceinline__ float fsilu(float x) { return x * __builtin_amdgcn_rcpf(1.f + __builtin_amdgcn_exp2f(-x * LOG2E)); }
__device__ __forceinline__ float fsigm(float x) { return __builtin_amdgcn_rcpf(1.f + __builtin_amdgcn_exp2f(-x * LOG2E)); }
template <int M> __device__ __forceinline__ float swz_xor(float v) { return __int_as_float(__builtin_amdgcn_ds_swizzle(__float_as_int(v), (M << 10) | 0x1f)); }
__device__ __forceinline__ float half_sum(float v) { auto rr = __builtin_amdgcn_permlane32_swap(__float_as_uint(v), __float_as_uint(v), false, false); return __uint_as_float(rr[0]) + __uint_as_float(rr[1]); }
__device__ __forceinline__ float half_max(float v) { auto rr = __builtin_amdgcn_permlane32_swap(__float_as_uint(v), __float_as_uint(v), false, false); return __builtin_fmaxf(__uint_as_float(rr[0]), __uint_as_float(rr[1])); }
__device__ __forceinline__ float sum32(float v) { v += swz_xor<1>(v); v += swz_xor<2>(v); v += swz_xor<4>(v); v += swz_xor<8>(v); v += swz_xor<16>(v); return v; }
__device__ __forceinline__ float wave_sum(float v) { return half_sum(sum32(v)); }
#define UNPK8(W_, f) do { const u32x4 w__ = (W_); f[0] = bf2f(w__[0] & 0xffffu); f[1] = __uint_as_float(w__[0] & 0xffff0000u); f[2] = bf2f(w__[1] & 0xffffu); f[3] = __uint_as_float(w__[1] & 0xffff0000u); \
                         f[4] = bf2f(w__[2] & 0xffffu); f[5] = __uint_as_float(w__[2] & 0xffff0000u); f[6] = bf2f(w__[3] & 0xffffu); f[7] = __uint_as_float(w__[3] & 0xffff0000u); } while (0)

struct MapOrder {
    pg8::StaticOrder s; int nl, lat0, ctx0; unsigned long long cmap;
    __device__ __forceinline__ void init(int nl_, int nc_, int lat0_, int ctx0_, int N, int G, int c) { nl = nl_; lat0 = lat0_; ctx0 = ctx0_; cmap = 0ull; s.init((nl_ + nc_) * 256, N, G, c); }
    __device__ __forceinline__ bool next(int i, Unit& u) const { if (!s.next(i, u)) return false; u.pm = u.pm < nl ? lat0 + u.pm : ctx0 + (u.pm - nl);
        if (cmap) u.pn = (int)((cmap >> (4 * u.pn)) & 15ull); return true; }
    __device__ __forceinline__ void a_ready(const Unit&) const {}
    __device__ __forceinline__ void done(const Unit&) const {}
};

#ifndef RESID_ALIGN
#define RESID_ALIGN false
#endif
#define EPI_COMMON static constexpr bool PERM = true, AFTER_DRAIN = false
#define EPI_NOMID static constexpr bool HAS_MID = false; static constexpr int MID1 = -1, MID2 = -1; \
    __device__ __forceinline__ void mid(f32x4 (&)[2][2][4][2], const Unit&, int, int, int, int, int) const {}
typedef f32x4 Acc[2][2][4][2];

struct EpiSwiGLU { EPI_COMMON; static constexpr bool ALIGN = true; EPI_NOMID; bf16* H;
    __device__ __forceinline__ void operator()(const Acc& acc, const Unit& u, int wr, int wc, int fr, int fq) const {
        const int row0 = u.pm * 256 + wr * 64 + fr, col0 = u.pn * 128 + wc * 32 + 8 * fq;
#pragma unroll
        for (int ai = 0; ai < 2; ++ai)
#pragma unroll
            for (int m = 0; m < 4; ++m) {
                const f32x4 g0 = acc[ai][0][m][0], g1 = acc[ai][0][m][1], u0 = acc[ai][1][m][0], u1 = acc[ai][1][m][1];
                u32x4 w; w.x = pk2(fsilu(g0[0]) * u0[0], fsilu(g0[1]) * u0[1]); w.y = pk2(fsilu(g0[2]) * u0[2], fsilu(g0[3]) * u0[3]);
                w.z = pk2(fsilu(g1[0]) * u1[0], fsilu(g1[1]) * u1[1]); w.w = pk2(fsilu(g1[2]) * u1[2], fsilu(g1[3]) * u1[3]);
                *(u32x4*)(H + (size_t)(row0 + ai * 128 + m * 16) * DFF + col0) = w; }
    }
};
struct EpiResid { EPI_COMMON; static constexpr bool ALIGN = RESID_ALIGN; EPI_NOMID; const float* src_lat; const float* src_ctx; float* dst_lat; float* dst_ctx; const float* modl; int gidx; float coef;
    __device__ __forceinline__ void operator()(const Acc& acc, const Unit& u, int wr, int wc, int fr, int fq) const {
        const bool isl = u.pm < 256;
        const float* src = isl ? src_lat + (size_t)u.pm * 256 * D : src_ctx + (size_t)(u.pm - 256) * 256 * D;
        float* dst = isl ? dst_lat + (size_t)u.pm * 256 * D : dst_ctx + (size_t)(u.pm - 256) * 256 * D;
        const float* gate = modl + (size_t)(isl ? (u.pm >> 3) : 32) * MODW + gidx * D;
        const int col0 = u.pn * 256 + wc * 32 + 8 * fq;
#pragma unroll
        for (int bj = 0; bj < 2; ++bj) {
            const f32x4 g0 = *(const f32x4*)(gate + col0 + bj * 128) * coef, g1 = *(const f32x4*)(gate + col0 + bj * 128 + 4) * coef;
            f32x4 x0[8], x1[8];
#pragma unroll
            for (int g = 0; g < 8; ++g) { const size_t off = (size_t)((g >> 2) * 128 + wr * 64 + (g & 3) * 16 + fr) * D + col0 + bj * 128;
                x0[g] = *(const f32x4*)(src + off); x1[g] = *(const f32x4*)(src + off + 4); }
            __builtin_amdgcn_sched_barrier(0);
#pragma unroll
            for (int g = 0; g < 8; ++g) { const size_t off = (size_t)((g >> 2) * 128 + wr * 64 + (g & 3) * 16 + fr) * D + col0 + bj * 128;
                *(f32x4*)(dst + off) = x0[g] + g0 * acc[g >> 2][bj][g & 3][0]; *(f32x4*)(dst + off + 4) = x1[g] + g1 * acc[g >> 2][bj][g & 3][1]; }
            __builtin_amdgcn_sched_barrier(0);
        }
    }
};
__device__ __forceinline__ int ltile(int pm, int hb) { return pm < 256 ? pm - (HL / 256) * hb : (HL / 256) + (pm - 256 - (HC / 256) * hb); }
struct EpiWin { EPI_COMMON; static constexpr bool ALIGN = true; EPI_NOMID; bf16* bA; bf16* bB; bf16* bC; bf16* G; int hb;
    __device__ __forceinline__ void operator()(const Acc& acc, const Unit& u, int wr, int wc, int fr, int fq) const {
        const int lrow0 = ltile(u.pm, hb) * 256 + wr * 64 + fr;
        bf16* base; int ld, ct; bool sg = false;
        if (u.pn < 3) { base = bA; ld = 768; ct = u.pn; } else if (u.pn < 6) { base = bB; ld = 768; ct = u.pn - 3; } else if (u.pn < 8) { base = bC; ld = 512; ct = u.pn - 6; } else { base = G; ld = 3072; ct = u.pn - 8; sg = true; }
        const int col0 = ct * 256 + wc * 32 + 8 * fq;
        const float qs = u.pn == 0 ? 0.125f * LOG2E : 1.0f;
#pragma unroll
        for (int ai = 0; ai < 2; ++ai)
#pragma unroll
            for (int m = 0; m < 4; ++m) { bf16* rp = base + (size_t)(lrow0 + ai * 128 + m * 16) * ld + col0;
#pragma unroll
                for (int bj = 0; bj < 2; ++bj) { f32x4 v0 = acc[ai][bj][m][0] * qs, v1 = acc[ai][bj][m][1] * qs;
                    if (sg) { v0 = (f32x4){fsigm(v0[0]), fsigm(v0[1]), fsigm(v0[2]), fsigm(v0[3])}; v1 = (f32x4){fsigm(v1[0]), fsigm(v1[1]), fsigm(v1[2]), fsigm(v1[3])}; }
                    u32x4 w; w.x = pk2(v0[0], v0[1]); w.y = pk2(v0[2], v0[3]); w.z = pk2(v1[0], v1[1]); w.w = pk2(v1[2], v1[3]);
                    *(u32x4*)(rp + bj * 128) = w; } }
    }
};
struct EpiPlain { EPI_COMMON; static constexpr bool ALIGN = true; EPI_NOMID; bf16* O; int ldc; float scale;
    __device__ __forceinline__ void operator()(const Acc& acc, const Unit& u, int wr, int wc, int fr, int fq) const {
        const int row0 = u.pm * 256 + wr * 64 + fr, col0 = u.pn * 256 + wc * 32 + 8 * fq;
#pragma unroll
        for (int ai = 0; ai < 2; ++ai)
#pragma unroll
            for (int m = 0; m < 4; ++m) { bf16* rp = O + (size_t)(row0 + ai * 128 + m * 16) * ldc + col0;
#pragma unroll
                for (int bj = 0; bj < 2; ++bj) { const f32x4 v0 = acc[ai][bj][m][0] * scale, v1 = acc[ai][bj][m][1] * scale;
                    u32x4 w; w.x = pk2(v0[0], v0[1]); w.y = pk2(v0[2], v0[3]); w.z = pk2(v1[0], v1[1]); w.w = pk2(v1[2], v1[3]);
                    *(u32x4*)(rp + bj * 128) = w; } }
    }
};
struct EpiAda { EPI_COMMON; static constexpr bool ALIGN = true; EPI_NOMID; float* MOD; const float* b_ada;
    __device__ __forceinline__ void operator()(const Acc& acc, const Unit& u, int wr, int wc, int fr, int fq) const {
        if (wr != 0) return;
        const int col0 = u.pn * 256 + wc * 32 + 8 * fq;
        const int layer = u.pn / 36, j0 = col0 - layer * MODW;
#pragma unroll
        for (int m = 0; m < 3; ++m) { const int row = m * 16 + fr; if (row < 33) {
#pragma unroll
            for (int bj = 0; bj < 2; ++bj) { const f32x4 b0 = *(const f32x4*)(b_ada + col0 + bj * 128), b1 = *(const f32x4*)(b_ada + col0 + bj * 128 + 4);
                float* o = MOD + ((size_t)layer * 33 + row) * MODW + j0 + bj * 128;
                *(f32x4*)o = acc[0][bj][m][0] + b0; *(f32x4*)(o + 4) = acc[0][bj][m][1] + b1; } } }
    }
};
struct EpiBranch { EPI_COMMON; static constexpr bool ALIGN = true; static constexpr bool HAS_MID = true; static constexpr int MID1 = 4, MID2 = 12;
    const bf16* G; bf16* Y; int hb;
    __device__ __forceinline__ void mid(Acc& acc, const Unit& u, int tt, int wr, int wc, int fr, int fq) const {
        asm volatile("" : "+v"(fr), "+v"(fq));
        const int lrow0 = ltile(u.pm, hb) * 256 + wr * 64 + fr, col0 = u.pn * 256 + wc * 32 + 8 * fq;
        const int num = tt == 4 ? 0 : D, den = tt == 4 ? D : 2 * D;
#pragma unroll
        for (int ai = 0; ai < 2; ++ai) {
            u32x4 wn[4][2], wd[4][2];
#pragma unroll
            for (int m = 0; m < 4; ++m) { const bf16* gp = G + (size_t)(lrow0 + ai * 128 + m * 16) * 3072 + col0;
#pragma unroll
                for (int bj = 0; bj < 2; ++bj) { wn[m][bj] = *(const u32x4*)(gp + num + bj * 128); wd[m][bj] = *(const u32x4*)(gp + den + bj * 128); } }
            __builtin_amdgcn_sched_barrier(0);
#pragma unroll
            for (int m = 0; m < 4; ++m)
#pragma unroll
                for (int bj = 0; bj < 2; ++bj) { float fn[8], fd[8]; UNPK8(wn[m][bj], fn); UNPK8(wd[m][bj], fd);
#pragma unroll
                    for (int e = 0; e < 8; ++e) { const float r = __builtin_fmaxf(fn[e], 1e-12f) * __builtin_amdgcn_rcpf(__builtin_fmaxf(fd[e], 1e-12f)); acc[ai][bj][m][e >> 2][e & 3] *= r; } }
            asm volatile("" ::: "memory"); }
    }
    __device__ __forceinline__ void operator()(const Acc& acc, const Unit& u, int wr, int wc, int fr, int fq) const {
        const int lrow0 = ltile(u.pm, hb) * 256 + wr * 64 + fr, row0 = u.pm * 256 + wr * 64 + fr, col0 = u.pn * 256 + wc * 32 + 8 * fq;
#pragma unroll
        for (int ai = 0; ai < 2; ++ai) {
            u32x4 wg[4][2];
#pragma unroll
            for (int m = 0; m < 4; ++m)
#pragma unroll
                for (int bj = 0; bj < 2; ++bj) wg[m][bj] = *(const u32x4*)(G + (size_t)(lrow0 + ai * 128 + m * 16) * 3072 + 2 * D + col0 + bj * 128);
            __builtin_amdgcn_sched_barrier(0);
#pragma unroll
            for (int m = 0; m < 4; ++m) { bf16* yp = Y + (size_t)(row0 + ai * 128 + m * 16) * D + col0;
#pragma unroll
                for (int bj = 0; bj < 2; ++bj) { float fg[8]; UNPK8(wg[m][bj], fg);
                    const f32x4 v0 = acc[ai][bj][m][0], v1 = acc[ai][bj][m][1];
                    u32x4 w; w.x = pk2(v0[0] * __builtin_fmaxf(fg[0], 1e-12f), v0[1] * __builtin_fmaxf(fg[1], 1e-12f)); w.y = pk2(v0[2] * __builtin_fmaxf(fg[2], 1e-12f), v0[3] * __builtin_fmaxf(fg[3], 1e-12f));
                    w.z = pk2(v1[0] * __builtin_fmaxf(fg[4], 1e-12f), v1[1] * __builtin_fmaxf(fg[5], 1e-12f)); w.w = pk2(v1[2] * __builtin_fmaxf(fg[6], 1e-12f), v1[3] * __builtin_fmaxf(fg[7], 1e-12f));
                    *(u32x4*)(yp + bj * 128) = w; } } }
    }
};
__device__ __forceinline__ int rope_logical(int p) { return 16 * ((p >> 3) & 1) + 8 * (p >> 4) + (p & 7); }
constexpr int PREP_PER_LAYER = 2 * (16 * 176) + 2 * (44 * 32) + 16 * 160 + 4 * 16 + 2 * 16 + 4 * 32 + 8 * 32 + 4 * 32 + 16 * 32, PREP_ADA = 2 * 16 * 288, PREP_TOTAL = PREP_ADA + 2 * PREP_PER_LAYER;
struct TrDesc { const float* srcp; bf16* dstp; int sstep, dstep; };
__device__ __forceinline__ TrDesc tr_decode(const Params& p, unsigned char* ws, int it, int lane) {
    const float* W0; const float* W1 = nullptr; bf16* dst; int K, ldw, ldd, koff = 0, nrows, kind = 0;
    int r = it;
    if (r < PREP_ADA) { const int L = r / (PREP_ADA / 2); r -= L * (PREP_ADA / 2);
        W0 = p.w_ada + (size_t)L * D * MODW; dst = (bf16*)(ws + WS_WADA) + (size_t)L * MODW * D; K = D; ldw = MODW; ldd = D; nrows = MODW; }
    else { r -= PREP_ADA; const int L = r / PREP_PER_LAYER; r -= L * PREP_PER_LAYER;
        unsigned char* wl = ws + WS_W + (size_t)L * LW_SIZE; bool found = false;
        W0 = nullptr; dst = nullptr; K = 64; ldw = 0; ldd = 0; nrows = 32;
#define TRY_JOB(KIND_, W0_, W1_, K_, LDW_, DST_, LDD_, KOFF_, NROWS_) if (!found) { const int cnt = ((K_) / 64) * ((NROWS_) / 32); if (r < cnt) { found = true; kind = KIND_; W0 = W0_; W1 = W1_; K = K_; ldw = LDW_; dst = (bf16*)(DST_); ldd = LDD_; koff = KOFF_; nrows = NROWS_; } else r -= cnt; }
        TRY_JOB(1, p.f1_wg + (size_t)L * D * DFF, p.f1_wu + (size_t)L * D * DFF, D, DFF, wl + LW_U1, D, 0, 2 * DFF)
        TRY_JOB(0, p.f1_wd + (size_t)L * DFF * D, nullptr, DFF, D, wl + LW_D1, DFF, 0, D)
        TRY_JOB(1, p.f2_wg + (size_t)L * D * DFF, p.f2_wu + (size_t)L * D * DFF, D, DFF, wl + LW_U2, D, 0, 2 * DFF)
        TRY_JOB(0, p.f2_wd + (size_t)L * DFF * D, nullptr, DFF, D, wl + LW_D2, DFF, 0, D)
        TRY_JOB(2, p.w_in + (size_t)L * D * INW, nullptr, D, INW, wl + LW_IN, D, 0, INWP)
        TRY_JOB(3, p.w_uq + (size_t)L * 256 * 384, nullptr, 256, 384, wl + LW_UQ, 256, 0, 512)
        TRY_JOB(0, p.w_ukv + (size_t)L * 128 * 512, nullptr, 128, 512, wl + LW_UKV, 128, 0, 512)
        TRY_JOB(0, p.w_ba + (size_t)L * 256 * D, nullptr, 256, D, wl + LW_BR, D, 0, D)
        TRY_JOB(0, p.w_bb + (size_t)L * 512 * D, nullptr, 512, D, wl + LW_BR, D, 256, D)
        TRY_JOB(0, p.w_bc + (size_t)L * 256 * D, nullptr, 256, D, wl + LW_BR, D, 768, D)
        TRY_JOB(0, p.w_out + (size_t)L * D * D, nullptr, D, D, wl + LW_OUT, D, 0, D)
#undef TRY_JOB
    }
    (void)K;
    const int nblk = nrows / 32, kb = r / nblk, nb = r % nblk, k0 = 64 * kb, n0 = 32 * nb, np = n0 + (lane & 31);
    const float* src = W0; int col = np;
    if (kind == 1) { const int pn = np >> 8, j = np & 255; src = j < 128 ? W0 : W1; col = 128 * pn + (j & 127); }
    else if (kind == 2) { if (np < 1920) col = np; else if (np < 1952) col = 1920 + rope_logical(np - 1920); else if (np < 2048) col = -1; else col = np - 96; }
    else if (kind == 3) { if (np < 384) { const int h = np / 96, j = np % 96; col = j < 64 ? np : 96 * h + 64 + rope_logical(j - 64); } else col = -1; }
    TrDesc d; d.srcp = col >= 0 ? src + (size_t)(k0 + (lane >> 5)) * ldw + col : nullptr; d.sstep = 2 * ldw;
    d.dstp = dst + (size_t)(n0 + (lane >> 3)) * ldd + koff + k0 + 8 * (lane & 7); d.dstep = 8 * ldd;
    return d;
}
#define TR_LOAD(DESC, V) do { _Pragma("unroll") for (int i = 0; i < 32; ++i) V[i] = (DESC).srcp ? (DESC).srcp[(size_t)i * (DESC).sstep] : 0.f; } while (0)
__device__ __forceinline__ void tr_finish(const TrDesc& d, const float (&v)[32], LAS float* scr, int lane) {
#pragma unroll
    for (int i = 0; i < 32; ++i) scr[(2 * i + (lane >> 5)) * 33 + (lane & 31)] = v[i];
    asm volatile("s_waitcnt lgkmcnt(0)" ::: "memory");
    const int c = lane & 7;
#pragma unroll
    for (int j = 0; j < 4; ++j) { const int n = (lane >> 3) + 8 * j; const LAS float* s = scr + (8 * c) * 33 + n;
        u32x4 o; o.x = pk2(s[0 * 33], s[1 * 33]); o.y = pk2(s[2 * 33], s[3 * 33]); o.z = pk2(s[4 * 33], s[5 * 33]); o.w = pk2(s[6 * 33], s[7 * 33]);
        *(u32x4*)(d.dstp + (size_t)j * d.dstep) = o; }
    asm volatile("s_waitcnt lgkmcnt(0)" ::: "memory");
}
__device__ __forceinline__ void prep_phase(const Params& p, LAS unsigned char* lds, int tid, int bid, int nbk, int item_lo, int item_hi, int wg0, bool misc) {
    asm volatile("" : "+v"(tid)); const int lane = tid & 63, wave = __builtin_amdgcn_readfirstlane(tid >> 6);
    LAS float* scr = (LAS float*)(lds + wave * 16384);
    const int gw = (bid - wg0) * 8 + wave, NGW = (nbk - wg0) * 8;
    unsigned char* ws = p.ws;
    if (bid >= wg0 && item_lo + gw < item_hi) {
        TrDesc dc = tr_decode(p, ws, item_lo + gw, lane); float vc[32]; TR_LOAD(dc, vc);
        for (int it = item_lo + gw; it < item_hi; it += NGW) {
            const bool more = it + NGW < item_hi;
            TrDesc dn = dc; float vn[32];
            if (more) { dn = tr_decode(p, ws, it + NGW, lane); TR_LOAD(dn, vn); }
            tr_finish(dc, vc, scr, lane);
            if (more) { dc = dn;
#pragma unroll
                for (int i = 0; i < 32; ++i) vc[i] = vn[i]; }
        }
    }
    bf16* SC = (bf16*)(ws + WS_SC);
    if (misc) for (int i = bid * 512 + tid; i < 256 * D; i += nbk * 512) { const int row = i >> 10, col = i & 1023;
        float v = 0.f; if (row < 32) v = fsilu(p.c[row * D + col]); else if (row == 32) v = fsilu(p.c_ctx[col]);
        SC[i] = (bf16)(pk2(v, 0.f) & 0xffffu); }
}

__device__ __forceinline__ void normmod_phase(const float* xlat, const float* xctx, const float* gain, const float* modl, int sidx, bf16* NBp, int row_lo, int nrows, int tid, int bid, int nbk, int wg0) {
    asm volatile("" : "+v"(tid)); const int lane = tid & 63, wave = __builtin_amdgcn_readfirstlane(tid >> 6);
    if (bid < wg0) return;
    const int gw = row_lo + (bid - wg0) * 8 + wave, NGW = (nbk - wg0) * 8;
    f32x4 gv[4];
#pragma unroll
    for (int j = 0; j < 4; ++j) gv[j] = *(const f32x4*)(gain + 4 * lane + 256 * j);
    constexpr int R = 3;
    for (int row0 = gw; row0 < nrows; row0 += R * NGW) {
        f32x4 v[R][4]; f32x4 sh[R][4], sc[R][4];
#pragma unroll
        for (int q = 0; q < R; ++q) { const int row = row0 + q * NGW; if (row < nrows) {
            const float* xr = row < ML ? xlat + (size_t)row * D : xctx + (size_t)(row - ML) * D;
#pragma unroll
            for (int j = 0; j < 4; ++j) v[q][j] = *(const f32x4*)(xr + 4 * lane + 256 * j); } }
#pragma unroll
        for (int q = 0; q < R; ++q) { const int row = row0 + q * NGW; if (row < nrows) {
            const float* mr = modl + (size_t)(row < ML ? (row >> 11) : 32) * MODW + sidx * D;
#pragma unroll
            for (int j = 0; j < 4; ++j) { sh[q][j] = *(const f32x4*)(mr + 4 * lane + 256 * j); sc[q][j] = *(const f32x4*)(mr + D + 4 * lane + 256 * j); } } }
#pragma unroll
        for (int q = 0; q < R; ++q) { const int row = row0 + q * NGW; if (row < nrows) {
            float ss = 0.f;
#pragma unroll
            for (int j = 0; j < 4; ++j) ss += (v[q][j].x * v[q][j].x + v[q][j].y * v[q][j].y) + (v[q][j].z * v[q][j].z + v[q][j].w * v[q][j].w);
            const float rstd = 1.0f / sqrtf(wave_sum(ss) * (1.f / D) + EPS);
            u32x2* o = (u32x2*)(NBp + (size_t)row * D) + lane;
#pragma unroll
            for (int j = 0; j < 4; ++j) { const f32x4 n = (v[q][j] * rstd) * gv[j] * (sc[q][j] + 1.0f) + sh[q][j];
                u32x2 w; w.x = pk2(n.x, n.y); w.y = pk2(n.z, n.w); o[64 * j] = w; } } }
    }
}
__device__ __forceinline__ void final_phase(float* out, const float* gain, int tid, int bid, int nbk) {
    asm volatile("" : "+v"(tid)); const int lane = tid & 63, wave = __builtin_amdgcn_readfirstlane(tid >> 6);
    const int gw = bid * 8 + wave, NGW = nbk * 8;
    f32x4 gv[4];
#pragma unroll
    for (int j = 0; j < 4; ++j) gv[j] = *(const f32x4*)(gain + 4 * lane + 256 * j);
    constexpr int R = 3;
    for (int row0 = gw; row0 < ML; row0 += R * NGW) {
        f32x4 v[R][4];
#pragma unroll
        for (int q = 0; q < R; ++q) { const int row = row0 + q * NGW; if (row < ML) {
#pragma unroll
            for (int j = 0; j < 4; ++j) v[q][j] = *(const f32x4*)(out + (size_t)row * D + 4 * lane + 256 * j); } }
#pragma unroll
        for (int q = 0; q < R; ++q) { const int row = row0 + q * NGW; if (row < ML) {
            float ss = 0.f;
#pragma unroll
            for (int j = 0; j < 4; ++j) ss += (v[q][j].x * v[q][j].x + v[q][j].y * v[q][j].y) + (v[q][j].z * v[q][j].z + v[q][j].w * v[q][j].w);
            const float rstd = 1.0f / sqrtf(wave_sum(ss) * (1.f / D) + EPS);
#pragma unroll
            for (int j = 0; j < 4; ++j) *(f32x4*)(out + (size_t)row * D + 4 * lane + 256 * j) = (v[q][j] * rstd) * gv[j]; } }
    }
}

__device__ __forceinline__ void post_phase(bf16* bB, bf16* bC, const float* k_norm, const float* mq_norm, const float* mkv_norm, int tid, int bid, int nbk) {
    asm volatile("" : "+v"(tid)); const int lane = tid & 63, wave = __builtin_amdgcn_readfirstlane(tid >> 6);
    const int gw = bid * 8 + wave, NGW = nbk * 8;
    const int hd = lane >> 5, a = (lane >> 4) & 1, f = lane & 15, d0 = 32 * a + f;
    const int a2 = (lane >> 3) & 1, f2 = lane & 7;
    const float kg0 = k_norm[d0], kg1 = k_norm[d0 + 16];
    const f32x4 qg = *(const f32x4*)(mq_norm + 4 * lane);
    const float vg0 = mkv_norm[2 * lane], vg1 = mkv_norm[2 * lane + 1];
    const float fr1 = __builtin_amdgcn_exp2f(-(float)f * (13.287712379549449f / 16.f)), fr2 = __builtin_amdgcn_exp2f(-(float)f2 * (13.287712379549449f / 8.f));
    constexpr int R = 4;
    for (int row0 = gw; row0 < HM; row0 += R * NGW) {
        unsigned k0r[R], k1r[R], cvr[R], r0r[R], r1r[R]; u32x2 cqr[R];
#pragma unroll
        for (int q = 0; q < R; ++q) { const int row = row0 + q * NGW; if (row < HM) {
            const bf16* kp = bB + (size_t)row * 768 + 512 + hd * 64; const bf16* cp = bC + (size_t)row * 512;
            k0r[q] = kp[d0]; k1r[q] = kp[d0 + 16]; cqr[q] = *(const u32x2*)(cp + 4 * lane); cvr[q] = *(const unsigned*)(cp + 256 + 2 * lane);
            r0r[q] = cp[384 + 8 * a2 + f2]; r1r[q] = cp[384 + 16 + 8 * a2 + f2]; } }
#pragma unroll
        for (int q = 0; q < R; ++q) { const int row = row0 + q * NGW; if (row < HM) {
            const bool lat = row < HL; const int t = row & (SEQ - 1); const float prow = (float)(t >> 6), pcol = (float)(t & 63);
            bf16* kp = bB + (size_t)row * 768 + 512 + hd * 64; bf16* cp = bC + (size_t)row * 512;
            { float x0 = bf2f(k0r[q]), x1 = bf2f(k1r[q]);
              const float rstd = 1.0f / sqrtf(sum32(x0 * x0 + x1 * x1) * (1.f / 64.f) + EPS);
              x0 = x0 * rstd * kg0; x1 = x1 * rstd * kg1;
              if (lat) { const float ang = (a ? pcol : prow) * fr1; const float cs = __cosf(ang), sn = __sinf(ang);
                  const float y0 = x0 * cs - x1 * sn, y1 = x1 * cs + x0 * sn; x0 = y0; x1 = y1; }
              kp[d0] = (bf16)(pk2(x0, 0.f) & 0xffffu); kp[d0 + 16] = (bf16)(pk2(x1, 0.f) & 0xffffu); }
            { const u32x2 w = cqr[q];
              const float x[4] = {bf2f(w.x & 0xffffu), __uint_as_float(w.x & 0xffff0000u), bf2f(w.y & 0xffffu), __uint_as_float(w.y & 0xffff0000u)};
              const float rstd = 1.0f / sqrtf(wave_sum((x[0] * x[0] + x[1] * x[1]) + (x[2] * x[2] + x[3] * x[3])) * (1.f / 256.f) + EPS);
              u32x2 o; o.x = pk2(x[0] * rstd * qg.x, x[1] * rstd * qg.y); o.y = pk2(x[2] * rstd * qg.z, x[3] * rstd * qg.w); *(u32x2*)(cp + 4 * lane) = o; }
            { const unsigned w = cvr[q]; const float x0 = bf2f(w & 0xffffu), x1 = __uint_as_float(w & 0xffff0000u);
              const float rstd = 1.0f / sqrtf(wave_sum(x0 * x0 + x1 * x1) * (1.f / 128.f) + EPS);
              *(unsigned*)(cp + 256 + 2 * lane) = pk2(x0 * rstd * vg0, x1 * rstd * vg1); }
            if (lat && lane < 16) { const float x0 = bf2f(r0r[q]), x1 = bf2f(r1r[q]);
              const float ang = (a2 ? pcol : prow) * fr2; const float cs = __cosf(ang), sn = __sinf(ang);
              cp[384 + 8 * a2 + f2] = (bf16)(pk2(x0 * cs - x1 * sn, 0.f) & 0xffffu); cp[384 + 16 + 8 * a2 + f2] = (bf16)(pk2(x1 * cs + x0 * sn, 0.f) & 0xffffu); }
        } }
    }
}
constexpr int KTP = 208, KTB = 64 * KTP, VTP = 144, VTB = 64 * VTP;
constexpr int A_KT = 0, A_VT = 2 * KTB, A_BIAS = A_VT + 3 * VTB, A_END = A_BIAS + 480 * 4;
struct AttnArgs { const bf16* bA; const bf16* bB; const bf16* bC; const bf16* MQ; const bf16* MKV; bf16* OB; const float* q_norm; const float* na_bias; int hb; int with_ctx_q; };
__device__ __forceinline__ int crow(int r, int hi) { return (r & 3) + 8 * (r >> 2) + 4 * hi; }
__device__ __forceinline__ int na_r0(int r) { const int v = r - 4; return v < 0 ? 0 : (v > 24 ? 24 : v); }


template <int QD> __device__ __forceinline__ void attn_tile(const bf16x8 (&qf)[QD], bool& fresh, f32x16& negm, float& m2, float& lsum, f32x16& o0, f32x16& o1, const LAS unsigned char* kb, const LAS unsigned char* vb,
                                                           bool local, const LAS float* bt, int c0, int hi) {
    bf16x8 k0[QD], k1[QD];
#pragma unroll
    for (int d0 = 0; d0 < QD; ++d0) { k0[d0] = *(const LAS bf16x8*)(kb + d0 * 32); k1[d0] = *(const LAS bf16x8*)(kb + 32 * KTP + d0 * 32); }
    bf16x8 vfa[4], vfc[4];
#pragma unroll
    for (int j4 = 0; j4 < 4; ++j4) { vfa[j4] = *(const LAS bf16x8*)(vb + j4 * 32); vfc[j4] = *(const LAS bf16x8*)(vb + 32 * VTP + j4 * 32); }
    __builtin_amdgcn_sched_barrier(0);
    f32x16 s0, s1;
    s0 = __builtin_amdgcn_mfma_f32_32x32x16_bf16(k0[0], qf[0], negm, 0, 0, 0); s1 = __builtin_amdgcn_mfma_f32_32x32x16_bf16(k1[0], qf[0], negm, 0, 0, 0);
#pragma unroll
    for (int d0 = 1; d0 < QD; ++d0) { s0 = __builtin_amdgcn_mfma_f32_32x32x16_bf16(k0[d0], qf[d0], s0, 0, 0, 0); s1 = __builtin_amdgcn_mfma_f32_32x32x16_bf16(k1[d0], qf[d0], s1, 0, 0, 0); }
    if (local) {
        int base = 4 * hi - c0; asm volatile("" : "+v"(base));
        const LAS float* btl = bt + 4 * hi;
#pragma unroll
        for (int r = 0; r < 16; ++r) { const int cr = (r & 3) + 8 * (r >> 2);
            s0[r] = ((unsigned)(cr + base) < 16u) ? s0[r] + btl[cr] : -1e30f;
            s1[r] = ((unsigned)(cr + 32 + base) < 16u) ? s1[r] + btl[cr + 32] : -1e30f; }
    }
    float tmax;
    { float a = __builtin_fmaxf(s0[0], s1[0]), b = __builtin_fmaxf(s0[1], s1[1]);
#pragma unroll
      for (int r = 2; r < 16; r += 2) { a = __builtin_fmaxf(__builtin_fmaxf(a, s0[r]), s1[r]); b = __builtin_fmaxf(__builtin_fmaxf(b, s0[r + 1]), s1[r + 1]); }
      tmax = half_max(__builtin_fmaxf(a, b)); }
    if (fresh || __any(tmax > 8.0f)) {
        const float dl = fresh ? tmax : __builtin_fmaxf(tmax, 0.f); m2 += dl; fresh = false;
#pragma unroll
        for (int r = 0; r < 16; ++r) { s0[r] -= dl; s1[r] -= dl; negm[r] = -m2; }
        const float al = __builtin_amdgcn_exp2f(-dl); lsum *= al;
#pragma unroll
        for (int r = 0; r < 16; ++r) { o0[r] *= al; o1[r] *= al; } }
    float ps0 = 0.f, ps1 = 0.f;
#pragma unroll
    for (int r = 0; r < 16; ++r) { s0[r] = __builtin_amdgcn_exp2f(s0[r]); s1[r] = __builtin_amdgcn_exp2f(s1[r]); ps0 += s0[r]; ps1 += s1[r]; }
    lsum += ps0 + ps1;
    bf16x8 pb[4];
    { u32x4 w;
      w.x = pk2(s0[0], s0[1]); w.y = pk2(s0[2], s0[3]); w.z = pk2(s0[4], s0[5]); w.w = pk2(s0[6], s0[7]); pb[0] = __builtin_bit_cast(bf16x8, w);
      w.x = pk2(s0[8], s0[9]); w.y = pk2(s0[10], s0[11]); w.z = pk2(s0[12], s0[13]); w.w = pk2(s0[14], s0[15]); pb[1] = __builtin_bit_cast(bf16x8, w);
      w.x = pk2(s1[0], s1[1]); w.y = pk2(s1[2], s1[3]); w.z = pk2(s1[4], s1[5]); w.w = pk2(s1[6], s1[7]); pb[2] = __builtin_bit_cast(bf16x8, w);
      w.x = pk2(s1[8], s1[9]); w.y = pk2(s1[10], s1[11]); w.z = pk2(s1[12], s1[13]); w.w = pk2(s1[14], s1[15]); pb[3] = __builtin_bit_cast(bf16x8, w); }
#pragma unroll
    for (int j4 = 0; j4 < 4; ++j4) {
        o0 = __builtin_amdgcn_mfma_f32_32x32x16_bf16(vfa[j4], pb[j4], o0, 0, 0, 0);
        o1 = __builtin_amdgcn_mfma_f32_32x32x16_bf16(vfc[j4], pb[j4], o1, 0, 0, 0); }
}

template <int TYPE  >
__device__ __forceinline__ void attn_unit(const AttnArgs& a, int bl, int head, int qb  , LAS unsigned char* lds, int tid) {
    constexpr int QD = TYPE == 2 ? 6 : 4;
    asm volatile("" : "+v"(tid));
    const int lane = tid & 63, wid = __builtin_amdgcn_readfirstlane(tid >> 6), q32 = lane & 31, hi = lane >> 5;
    const bool isctx = qb < 0;
    const int lat_row0 = bl * SEQ, ctx_row0 = HL + bl * CTXL;
    const bf16* Qb; const bf16* Kb; const bf16* Vb; int qp, kp, vp, ocol; float scale;
    if (TYPE == 0) { Qb = a.bA + 64 * head; Kb = a.bA + 256 + 64 * head; Vb = a.bA + 512 + 64 * head; qp = kp = vp = 768; ocol = 64 * head; scale = 0.125f; }
    else if (TYPE == 1) { Qb = a.bB + 64 * head; Kb = a.bB + 512 + 64 * (head >> 2); Vb = a.bB + 640 + 64 * (head >> 2); qp = kp = vp = 768; ocol = 256 + 64 * head; scale = 0.125f; }
    else { Qb = a.MQ + 96 * head; Kb = a.MKV + 128 * head; Vb = a.MKV + 128 * head + 64; qp = kp = vp = 512; ocol = 768 + 64 * head; scale = 0.10206207261596575f; }
    const float sc2 = scale * LOG2E;
    int nfirst, first_base, kr_lo = 0;
    if (isctx) { nfirst = 0; first_base = 0; }
    else if (TYPE == 0) { kr_lo = na_r0(4 * qb); const int kr_hi = na_r0(4 * qb + 3) + 7; nfirst = kr_hi - kr_lo + 1; first_base = lat_row0 + 64 * kr_lo; }
    else { nfirst = 32; first_base = lat_row0; }
    const int NT = nfirst + 4;
#define TILE_ROW(j) ((j) < nfirst ? first_base + 64 * (j) : ctx_row0 + 64 * ((j) - nfirst))
    const int krow = tid >> 3, kc = tid & 7, k2row = tid >> 2, k2c = tid & 3;
    u32x4 kA, vA, k2A = (u32x4){0u, 0u, 0u, 0u}, kB, vB, k2B = (u32x4){0u, 0u, 0u, 0u};
#define LOAD_TILE(j, kreg, vreg, k2reg) do { const int rb_ = TILE_ROW(j); kreg = *(const u32x4*)(Kb + (size_t)(rb_ + krow) * kp + 8 * kc); vreg = *(const u32x4*)(Vb + (size_t)(rb_ + krow) * vp + 8 * kc); \
        if (TYPE == 2 && tid < 256) k2reg = *(const u32x4*)(a.bC + (size_t)(rb_ + k2row) * 512 + 384 + 8 * k2c); } while (0)
#define STORE_TILE(buf, vbuf, kreg, vreg, k2reg) do { *(LAS u32x4*)(lds + A_KT + (buf) * KTB + krow * KTP + kc * 16) = kreg; \
        if (TYPE == 2 && tid < 256) *(LAS u32x4*)(lds + A_KT + (buf) * KTB + k2row * KTP + 128 + k2c * 16) = k2reg; \
          \
        { const bool odd_ = krow & 1; \
          const unsigned snd0_ = odd_ ? vreg.x : vreg.z, snd1_ = odd_ ? vreg.y : vreg.w;             \
          const unsigned rcv0_ = (unsigned)__builtin_amdgcn_ds_swizzle((int)snd0_, (8 << 10) | 0x1f), rcv1_ = (unsigned)__builtin_amdgcn_ds_swizzle((int)snd1_, (8 << 10) | 0x1f); \
          const unsigned ev0_ = odd_ ? rcv0_ : vreg.x, ev1_ = odd_ ? rcv1_ : vreg.y, od0_ = odd_ ? vreg.z : rcv0_, od1_ = odd_ ? vreg.w : rcv1_;     \
          const int kvp_ = (krow & 0x30) | ((krow & 4) << 1) | ((krow & 8) >> 1) | (krow & 2);        \
          LAS unsigned* vt_ = (LAS unsigned*)(lds + A_VT + (vbuf) * VTB + (8 * kc + 4 * (krow & 1)) * VTP + kvp_ * 2); \
          vt_[0 * (VTP / 4)] = __builtin_amdgcn_perm(od0_, ev0_, 0x05040100u); vt_[1 * (VTP / 4)] = __builtin_amdgcn_perm(od0_, ev0_, 0x07060302u); \
          vt_[2 * (VTP / 4)] = __builtin_amdgcn_perm(od1_, ev1_, 0x05040100u); vt_[3 * (VTP / 4)] = __builtin_amdgcn_perm(od1_, ev1_, 0x07060302u); } } while (0)
    LOAD_TILE(0, kA, vA, k2A);
    if (TYPE == 0 && !isctx) { if (tid < 465) ((LAS float*)(lds + A_BIAS))[tid] = a.na_bias[head * 465 + tid] * LOG2E; }
    const int qloc = 32 * wid + q32;
    const int qrow_l = isctx ? ctx_row0 + qloc : lat_row0 + 256 * qb + qloc;
    const size_t orow_p = isctx ? (size_t)ML + (size_t)(a.hb * BPH + bl) * CTXL + qloc : (size_t)(a.hb * BPH + bl) * SEQ + 256 * qb + qloc;
    bf16x8 qf[QD];
    {
        u32x4 qw[QD];
#pragma unroll
        for (int d0 = 0; d0 < QD; ++d0) qw[d0] = *(const u32x4*)(Qb + (size_t)qrow_l * qp + 16 * d0 + 8 * hi);
        if (TYPE == 1) {
            float x[4][8]; float ss = 0.f;
#pragma unroll
            for (int d0 = 0; d0 < 4; ++d0) { UNPK8(qw[d0], x[d0]);
#pragma unroll
                for (int i = 0; i < 8; ++i) ss += x[d0][i] * x[d0][i]; }
            ss = half_sum(ss);
            const float rstd = sc2 / sqrtf(ss * (1.f / 64.f) + EPS);
#pragma unroll
            for (int d0 = 0; d0 < 4; ++d0) { const f32x4 g0 = *(const f32x4*)(a.q_norm + 16 * d0 + 8 * hi), g1 = *(const f32x4*)(a.q_norm + 16 * d0 + 8 * hi + 4);
#pragma unroll
                for (int i = 0; i < 4; ++i) { x[d0][i] *= rstd * g0[i]; x[d0][4 + i] *= rstd * g1[i]; } }
            if (!isctx) { const int t = 256 * qb + qloc; const float prow = (float)(t >> 6), pcol = (float)(t & 63);
#pragma unroll
                for (int i = 0; i < 8; ++i) { const float fr_ = __builtin_amdgcn_exp2f(-(float)(8 * hi + i) * (13.287712379549449f / 16.f));
                    { const float ang = prow * fr_, cs = __cosf(ang), sn = __sinf(ang), y0 = x[0][i] * cs - x[1][i] * sn, y1 = x[1][i] * cs + x[0][i] * sn; x[0][i] = y0; x[1][i] = y1; }
                    { const float ang = pcol * fr_, cs = __cosf(ang), sn = __sinf(ang), y0 = x[2][i] * cs - x[3][i] * sn, y1 = x[3][i] * cs + x[2][i] * sn; x[2][i] = y0; x[3][i] = y1; } } }
#pragma unroll
            for (int d0 = 0; d0 < 4; ++d0) { qw[d0].x = pk2(x[d0][0], x[d0][1]); qw[d0].y = pk2(x[d0][2], x[d0][3]); qw[d0].z = pk2(x[d0][4], x[d0][5]); qw[d0].w = pk2(x[d0][6], x[d0][7]); }
        }
        if (TYPE == 2 && !isctx) {
            float x0[8], x1[8]; UNPK8(qw[4], x0); UNPK8(qw[5], x1);
            const int t = 256 * qb + qloc; const float pos = hi ? (float)(t & 63) : (float)(t >> 6);
#pragma unroll
            for (int i = 0; i < 8; ++i) { const float ang = pos * __builtin_amdgcn_exp2f(-(float)i * (13.287712379549449f / 8.f)), cs = __cosf(ang), sn = __sinf(ang);
                const float y0 = x0[i] * cs - x1[i] * sn, y1 = x1[i] * cs + x0[i] * sn; x0[i] = y0; x1[i] = y1; }
            qw[4].x = pk2(x0[0], x0[1]); qw[4].y = pk2(x0[2], x0[3]); qw[4].z = pk2(x0[4], x0[5]); qw[4].w = pk2(x0[6], x0[7]);
            qw[5].x = pk2(x1[0], x1[1]); qw[5].y = pk2(x1[2], x1[3]); qw[5].z = pk2(x1[4], x1[5]); qw[5].w = pk2(x1[6], x1[7]);
        }
#pragma unroll
        for (int d0 = 0; d0 < QD; ++d0) qf[d0] = __builtin_bit_cast(bf16x8, qw[d0]);
    }
    STORE_TILE(0, 0, kA, vA, k2A);
    if (NT > 1) LOAD_TILE(1, kA, vA, k2A);
    if (NT > 2) LOAD_TILE(2, kB, vB, k2B);
    __syncthreads();
    const int na_r = 4 * qb + (wid >> 1), na_w0 = na_r0(na_r), qc = 32 * (wid & 1) + q32;
    const int c0 = (qc - 8) < 0 ? 0 : ((qc - 8) > 48 ? 48 : (qc - 8));
    bool fresh = true; float m2 = 0.f, lsum = 0.f; f32x16 o0 = {}, o1 = {}, negm = {};
#define ATT_COMPUTE(IT) do { bool act_c = true; const bool local = (TYPE == 0) && ((IT) < nfirst); \
        if (local) { const int kr = kr_lo + (IT); act_c = (kr >= na_w0) && (kr < na_w0 + 8); } \
        if (act_c) attn_tile<QD>(qf, fresh, negm, m2, lsum, o0, o1, lds + A_KT + ((IT) & 1) * KTB + q32 * KTP + hi * 16, lds + A_VT + ((IT) & 1) * VTB + q32 * VTP + hi * 16, \
                                 local, (const LAS float*)(lds + A_BIAS) + (kr_lo + (IT) - na_r + 7) * 31 + 15 - qc, c0, hi); } while (0)
    for (int it = 0; it < NT; it += 2) {
        ATT_COMPUTE(it);
        if (it + 1 < NT) STORE_TILE(1, 1, kA, vA, k2A);
        if (it + 3 < NT) LOAD_TILE(it + 3, kA, vA, k2A);
        __syncthreads();
        if (it + 1 < NT) {
            ATT_COMPUTE(it + 1);
            if (it + 2 < NT) STORE_TILE(0, 0, kB, vB, k2B);
            if (it + 4 < NT) LOAD_TILE(it + 4, kB, vB, k2B);
            __syncthreads();
        }
    }
#undef ATT_COMPUTE
    lsum = half_sum(lsum);
    const float inv = 1.0f / lsum;
    bf16* op = a.OB + orow_p * D + ocol + 4 * hi;
#pragma unroll
    for (int g = 0; g < 4; ++g) { u32x2 w;
        w.x = pk2(o0[4 * g] * inv, o0[4 * g + 1] * inv); w.y = pk2(o0[4 * g + 2] * inv, o0[4 * g + 3] * inv); *(u32x2*)(op + 8 * g) = w;
        w.x = pk2(o1[4 * g] * inv, o1[4 * g + 1] * inv); w.y = pk2(o1[4 * g + 2] * inv, o1[4 * g + 3] * inv); *(u32x2*)(op + 32 + 8 * g) = w; }
#undef TILE_ROW
#undef LOAD_TILE
#undef STORE_TILE
}
__device__ __forceinline__ void attn_phase(const AttnArgs& a, LAS unsigned char* lds, int tid, int bid, int nbk) {
    const int nunits = 2048 + (a.with_ctx_q ? 256 : 0);
    for (int u = bid; u < nunits; u += nbk) {
        const int rnd = u >> 8, blk = u & 255, x = blk & 7, y = blk >> 3;
        int type, bl, head, qb;
        if (rnd < 4) { const int g = 4 * x + rnd; type = 1; bl = g >> 1; head = 4 * (g & 1) + (y >> 3); qb = y & 7; }
        else if (rnd < 8) { const int g = ((rnd - 4) & 1) * 32 + 4 * x + (y >> 3); type = rnd < 6 ? 2 : 0; bl = g >> 2; head = g & 3; qb = y & 7; }
        else { const int h16 = blk & 15; bl = blk >> 4; qb = -1; if (h16 < 4) { type = 0; head = h16; } else if (h16 < 12) { type = 1; head = h16 - 4; } else { type = 2; head = h16 - 12; } }
        if (type == 1) attn_unit<1>(a, bl, head, qb, lds, tid); else if (type == 2) attn_unit<2>(a, bl, head, qb, lds, tid); else attn_unit<0>(a, bl, head, qb, lds, tid);
    }
}
constexpr size_t WS_CTL = 0, CTL_ZERO_BYTES = 16384;
#define XB_TMO      128
#define XB_XCNT(j)  (256  + 64 * (j))
#define XB_XSUB(j)  (1280 + 64 * (j))
#define XB_XGEN(j)  (2304 + 64 * (j))
#define XB_TOP      3328
#define XB_TOPGEN   3392
#define XCD_BAR_WORDS 3456
#define XB_SPIN_CAP (1u << 18)

__device__ __forceinline__ unsigned xb_ld(unsigned* p)              { return __hip_atomic_load(p, __ATOMIC_RELAXED, __HIP_MEMORY_SCOPE_AGENT); }
__device__ __forceinline__ unsigned xb_add(unsigned* p, unsigned v) { return __hip_atomic_fetch_add(p, v, __ATOMIC_RELAXED, __HIP_MEMORY_SCOPE_AGENT); }
__device__ __forceinline__ unsigned xb_xcc_id() { return (unsigned)__builtin_amdgcn_s_getreg((3 << 11) | 20) & 0xFu; }
#define XB_SPIN(cond, bar) do { unsigned _sp = 0; while (cond) { __builtin_amdgcn_s_sleep(1); \
    if ((++_sp & 255u) == 0u) { if (xb_ld(&(bar)[XB_TMO])) break; if (_sp > XB_SPIN_CAP) { atomicAdd(&(bar)[XB_TMO], 1u); break; } } } } while (0)

struct XcdBarrier {
    unsigned* bar; unsigned x;
    volatile LAS unsigned* st;
};

__device__ __forceinline__ XcdBarrier xcd_barrier_post(unsigned* bar, volatile LAS unsigned* st) {
    XcdBarrier b; b.bar = bar; b.x = xb_xcc_id(); b.st = st;
    if (threadIdx.x == 0) (void)xb_add(&bar[XB_XCNT(b.x)], 1u);
    return b;
}
__device__ __forceinline__ void xcd_barrier_complete(unsigned* bar, unsigned x, unsigned& nloc, unsigned& nx) {
    const unsigned G = gridDim.x * gridDim.y * gridDim.z;
    unsigned sum, cnt, mine, sp = 0u;
    for (;;) {
        sum = 0u; cnt = 0u; mine = 0u;
#pragma unroll
        for (unsigned j = 0; j < 16; ++j) { const unsigned c = xb_ld(&bar[XB_XCNT(j)]); sum += c; cnt += (c > 0u) ? 1u : 0u; mine = (j == x) ? c : mine; }
        if (sum == G) break;
        __builtin_amdgcn_s_sleep(1);
        if ((++sp & 255u) == 0u) { if (xb_ld(&bar[XB_TMO])) break; if (sp > XB_SPIN_CAP) { atomicAdd(&bar[XB_TMO], 1u); break; } }
    }
    nloc = mine > 0u ? mine : 1u; nx = cnt > 0u ? cnt : 1u;
}

__device__ __forceinline__ void xcd_barrier(const XcdBarrier& b) {
    asm volatile("s_waitcnt vmcnt(0)" ::: "memory");
    __syncthreads();
    if (threadIdx.x == 0) {
        unsigned* bar = b.bar;
        __builtin_amdgcn_s_waitcnt(0);
        unsigned nloc = b.st[0], nx = b.st[1];
        if (nloc == 0u) { xcd_barrier_complete(bar, b.x, nloc, nx); b.st[0] = nloc; b.st[1] = nx; }
        const unsigned old = xb_add(&bar[XB_XSUB(b.x)], 1u);
        const unsigned gen = old / nloc;
        if (old + 1u == (gen + 1u) * nloc) {
            __builtin_amdgcn_fence(__ATOMIC_RELEASE, "agent");
            asm volatile("s_waitcnt vmcnt(0)" ::: "memory");
            const unsigned og = xb_add(&bar[XB_TOP], 1u);
            const unsigned tg = og / nx;
            if (og + 1u == (tg + 1u) * nx) xb_add(&bar[XB_TOPGEN], 1u);
            else XB_SPIN(xb_ld(&bar[XB_TOPGEN]) == tg, bar);
            __builtin_amdgcn_fence(__ATOMIC_ACQUIRE, "agent");
            xb_add(&bar[XB_XGEN(b.x)], 1u);
            asm volatile("s_waitcnt vmcnt(0)" ::: "memory");
        } else {
            XB_SPIN(xb_ld(&bar[XB_XGEN(b.x)]) == gen, bar);
            __builtin_amdgcn_fence(__ATOMIC_ACQUIRE, "agent");
            asm volatile("s_waitcnt vmcnt(0)" ::: "memory");
        }
    }
    __syncthreads();
}
constexpr int XB_LDS_OFF = pg8::STAGE_BYTES, LDS_BYTES = pg8::STAGE_BYTES + 64;
static_assert(A_END <= pg8::STAGE_BYTES && XCD_BAR_WORDS * 4 <= (int)CTL_ZERO_BYTES && CTL_ZERO_BYTES <= WS_SC, "LDS / ctl map");
#define GEMM_RUN(EPI_T, E, APTR, LDA, BPTR, LDB, KK, NN, NL, NC, LAT0, CTX0) do { const pg8::Gemm g_{(const bf16*)(APTR), (const bf16*)(BPTR), (LDA), (LDB), (KK)}; \
    MapOrder S_; S_.init((NL), (NC), (LAT0), (CTX0), (NN), nbk, bid); pg8::gemm_phase<EPI_T, MapOrder, EPI_T::ALIGN, true>(lds, g_, S_, E, tid); } while (0)
constexpr int PH_PER_LAYER = 4 + 5 * NCH + 4, PH_TOTAL = 2 + DEPTH * PH_PER_LAYER + 1;

__global__ void __launch_bounds__(512, 2) mega_fwd(Params p_unused) {
#if defined(__HIP_DEVICE_COMPILE__)
    extern __shared__ __attribute__((aligned(16))) unsigned char lds_raw[];
    LAS unsigned char* lds = (LAS unsigned char*)lds_raw;
    cg::grid_group grid = cg::this_grid();
    typedef const __attribute__((address_space(4))) Params* KP;
    const int wave_s = __builtin_amdgcn_readfirstlane(threadIdx.x >> 6);
    if (threadIdx.x < 16) ((LAS unsigned*)(lds + XB_LDS_OFF))[threadIdx.x] = 0u;
    __syncthreads();
    { KP pp0 = (KP)__builtin_amdgcn_kernarg_segment_ptr(); (void)xcd_barrier_post((unsigned*)(pp0->ws + WS_CTL), (volatile LAS unsigned*)(lds + XB_LDS_OFF)); }
#ifndef PROBE_KIND
#define PROBE_KIND -1
#endif
#ifndef PROBE_SYNCS
#define PROBE_SYNCS 0
#endif
    for (int ph2 = 0; ph2 < PH_TOTAL * 2; ++ph2) {
        const int ph = ph2 >> 1;
        if (ph2 & 1) { bool rep = false;
            if (PROBE_KIND >= 0 && ph >= 2 && ph < PH_TOTAL - 1) { const int st_ = (ph - 2) % PH_PER_LAYER; int k_;
                if (st_ < 3) k_ = st_; else if (st_ == 3) k_ = 0; else if (st_ < 4 + 5 * NCH) k_ = 3 + (st_ - 4) % 5; else if (st_ == 4 + 5 * NCH) k_ = 8; else k_ = st_ - (5 + 5 * NCH);
                rep = (k_ == PROBE_KIND); }
            if (PROBE_KIND == 12) rep = (ph == 4);
            if (PROBE_KIND == 13) rep = (ph == 0);
            if (!rep) continue; }
        int lane_, wv_ = wave_s, bid = blockIdx.x, nbk = gridDim.x; KP pp = (KP)__builtin_amdgcn_kernarg_segment_ptr();
        asm volatile("v_mbcnt_lo_u32_b32 %0, -1, 0\n\tv_mbcnt_hi_u32_b32 %0, -1, %0" : "=v"(lane_));
        asm volatile("" : "+s"(wv_), "+s"(bid), "+s"(nbk), "+s"(pp));
        int tid = wv_ * 64 + lane_; asm volatile("" : "+v"(tid));
        unsigned char* ws = pp->ws;
        float* MOD = (float*)(ws + WS_MOD); float* CTXRES = (float*)(ws + WS_CTXRES);
        bf16* NBp = (bf16*)(ws + WS_NB);
        if (ph == 0) { { const Params p = *pp; prep_phase(p, lds, tid, bid, nbk, 0, PREP_ADA + PREP_PER_LAYER, 0, true); } __syncthreads(); }
        else if (ph == 1) { EpiAda E; E.MOD = MOD; E.b_ada = pp->b_ada; GEMM_RUN(EpiAda, E, ws + WS_SC, D, ws + WS_WADA, D, D, 2 * MODW, 1, 0, 0, 0); }
        else if (ph == PH_TOTAL - 1) { final_phase(pp->out, pp->final_norm, tid, bid, nbk); }
        else {
            const int L = (ph - 2) / PH_PER_LAYER, st = (ph - 2) % PH_PER_LAYER;
            const bool last = (L == DEPTH - 1);
            const float* modl = MOD + (size_t)L * 33 * MODW;
            const unsigned char* wl = ws + WS_W + (size_t)L * LW_SIZE;
            int kind, which = 0, hb = 0;
            if (st < 3) { kind = st; which = 0; }
            else if (st == 3) { kind = 0; which = 1; }
            else if (st < 4 + 5 * NCH) { hb = (st - 4) / 5; kind = 3 + (st - 4) % 5; }
            else if (st == 4 + 5 * NCH) { kind = 8; }
            else { kind = st - (5 + 5 * NCH); which = 2; }
            const bool first_in = (L == 0 && which == 0);
            const float* xl = first_in ? pp->x : pp->out; const float* xc = first_in ? pp->ctx : CTXRES;
            const int nctx = (last && (which == 2 || kind >= 7)) ? 0 : 32;
            if (kind == 0) {
                const float* gain = (which == 0 ? pp->f1_norm : which == 1 ? pp->mix_norm : pp->f2_norm) + L * D;
                const bool carry = (which == 1) || (which == 0 && L > 0);
                if (!carry) normmod_phase(xl, xc, gain, modl, 3 * which, NBp, 0, nctx ? MT : ML, tid, bid, nbk, 0);
                else {
                    const int Lp = which == 1 ? L : L - 1, whp = which == 1 ? 0 : 2;
                    const bool firstp = (Lp == 0 && whp == 0);
                    { EpiResid E; E.src_lat = pp->out; E.src_ctx = firstp ? pp->ctx : CTXRES; E.dst_lat = pp->out; E.dst_ctx = CTXRES; E.modl = MOD + (size_t)Lp * 33 * MODW; E.gidx = whp == 0 ? 2 : 8; E.coef = 0.5f;
                      const unsigned char* wlp = ws + WS_W + (size_t)Lp * LW_SIZE;
                      GEMM_RUN(EpiResid, E, ws + WS_H, DFF, wlp + (whp == 0 ? LW_D1 : LW_D2), DFF, DFF, D, 0, 32, 0, 256); }
                    normmod_phase(xl, xc, gain, modl, 3 * which, NBp, 0, ML, tid, bid, nbk, nbk / 2);
                    { XcdBarrier xb_; xb_.bar = (unsigned*)(pp->ws + WS_CTL); xb_.x = xb_xcc_id(); xb_.st = (volatile LAS unsigned*)(lds + XB_LDS_OFF); xcd_barrier(xb_); }
                    normmod_phase(xl, xc, gain, modl, 3 * which, NBp, ML, MT, tid, bid, nbk, 0);
                }
            } else if (kind == 1) {
                EpiSwiGLU E; E.H = (bf16*)(ws + WS_H);
                GEMM_RUN(EpiSwiGLU, E, NBp, D, wl + (which == 0 ? LW_U1 : LW_U2), D, D, 2 * DFF, 256, nctx, 0, 256);
            } else if (kind == 2) {
                EpiResid E; E.src_lat = xl; E.src_ctx = xc; E.dst_lat = pp->out; E.dst_ctx = CTXRES; E.modl = modl; E.gidx = which == 0 ? 2 : 8; E.coef = 0.5f;
                GEMM_RUN(EpiResid, E, ws + WS_H, DFF, wl + (which == 0 ? LW_D1 : LW_D2), DFF, DFF, D, 256, 0, 0, 256);
            } else if (kind == 8) {
                EpiResid E; E.src_lat = pp->out; E.src_ctx = CTXRES; E.dst_lat = pp->out; E.dst_ctx = CTXRES; E.modl = modl; E.gidx = 5; E.coef = 1.0f;
                GEMM_RUN(EpiResid, E, ws + WS_Y, D, wl + LW_OUT, D, D, D, 256, nctx, 0, 256);
            } else if (kind == 3) {
                EpiWin E; E.bA = (bf16*)(ws + WS_BA); E.bB = (bf16*)(ws + WS_BB); E.bC = (bf16*)(ws + WS_BC); E.G = (bf16*)(ws + WS_G); E.hb = hb;
                if (!last) { GEMM_RUN(EpiWin, E, NBp, D, wl + LW_IN, D, D, INWP, HL / 256, HC / 256, (HL / 256) * hb, 256 + (HC / 256) * hb);
                    if (L == 0 && DEPTH > 1) { const int lo_ = PREP_ADA + PREP_PER_LAYER + (PREP_PER_LAYER * hb) / NCH, hi_ = PREP_ADA + PREP_PER_LAYER + (PREP_PER_LAYER * (hb + 1)) / NCH;
                        __syncthreads(); const Params p = *pp; prep_phase(p, lds, tid, bid, nbk, lo_, hi_, nbk / 4, false); __syncthreads(); } }
                else {
                    GEMM_RUN(EpiWin, E, NBp, D, wl + LW_IN, D, D, INWP, HL / 256, 0, (HL / 256) * hb, 0);
                    { const pg8::Gemm g_{(const bf16*)NBp, (const bf16*)(wl + LW_IN), D, D, D}; MapOrder S_; S_.init(0, HC / 256, 0, 256 + (HC / 256) * hb, 4 * 256, nbk, (bid + nbk / 2) % nbk); S_.cmap = 0x7521ull;
                      pg8::gemm_phase<EpiWin, MapOrder, EpiWin::ALIGN, true>(lds, g_, S_, E, tid); } }
            } else if (kind == 4) {
                post_phase((bf16*)(ws + WS_BB), (bf16*)(ws + WS_BC), pp->k_norm + L * 64, pp->mq_norm + L * 256, pp->mkv_norm + L * 128, tid, bid, nbk);
            } else if (kind == 5) {
                for (int s = 0; s < 2; ++s) { EpiPlain E; E.O = (bf16*)(ws + (s ? WS_MKV : WS_MQ)); E.ldc = 512; E.scale = s ? 1.0f : 0.10206207261596575f * LOG2E;
                    GEMM_RUN(EpiPlain, E, (bf16*)(ws + WS_BC) + (s ? 256 : 0), 512, wl + (s ? LW_UKV : LW_UQ), s ? 128 : 256, s ? 128 : 256, 512, HM / 256, 0, 0, 0); }
            } else if (kind == 6) {
                AttnArgs a; a.bA = (const bf16*)(ws + WS_BA); a.bB = (const bf16*)(ws + WS_BB); a.bC = (const bf16*)(ws + WS_BC); a.MQ = (const bf16*)(ws + WS_MQ); a.MKV = (const bf16*)(ws + WS_MKV); a.OB = NBp;
                a.q_norm = pp->q_norm + L * 64; a.na_bias = pp->na_bias + (size_t)L * 4 * 465; a.hb = hb; a.with_ctx_q = last ? 0 : 1;
                attn_phase(a, lds, tid, bid, nbk);
            } else {
                EpiBranch E; E.G = (const bf16*)(ws + WS_G); E.Y = (bf16*)(ws + WS_Y); E.hb = hb;
                GEMM_RUN(EpiBranch, E, NBp, D, wl + LW_BR, D, D, D, HL / 256, nctx ? HC / 256 : 0, (HL / 256) * hb, 256 + (HC / 256) * hb);
            }
        }
        if (ph + 1 < PH_TOTAL) {
            if (ph == 0) grid.sync();
            else { XcdBarrier xb_; xb_.bar = (unsigned*)(pp->ws + WS_CTL); xb_.x = xb_xcc_id(); xb_.st = (volatile LAS unsigned*)(lds + XB_LDS_OFF); xcd_barrier(xb_); }
            for (int e_ = 0; e_ < PROBE_SYNCS; ++e_) grid.sync(); }
    }
#endif
}

extern "C" void kernel_launch(void* const* d_in, const int* in_sizes, int n_in, void* d_out, int out_size, void* d_ws, size_t ws_size, hipStream_t stream) {
    static int grid = 0;
    if (grid == 0) {
        if (n_in != 28 || out_size != ML * D || ws_size < (size_t)1024 * MiB) { fprintf(stderr, "kernel_launch: unexpected problem (n_in %d, out %d, ws %zu)\n", n_in, out_size, ws_size); grid = -1; return; }
        int dev = 0, cus = 0, per_cu = 0;
        (void)hipGetDevice(&dev); (void)hipDeviceGetAttribute(&cus, hipDeviceAttributeMultiprocessorCount, dev);
        (void)hipFuncSetAttribute((const void*)mega_fwd, hipFuncAttributeMaxDynamicSharedMemorySize, LDS_BYTES);
        (void)hipOccupancyMaxActiveBlocksPerMultiprocessor(&per_cu, (const void*)mega_fwd, 512, LDS_BYTES);
        if (per_cu < 1) per_cu = 1;
        grid = cus * per_cu;
    }
    if (grid < 0) return;
    if (hipMemsetAsync((char*)d_ws + WS_CTL, 0, CTL_ZERO_BYTES, stream) != hipSuccess) { fprintf(stderr, "kernel_launch: memset of barrier words failed\n"); return; }
    Params p{};
    const float* const* in = (const float* const*)d_in;
    p.x = in[0]; p.c = in[1]; p.ctx = in[2]; p.c_ctx = in[3]; p.w_ada = in[4]; p.b_ada = in[5];
    p.f1_norm = in[6]; p.f1_wg = in[7]; p.f1_wu = in[8]; p.f1_wd = in[9];
    p.mix_norm = in[10]; p.w_in = in[11]; p.na_bias = in[12]; p.q_norm = in[13]; p.k_norm = in[14]; p.mq_norm = in[15]; p.mkv_norm = in[16];
    p.w_uq = in[17]; p.w_ukv = in[18]; p.w_ba = in[19]; p.w_bb = in[20]; p.w_bc = in[21]; p.w_out = in[22];
    p.f2_norm = in[23]; p.f2_wg = in[24]; p.f2_wu = in[25]; p.f2_wd = in[26]; p.final_norm = in[27];
    p.out = (float*)d_out; p.ws = (unsigned char*)d_ws;
    void* args[] = {&p};
    hipError_t e = hipLaunchCooperativeKernel((const void*)mega_fwd, dim3(grid), dim3(512), args, LDS_BYTES, stream);
    if (e != hipSuccess) fprintf(stderr, "cooperative launch failed: %s (grid %d)\n", hipGetErrorString(e), grid);
}
```

```cpp
#include <hip/hip_runtime.h>
#include <hip/hip_cooperative_groups.h>
#include <cstdio>
#include <cstdint>
namespace cg = cooperative_groups;
namespace pg8 {
#define PG8_LAS __attribute__((address_space(3)))
typedef unsigned short bf16_t;
typedef short bf16x8 __attribute__((ext_vector_type(8)));
typedef float f32x4 __attribute__((ext_vector_type(4)));
typedef unsigned u32x4 __attribute__((ext_vector_type(4)));
constexpr int BM = 256, BK = 64, HALF = 128, HTB = HALF * BK * 2  , STAGE_BYTES = 8 * HTB, NXCD = 8, WGM = 8;

__host__ __device__ __forceinline__ int lds_byte(int r, int c) { const int st = (r >> 4) * 2 + (c >> 5), rr = r & 15, cc = c & 31, ob = rr * 64 + cc * 2; return st * 1024 + (ob ^ (((ob >> 9) & 1) << 5)); }
__host__ __device__ __forceinline__ void stage_rc(int b, int& R, int& C) { const int st = b / 1024, sb = b % 1024, swz = sb ^ (((sb >> 9) & 1) << 5); R = (st >> 1) * 16 + swz / 64; C = (st & 1) * 32 + (swz % 64) / 2; }
__host__ __device__ __forceinline__ int perm32(int rho) { const int n = rho >> 4, i = rho & 15; return 8 * (i >> 2) + 4 * n + (i & 3); }

struct Unit { int pm, pn; };
struct Gemm { const bf16_t* A; const bf16_t* Bt; int lda, ldb, K; };

struct StaticOrder {
    int nM, nN, nwg, G, c;
    __host__ __device__ void init(int M, int N, int G_, int c_) { nM = M / BM; nN = N / BM; nwg = nM * nN; G = G_; c = c_; }
    __host__ __device__ bool next(int i, Unit& u) const {
        const long L = (long)i * G + c; if (L >= nwg) return false;
        int wgid = (int)L; { const int q = nwg / NXCD, r = nwg % NXCD, xcd = wgid % NXCD, off = wgid / NXCD; wgid = (xcd < r ? xcd * (q + 1) : r * (q + 1) + (xcd - r) * q) + off; }
        const int nig = WGM * nN, gid = wgid / nig, fm = gid * WGM, gsz = (nM - fm) < WGM ? (nM - fm) : WGM;
        u.pm = fm + ((wgid % nig) % gsz); u.pn = (wgid % nig) / gsz; return true;
    }
    __device__ __forceinline__ void a_ready(const Unit&) const {}
    __device__ __forceinline__ void done(const Unit&) const {}
};

__device__ __forceinline__ unsigned cvt_pk_bf16(float lo, float hi) { unsigned r; asm volatile("v_cvt_pk_bf16_f32 %0, %1, %2" : "=v"(r) : "v"(lo), "v"(hi)); return r; }
template <class Epi, class Sched, bool ALIGN_EPI = false, bool SP2 = false>
__device__ __forceinline__ void gemm_phase(PG8_LAS unsigned char* lds, const Gemm g, const Sched& S, const Epi& E, const int tid) {
    const int wid = __builtin_amdgcn_readfirstlane(tid >> 6), lane = tid & 63, wr = wid >> 2, wc = wid & 3, fr = lane & 15, fq = lane >> 4;
    const int K = g.K, nt = K / BK;
    unsigned voffA[2], voffB[2];
#pragma unroll
    for (int i = 0; i < 2; ++i) { int R, C; stage_rc(tid * 16 + i * 8192, R, C); const int Rb = Epi::PERM ? ((R & ~31) + perm32(R & 31)) : R;
        voffA[i] = (unsigned)(R * g.lda + C) * 2u; voffB[i] = (unsigned)(Rb * g.ldb + C) * 2u; }
    const size_t kstep = (size_t)(BK * 2);
    const size_t hstepA = (size_t)HALF * g.lda * 2, hstepB = (size_t)HALF * g.ldb * 2;
    const size_t tstepA = 2 * hstepA, tstepB = 2 * hstepB;
    const unsigned ldsw = (unsigned)wid * 1024u;
    const int aoff = lds_byte(wr * 64 + fr, fq * 8), boff = lds_byte(wc * 32 + fr, fq * 8);
#define PG8_SA(b, h) (((b) * 2 + (h)) * HTB)
#define PG8_SB(b, h) ((4 + (b) * 2 + (h)) * HTB)
#define PG8_STAGE(bufoff, gbase, voff) do { _Pragma("unroll") for (int _i = 0; _i < 2; ++_i) \
        __builtin_amdgcn_global_load_lds((const unsigned*)((const char*)(gbase) + (voff)[_i]), (PG8_LAS unsigned*)(lds + (bufoff) + ldsw + _i * 8192), 16, 0, 0); } while (0)
#define PG8_LDA(dst, b, h) do { _Pragma("unroll") for (int m = 0; m < 4; ++m) _Pragma("unroll") for (int k = 0; k < 2; ++k) dst[m][k] = *(const PG8_LAS bf16x8*)(lds + PG8_SA(b, h) + aoff + m * 2048 + k * 1024); } while (0)
#define PG8_LDB(dst, b, h) do { _Pragma("unroll") for (int n = 0; n < 2; ++n) _Pragma("unroll") for (int k = 0; k < 2; ++k) dst[n][k] = *(const PG8_LAS bf16x8*)(lds + PG8_SB(b, h) + boff + n * 2048 + k * 1024); } while (0)
#define PG8_MMA(ai, bj, At, Bt) do { __builtin_amdgcn_s_setprio(1); _Pragma("unroll") for (int m = 0; m < 4; ++m) _Pragma("unroll") for (int n = 0; n < 2; ++n) _Pragma("unroll") for (int k = 0; k < 2; ++k) \
        acc[ai][bj][m][n] = __builtin_amdgcn_mfma_f32_16x16x32_bf16(Bt[n][k], At[m][k], acc[ai][bj][m][n], 0, 0, 0); __builtin_amdgcn_s_setprio(0); } while (0)
#define PG8_WAIT_V(n) asm volatile("s_waitcnt vmcnt(" #n ")" ::: "memory")
#define PG8_WAIT_L(n) asm volatile("s_waitcnt lgkmcnt(" #n ")" ::: "memory")
#define PG8_BAR __builtin_amdgcn_s_barrier()
#define PG8_SCHED __builtin_amdgcn_sched_barrier(0)
    Unit cur, nxt; int ui = 0;
    if (!S.next(0, cur)) return;
    f32x4 acc[2][2][4][2];
#pragma unroll
    for (int a = 0; a < 2; ++a)
#pragma unroll
        for (int b = 0; b < 2; ++b)
#pragma unroll
            for (int m = 0; m < 4; ++m)
#pragma unroll
                for (int n = 0; n < 2; ++n) acc[a][b][m][n] = (f32x4){0.f, 0.f, 0.f, 0.f};
    bf16x8 At[4][2], B0[2][2], B1[2][2];
    const char* cA = (const char*)g.A + (size_t)cur.pm * tstepA; const char* cB = (const char*)g.Bt + (size_t)cur.pn * tstepB;
    S.a_ready(cur);
    if constexpr (SP2) {
        PG8_STAGE(PG8_SB(0, 0), cB, voffB); PG8_STAGE(PG8_SB(0, 1), cB + hstepB, voffB); PG8_STAGE(PG8_SA(0, 0), cA, voffA); PG8_STAGE(PG8_SA(0, 1), cA + hstepA, voffA);
        if (wr == 1) PG8_BAR;
        PG8_WAIT_V(2); PG8_BAR;
        PG8_STAGE(PG8_SB(1, 0), cB + kstep, voffB); PG8_STAGE(PG8_SA(1, 0), cA + kstep, voffA); PG8_STAGE(PG8_SB(1, 1), cB + hstepB + kstep, voffB);
        PG8_WAIT_V(6); PG8_BAR;
    } else {
        PG8_STAGE(PG8_SB(0, 0), cB, voffB); PG8_STAGE(PG8_SA(0, 0), cA, voffA); PG8_STAGE(PG8_SB(0, 1), cB + hstepB, voffB); PG8_STAGE(PG8_SA(0, 1), cA + hstepA, voffA);
        if (wr == 1) PG8_BAR;
        PG8_WAIT_V(4); PG8_BAR;
        PG8_STAGE(PG8_SB(1, 0), cB + kstep, voffB); PG8_STAGE(PG8_SA(1, 0), cA + kstep, voffA); PG8_STAGE(PG8_SB(1, 1), cB + hstepB + kstep, voffB);
        PG8_WAIT_V(6); PG8_BAR;
    }
    for (;;) {
        const bool has_next = S.next(ui + 1, nxt);
        const char* nA = has_next ? (const char*)g.A + (size_t)nxt.pm * tstepA : cA; const char* nB = has_next ? (const char*)g.Bt + (size_t)nxt.pn * tstepB : cB;
        for (int t = 0; t < nt; t += 2) {
            const bool last = (t == nt - 2);
            const char* a1 = cA + (size_t)(t + 1) * kstep;
            const char* a2 = last ? nA : cA + (size_t)(t + 2) * kstep; const char* b2 = last ? nB : cB + (size_t)(t + 2) * kstep;
            const char* a3 = a2 + kstep; const char* b3 = b2 + kstep;
            if (last && has_next) S.a_ready(nxt);
            if constexpr (SP2) {
            PG8_LDB(B0, 0, 0); PG8_LDB(B1, 0, 1); PG8_SCHED; PG8_LDA(At, 0, 0); PG8_STAGE(PG8_SA(1, 1), a1 + hstepA, voffA);
            PG8_WAIT_V(8); PG8_WAIT_L(0); PG8_BAR; PG8_MMA(0, 0, At, B0); PG8_MMA(0, 1, At, B1); PG8_BAR; PG8_SCHED;
            PG8_LDA(At, 0, 1); PG8_STAGE(PG8_SB(0, 0), b2, voffB); PG8_STAGE(PG8_SB(0, 1), b2 + hstepB, voffB); PG8_STAGE(PG8_SA(0, 0), a2, voffA);
            PG8_WAIT_V(8); PG8_WAIT_L(0); PG8_BAR; PG8_MMA(1, 0, At, B0); PG8_MMA(1, 1, At, B1); PG8_BAR; PG8_SCHED;
            PG8_LDB(B0, 1, 0); PG8_LDB(B1, 1, 1); PG8_SCHED; PG8_LDA(At, 1, 0); PG8_STAGE(PG8_SA(0, 1), a2 + hstepA, voffA);
            PG8_WAIT_V(8); PG8_WAIT_L(0); PG8_BAR; PG8_MMA(0, 0, At, B0); PG8_MMA(0, 1, At, B1); PG8_BAR; PG8_SCHED;
            PG8_LDA(At, 1, 1); PG8_STAGE(PG8_SB(1, 0), b3, voffB); PG8_STAGE(PG8_SB(1, 1), b3 + hstepB, voffB); PG8_STAGE(PG8_SA(1, 0), a3, voffA);
            PG8_WAIT_V(8); PG8_WAIT_L(0); PG8_BAR; PG8_MMA(1, 0, At, B0); PG8_MMA(1, 1, At, B1); PG8_BAR; PG8_SCHED;
            } else {
            PG8_LDB(B0, 0, 0); PG8_SCHED; PG8_LDA(At, 0, 0); PG8_STAGE(PG8_SA(1, 1), a1 + hstepA, voffA);
            PG8_WAIT_L(8); PG8_BAR; PG8_WAIT_L(0); PG8_MMA(0, 0, At, B0); PG8_BAR; PG8_SCHED;
            PG8_LDB(B1, 0, 1); PG8_STAGE(PG8_SB(0, 0), b2, voffB);
            PG8_BAR; PG8_WAIT_L(0); PG8_MMA(0, 1, At, B1); PG8_BAR;
            PG8_LDA(At, 0, 1); PG8_STAGE(PG8_SA(0, 0), a2, voffA);
            PG8_BAR; PG8_WAIT_L(0); PG8_MMA(1, 0, At, B0); PG8_BAR; PG8_SCHED;
            PG8_STAGE(PG8_SB(0, 1), b2 + hstepB, voffB);
            PG8_WAIT_V(6); PG8_BAR; PG8_MMA(1, 1, At, B1); PG8_BAR;
            PG8_LDB(B0, 1, 0); PG8_SCHED; PG8_LDA(At, 1, 0); PG8_STAGE(PG8_SA(0, 1), a2 + hstepA, voffA);
            PG8_WAIT_L(8); PG8_BAR; PG8_WAIT_L(0); PG8_MMA(0, 0, At, B0); PG8_BAR; PG8_SCHED;
            PG8_LDB(B1, 1, 1); PG8_STAGE(PG8_SB(1, 0), b3, voffB);
            PG8_BAR; PG8_WAIT_L(0); PG8_MMA(0, 1, At, B1); PG8_BAR;
            PG8_LDA(At, 1, 1); PG8_STAGE(PG8_SA(1, 0), a3, voffA);
            PG8_BAR; PG8_WAIT_L(0); PG8_MMA(1, 0, At, B0); PG8_BAR; PG8_SCHED;
            PG8_STAGE(PG8_SB(1, 1), b3 + hstepB, voffB);
            PG8_WAIT_V(6); PG8_BAR; PG8_MMA(1, 1, At, B1); PG8_BAR;
            }
            if constexpr (Epi::HAS_MID) { if (t + 2 == Epi::MID1 || t + 2 == Epi::MID2) E.mid(acc, cur, t + 2, wr, wc, fr, fq); }
        }
        if constexpr (ALIGN_EPI) { if (wr == 0) PG8_BAR; }
        if constexpr (!Epi::AFTER_DRAIN) { E(acc, cur, wr, wc, fr, fq); S.done(cur); }
        if (!has_next) break;
#pragma unroll
        for (int a = 0; a < 2; ++a)
#pragma unroll
            for (int b = 0; b < 2; ++b)
#pragma unroll
                for (int m = 0; m < 4; ++m)
#pragma unroll
                    for (int n = 0; n < 2; ++n) acc[a][b][m][n] = (f32x4){0.f, 0.f, 0.f, 0.f};
        cur = nxt; cA = nA; cB = nB; ++ui;
        if constexpr (ALIGN_EPI) { if (wr == 1) PG8_BAR; }
    }
    PG8_WAIT_V(0);
    if constexpr (!ALIGN_EPI) { if (wr == 0) PG8_BAR; }
    PG8_BAR;
    if constexpr (Epi::AFTER_DRAIN) { E.fused(acc, cur, wr, wc, fr, fq, lds, wid, lane); S.done(cur); }
#undef PG8_SA
#undef PG8_SB
#undef PG8_STAGE
#undef PG8_LDA
#undef PG8_LDB
#undef PG8_MMA
#undef PG8_WAIT_V
#undef PG8_WAIT_L
#undef PG8_BAR
#undef PG8_SCHED
}
}
using pg8::Unit; using pg8::f32x4; using pg8::u32x4; using pg8::bf16x8;
typedef unsigned short bf16;
#define LAS __attribute__((address_space(3)))
typedef float f32x16 __attribute__((ext_vector_type(16)));
typedef float f32x2 __attribute__((ext_vector_type(2)));
typedef unsigned u32x2 __attribute__((ext_vector_type(2)));

constexpr int D = 1024, NBATCH = 32, SEQ = 2048, CTXL = 256, DFF = 2816, DEPTH = 2;
constexpr int ML = NBATCH * SEQ, MC = NBATCH * CTXL, MT = ML + MC;
constexpr int MODW = 9 * D;
constexpr int INW = 5024, INWP = 5120;
constexpr int NCH = 2, BPH = NBATCH / NCH;
constexpr int HL = BPH * SEQ, HC = BPH * CTXL, HM = HL + HC;
constexpr float EPS = 1e-6f, LOG2E = 1.4426950408889634f;

constexpr size_t MiB = 1u << 20;
constexpr size_t WS_SC = 1 * MiB;
constexpr size_t WS_MOD = 2 * MiB;
constexpr size_t WS_CTXRES = 8 * MiB;
constexpr size_t WS_W = 40 * MiB;
constexpr size_t LW_U1 = 0, LW_D1 = LW_U1 + (size_t)2 * DFF * D * 2, LW_U2 = LW_D1 + (size_t)D * DFF * 2, LW_D2 = LW_U2 + (size_t)2 * DFF * D * 2,
                 LW_IN = LW_D2 + (size_t)D * DFF * 2, LW_UQ = LW_IN + (size_t)INWP * D * 2, LW_UKV = LW_UQ + (size_t)512 * 256 * 2, LW_BR = LW_UKV + (size_t)512 * 128 * 2,
                 LW_OUT = LW_BR + (size_t)D * D * 2, LW_SIZE = LW_OUT + (size_t)D * D * 2;
static_assert(WS_W + 2 * LW_SIZE <= 136 * MiB, "weights");
constexpr size_t WS_NB = 136 * MiB;
constexpr size_t WS_Y = 280 * MiB;
constexpr size_t WS_BIG = 424 * MiB;
constexpr size_t WS_H = WS_BIG;
constexpr size_t WS_WADA = WS_BIG;
constexpr size_t WS_BA = WS_BIG;
constexpr size_t WS_BB = WS_BA + (size_t)HM * 768 * 2;
constexpr size_t WS_BC = WS_BB + (size_t)HM * 768 * 2;
constexpr size_t WS_MQ = WS_BC + (size_t)HM * 512 * 2;
constexpr size_t WS_MKV = WS_MQ + (size_t)HM * 512 * 2;
constexpr size_t WS_G = WS_MKV + (size_t)HM * 512 * 2;
constexpr size_t WS_END = WS_G + (size_t)HM * 3072 * 2;
static_assert(WS_END <= 1024 * MiB && WS_H + (size_t)MT * DFF * 2 <= 1024 * MiB, "ws map");

struct Params {
    const float* x; const float* c; const float* ctx; const float* c_ctx; const float* w_ada; const float* b_ada;
    const float* f1_norm; const float* f1_wg; const float* f1_wu; const float* f1_wd;
    const float* mix_norm; const float* w_in; const float* na_bias; const float* q_norm; const float* k_norm; const float* mq_norm; const float* mkv_norm;
    const float* w_uq; const float* w_ukv; const float* w_ba; const float* w_bb; const float* w_bc; const float* w_out;
    const float* f2_norm; const float* f2_wg; const float* f2_wu; const float* f2_wd; const float* final_norm;
    float* out; unsigned char* ws;
};

__device__ __forceinline__ float bf2f(unsigned v) { return __uint_as_float(v << 16); }
typedef __bf16 bf16x2_t __attribute__((ext_vector_type(2)));
__device__ __forceinline__ unsigned pk2(float lo, float hi) { const f32x2 v = {lo, hi}; const bf16x2_t b = __builtin_convertvector(v, bf16x2_t); return __builtin_bit_cast(unsigned, b); }
__device__ __forceinline__ float fsilu(float x) { return x * __builtin_amdgcn_rcpf(1.f + __builtin_amdgcn_exp2f(-x * LOG2E)); }
__device__ __forceinline__ float fsigm(float x) { return __builtin_amdgcn_rcpf(1.f + __builtin_amdgcn_exp2f(-x * LOG2E)); }
template <int M> __device__ __forceinline__ float swz_xor(float v) { return __int_as_float(__builtin_amdgcn_ds_swizzle(__float_as_int(v), (M << 10) | 0x1f)); }
__device__ __forceinline__ float half_sum(float v) { auto rr = __builtin_amdgcn_permlane32_swap(__float_as_uint(v), __float_as_uint(v), false, false); return __uint_as_float(rr[0]) + __uint_as_float(rr[1]); }
__device__ __forceinline__ float half_max(float v) { auto rr = __builtin_amdgcn_permlane32_swap(__float_as_uint(v), __float_as_uint(v), false, false); return __builtin_fmaxf(__uint_as_float(rr[0]), __uint_as_float(rr[1])); }
__device__ __forceinline__ float sum32(float v) { v += swz_xor<1>(v); v += swz_xor<2>(v); v += swz_xor<4>(v); v += swz_xor<8>(v); v += swz_xor<16>(v); return v; }
__device__ __forceinline__ float wave_sum(float v) { return half_sum(sum32(v)); }
#define UNPK8(W_, f) do { const u32x4 w__ = (W_); f[0] = bf2f(w__[0] & 0xffffu); f[1] = __uint_as_float(w__[0] & 0xffff0000u); f[2] = bf2f(w__[1] & 0xffffu); f[3] = __uint_as_float(w__[1] & 0xffff0000u); \
                         f[4] = bf2f(w__[2] & 0xffffu); f[5] = __uint_as_float(w__[2] & 0xffff0000u); f[6] = bf2f(w__[3] & 0xffffu); f[7] = __uint_as_float(w__[3] & 0xffff0000u); } while (0)

struct MapOrder {
    pg8::StaticOrder s; int nl, lat0, ctx0; unsigned long long cmap;
    __device__ __forceinline__ void init(int nl_, int nc_, int lat0_, int ctx0_, int N, int G, int c) { nl = nl_; lat0 = lat0_; ctx0 = ctx0_; cmap = 0ull; s.init((nl_ + nc_) * 256, N, G, c); }
    __device__ __forceinline__ bool next(int i, Unit& u) const { if (!s.next(i, u)) return false; u.pm = u.pm < nl ? lat0 + u.pm : ctx0 + (u.pm - nl);
        if (cmap) u.pn = (int)((cmap >> (4 * u.pn)) & 15ull); return true; }
    __device__ __forceinline__ void a_ready(const Unit&) const {}
    __device__ __forceinline__ void done(const Unit&) const {}
};

#ifndef RESID_ALIGN
#define RESID_ALIGN false
#endif
#define EPI_COMMON static constexpr bool PERM = true, AFTER_DRAIN = false
#define EPI_NOMID static constexpr bool HAS_MID = false; static constexpr int MID1 = -1, MID2 = -1; \
    __device__ __forceinline__ void mid(f32x4 (&)[2][2][4][2], const Unit&, int, int, int, int, int) const {}
typedef f32x4 Acc[2][2][4][2];

struct EpiSwiGLU { EPI_COMMON; static constexpr bool ALIGN = true; EPI_NOMID; bf16* H;
    __device__ __forceinline__ void operator()(const Acc& acc, const Unit& u, int wr, int wc, int fr, int fq) const {
        const int row0 = u.pm * 256 + wr * 64 + fr, col0 = u.pn * 128 + wc * 32 + 8 * fq;
#pragma unroll
        for (int ai = 0; ai < 2; ++ai)
#pragma unroll
            for (int m = 0; m < 4; ++m) {
                const f32x4 g0 = acc[ai][0][m][0], g1 = acc[ai][0][m][1], u0 = acc[ai][1][m][0], u1 = acc[ai][1][m][1];
                u32x4 w; w.x = pk2(fsilu(g0[0]) * u0[0], fsilu(g0[1]) * u0[1]); w.y = pk2(fsilu(g0[2]) * u0[2], fsilu(g0[3]) * u0[3]);
                w.z = pk2(fsilu(g1[0]) * u1[0], fsilu(g1[1]) * u1[1]); w.w = pk2(fsilu(g1[2]) * u1[2], fsilu(g1[3]) * u1[3]);
                *(u32x4*)(H + (size_t)(row0 + ai * 128 + m * 16) * DFF + col0) = w; }
    }
};
struct EpiResid { EPI_COMMON; static constexpr bool ALIGN = RESID_ALIGN; EPI_NOMID; const float* src_lat; const float* src_ctx; float* dst_lat; float* dst_ctx; const float* modl; int gidx; float coef;
    __device__ __forceinline__ void operator()(const Acc& acc, const Unit& u, int wr, int wc, int fr, int fq) const {
        const bool isl = u.pm < 256;
        const float* src = isl ? src_lat + (size_t)u.pm * 256 * D : src_ctx + (size_t)(u.pm - 256) * 256 * D;
        float* dst = isl ? dst_lat + (size_t)u.pm * 256 * D : dst_ctx + (size_t)(u.pm - 256) * 256 * D;
        const float* gate = modl + (size_t)(isl ? (u.pm >> 3) : 32) * MODW + gidx * D;
        const int col0 = u.pn * 256 + wc * 32 + 8 * fq;
#pragma unroll
        for (int bj = 0; bj < 2; ++bj) {
            const f32x4 g0 = *(const f32x4*)(gate + col0 + bj * 128) * coef, g1 = *(const f32x4*)(gate + col0 + bj * 128 + 4) * coef;
            f32x4 x0[8], x1[8];
#pragma unroll
            for (int g = 0; g < 8; ++g) { const size_t off = (size_t)((g >> 2) * 128 + wr * 64 + (g & 3) * 16 + fr) * D + col0 + bj * 128;
                x0[g] = *(const f32x4*)(src + off); x1[g] = *(const f32x4*)(src + off + 4); }
            __builtin_amdgcn_sched_barrier(0);
#pragma unroll
            for (int g = 0; g < 8; ++g) { const size_t off = (size_t)((g >> 2) * 128 + wr * 64 + (g & 3) * 16 + fr) * D + col0 + bj * 128;
                *(f32x4*)(dst + off) = x0[g] + g0 * acc[g >> 2][bj][g & 3][0]; *(f32x4*)(dst + off + 4) = x1[g] + g1 * acc[g >> 2][bj][g & 3][1]; }
            __builtin_amdgcn_sched_barrier(0);
        }
    }
};
__device__ __forceinline__ int ltile(int pm, int hb) { return pm < 256 ? pm - (HL / 256) * hb : (HL / 256) + (pm - 256 - (HC / 256) * hb); }
struct EpiWin { EPI_COMMON; static constexpr bool ALIGN = true; EPI_NOMID; bf16* bA; bf16* bB; bf16* bC; bf16* G; int hb;
    __device__ __forceinline__ void operator()(const Acc& acc, const Unit& u, int wr, int wc, int fr, int fq) const {
        const int lrow0 = ltile(u.pm, hb) * 256 + wr * 64 + fr;
        bf16* base; int ld, ct; bool sg = false;
        if (u.pn < 3) { base = bA; ld = 768; ct = u.pn; } else if (u.pn < 6) { base = bB; ld = 768; ct = u.pn - 3; } else if (u.pn < 8) { base = bC; ld = 512; ct = u.pn - 6; } else { base = G; ld = 3072; ct = u.pn - 8; sg = true; }
        const int col0 = ct * 256 + wc * 32 + 8 * fq;
        const float qs = u.pn == 0 ? 0.125f * LOG2E : 1.0f;
#pragma unroll
        for (int ai = 0; ai < 2; ++ai)
#pragma unroll
            for (int m = 0; m < 4; ++m) { bf16* rp = base + (size_t)(lrow0 + ai * 128 + m * 16) * ld + col0;
#pragma unroll
                for (int bj = 0; bj < 2; ++bj) { f32x4 v0 = acc[ai][bj][m][0] * qs, v1 = acc[ai][bj][m][1] * qs;
                    if (sg) { v0 = (f32x4){fsigm(v0[0]), fsigm(v0[1]), fsigm(v0[2]), fsigm(v0[3])}; v1 = (f32x4){fsigm(v1[0]), fsigm(v1[1]), fsigm(v1[2]), fsigm(v1[3])}; }
                    u32x4 w; w.x = pk2(v0[0], v0[1]); w.y = pk2(v0[2], v0[3]); w.z = pk2(v1[0], v1[1]); w.w = pk2(v1[2], v1[3]);
                    *(u32x4*)(rp + bj * 128) = w; } }
    }
};
struct EpiPlain { EPI_COMMON; static constexpr bool ALIGN = true; EPI_NOMID; bf16* O; int ldc; float scale;
    __device__ __forceinline__ void operator()(const Acc& acc, const Unit& u, int wr, int wc, int fr, int fq) const {
        const int row0 = u.pm * 256 + wr * 64 + fr, col0 = u.pn * 256 + wc * 32 + 8 * fq;
#pragma unroll
        for (int ai = 0; ai < 2; ++ai)
#pragma unroll
            for (int m = 0; m < 4; ++m) { bf16* rp = O + (size_t)(row0 + ai * 128 + m * 16) * ldc + col0;
#pragma unroll
                for (int bj = 0; bj < 2; ++bj) { const f32x4 v0 = acc[ai][bj][m][0] * scale, v1 = acc[ai][bj][m][1] * scale;
                    u32x4 w; w.x = pk2(v0[0], v0[1]); w.y = pk2(v0[2], v0[3]); w.z = pk2(v1[0], v1[1]); w.w = pk2(v1[2], v1[3]);
                    *(u32x4*)(rp + bj * 128) = w; } }
    }
};
struct EpiAda { EPI_COMMON; static constexpr bool ALIGN = true; EPI_NOMID; float* MOD; const float* b_ada;
    __device__ __forceinline__ void operator()(const Acc& acc, const Unit& u, int wr, int wc, int fr, int fq) const {
        if (wr != 0) return;
        const int col0 = u.pn * 256 + wc * 32 + 8 * fq;
        const int layer = u.pn / 36, j0 = col0 - layer * MODW;
#pragma unroll
        for (int m = 0; m < 3; ++m) { const int row = m * 16 + fr; if (row < 33) {
#pragma unroll
            for (int bj = 0; bj < 2; ++bj) { const f32x4 b0 = *(const f32x4*)(b_ada + col0 + bj * 128), b1 = *(const f32x4*)(b_ada + col0 + bj * 128 + 4);
                float* o = MOD + ((size_t)layer * 33 + row) * MODW + j0 + bj * 128;
                *(f32x4*)o = acc[0][bj][m][0] + b0; *(f32x4*)(o + 4) = acc[0][bj][m][1] + b1; } } }
    }
};
struct EpiBranch { EPI_COMMON; static constexpr bool ALIGN = true; static constexpr bool HAS_MID = true; static constexpr int MID1 = 4, MID2 = 12;
    const bf16* G; bf16* Y; int hb;
    __device__ __forceinline__ void mid(Acc& acc, const Unit& u, int tt, int wr, int wc, int fr, int fq) const {
        asm volatile("" : "+v"(fr), "+v"(fq));
        const int lrow0 = ltile(u.pm, hb) * 256 + wr * 64 + fr, col0 = u.pn * 256 + wc * 32 + 8 * fq;
        const int num = tt == 4 ? 0 : D, den = tt == 4 ? D : 2 * D;
#pragma unroll
        for (int ai = 0; ai < 2; ++ai) {
            u32x4 wn[4][2], wd[4][2];
#pragma unroll
            for (int m = 0; m < 4; ++m) { const bf16* gp = G + (size_t)(lrow0 + ai * 128 + m * 16) * 3072 + col0;
#pragma unroll
                for (int bj = 0; bj < 2; ++bj) { wn[m][bj] = *(const u32x4*)(gp + num + bj * 128); wd[m][bj] = *(const u32x4*)(gp + den + bj * 128); } }
            __builtin_amdgcn_sched_barrier(0);
#pragma unroll
            for (int m = 0; m < 4; ++m)
#pragma unroll
                for (int bj = 0; bj < 2; ++bj) { float fn[8], fd[8]; UNPK8(wn[m][bj], fn); UNPK8(wd[m][bj], fd);
#pragma unroll
                    for (int e = 0; e < 8; ++e) { const float r = __builtin_fmaxf(fn[e], 1e-12f) * __builtin_amdgcn_rcpf(__builtin_fmaxf(fd[e], 1e-12f)); acc[ai][bj][m][e >> 2][e & 3] *= r; } }
            asm volatile("" ::: "memory"); }
    }
    __device__ __forceinline__ void operator()(const Acc& acc, const Unit& u, int wr, int wc, int fr, int fq) const {
        const int lrow0 = ltile(u.pm, hb) * 256 + wr * 64 + fr, row0 = u.pm * 256 + wr * 64 + fr, col0 = u.pn * 256 + wc * 32 + 8 * fq;
#pragma unroll
        for (int ai = 0; ai < 2; ++ai) {
            u32x4 wg[4][2];
#pragma unroll
            for (int m = 0; m < 4; ++m)
#pragma unroll
                for (int bj = 0; bj < 2; ++bj) wg[m][bj] = *(const u32x4*)(G + (size_t)(lrow0 + ai * 128 + m * 16) * 3072 + 2 * D + col0 + bj * 128);
            __builtin_amdgcn_sched_barrier(0);
#pragma unroll
            for (int m = 0; m < 4; ++m) { bf16* yp = Y + (size_t)(row0 + ai * 128 + m * 16) * D + col0;
#pragma unroll
                for (int bj = 0; bj < 2; ++bj) { float fg[8]; UNPK8(wg[m][bj], fg);
                    const f32x4 v0 = acc[ai][bj][m][0], v1 = acc[ai][bj][m][1];
                    u32x4 w; w.x = pk2(v0[0] * __builtin_fmaxf(fg[0], 1e-12f), v0[1] * __builtin_fmaxf(fg[1], 1e-12f)); w.y = pk2(v0[2] * __builtin_fmaxf(fg[2], 1e-12f), v0[3] * __builtin_fmaxf(fg[3], 1e-12f));
                    w.z = pk2(v1[0] * __builtin_fmaxf(fg[4], 1e-12f), v1[1] * __builtin_fmaxf(fg[5], 1e-12f)); w.w = pk2(v1[2] * __builtin_fmaxf(fg[6], 1e-12f), v1[3] * __builtin_fmaxf(fg[7], 1e-12f));
                    *(u32x4*)(yp + bj * 128) = w; } } }
    }
};
__device__ __forceinline__ int rope_logical(int p) { return 16 * ((p >> 3) & 1) + 8 * (p >> 4) + (p & 7); }
constexpr int PREP_PER_LAYER = 2 * (16 * 176) + 2 * (44 * 32) + 16 * 160 + 4 * 16 + 2 * 16 + 4 * 32 + 8 * 32 + 4 * 32 + 16 * 32, PREP_ADA = 2 * 16 * 288, PREP_TOTAL = PREP_ADA + 2 * PREP_PER_LAYER;
struct TrDesc { const float* srcp; bf16* dstp; int sstep, dstep; };
__device__ __forceinline__ TrDesc tr_decode(const Params& p, unsigned char* ws, int it, int lane) {
    const float* W0; const float* W1 = nullptr; bf16* dst; int K, ldw, ldd, koff = 0, nrows, kind = 0;
    int r = it;
    if (r < PREP_ADA) { const int L = r / (PREP_ADA / 2); r -= L * (PREP_ADA / 2);
        W0 = p.w_ada + (size_t)L * D * MODW; dst = (bf16*)(ws + WS_WADA) + (size_t)L * MODW * D; K = D; ldw = MODW; ldd = D; nrows = MODW; }
    else { r -= PREP_ADA; const int L = r / PREP_PER_LAYER; r -= L * PREP_PER_LAYER;
        unsigned char* wl = ws + WS_W + (size_t)L * LW_SIZE; bool found = false;
        W0 = nullptr; dst = nullptr; K = 64; ldw = 0; ldd = 0; nrows = 32;
#define TRY_JOB(KIND_, W0_, W1_, K_, LDW_, DST_, LDD_, KOFF_, NROWS_) if (!found) { const int cnt = ((K_) / 64) * ((NROWS_) / 32); if (r < cnt) { found = true; kind = KIND_; W0 = W0_; W1 = W1_; K = K_; ldw = LDW_; dst = (bf16*)(DST_); ldd = LDD_; koff = KOFF_; nrows = NROWS_; } else r -= cnt; }
        TRY_JOB(1, p.f1_wg + (size_t)L * D * DFF, p.f1_wu + (size_t)L * D * DFF, D, DFF, wl + LW_U1, D, 0, 2 * DFF)
        TRY_JOB(0, p.f1_wd + (size_t)L * DFF * D, nullptr, DFF, D, wl + LW_D1, DFF, 0, D)
        TRY_JOB(1, p.f2_wg + (size_t)L * D * DFF, p.f2_wu + (size_t)L * D * DFF, D, DFF, wl + LW_U2, D, 0, 2 * DFF)
        TRY_JOB(0, p.f2_wd + (size_t)L * DFF * D, nullptr, DFF, D, wl + LW_D2, DFF, 0, D)
        TRY_JOB(2, p.w_in + (size_t)L * D * INW, nullptr, D, INW, wl + LW_IN, D, 0, INWP)
        TRY_JOB(3, p.w_uq + (size_t)L * 256 * 384, nullptr, 256, 384, wl + LW_UQ, 256, 0, 512)
        TRY_JOB(0, p.w_ukv + (size_t)L * 128 * 512, nullptr, 128, 512, wl + LW_UKV, 128, 0, 512)
        TRY_JOB(0, p.w_ba + (size_t)L * 256 * D, nullptr, 256, D, wl + LW_BR, D, 0, D)
        TRY_JOB(0, p.w_bb + (size_t)L * 512 * D, nullptr, 512, D, wl + LW_BR, D, 256, D)
        TRY_JOB(0, p.w_bc + (size_t)L * 256 * D, nullptr, 256, D, wl + LW_BR, D, 768, D)
        TRY_JOB(0, p.w_out + (size_t)L * D * D, nullptr, D, D, wl + LW_OUT, D, 0, D)
#undef TRY_JOB
    }
    (void)K;
    const int nblk = nrows / 32, kb = r / nblk, nb = r % nblk, k0 = 64 * kb, n0 = 32 * nb, np = n0 + (lane & 31);
    const float* src = W0; int col = np;
    if (kind == 1) { const int pn = np >> 8, j = np & 255; src = j < 128 ? W0 : W1; col = 128 * pn + (j & 127); }
    else if (kind == 2) { if (np < 1920) col = np; else if (np < 1952) col = 1920 + rope_logical(np - 1920); else if (np < 2048) col = -1; else col = np - 96; }
    else if (kind == 3) { if (np < 384) { const int h = np / 96, j = np % 96; col = j < 64 ? np : 96 * h + 64 + rope_logical(j - 64); } else col = -1; }
    TrDesc d; d.srcp = col >= 0 ? src + (size_t)(k0 + (lane >> 5)) * ldw + col : nullptr; d.sstep = 2 * ldw;
    d.dstp = dst + (size_t)(n0 + (lane >> 3)) * ldd + koff + k0 + 8 * (lane & 7); d.dstep = 8 * ldd;
    return d;
}
#define TR_LOAD(DESC, V) do { _Pragma("unroll") for (int i = 0; i < 32; ++i) V[i] = (DESC).srcp ? (DESC).srcp[(size_t)i * (DESC).sstep] : 0.f; } while (0)
__device__ __forceinline__ void tr_finish(const TrDesc& d, const float (&v)[32], LAS float* scr, int lane) {
#pragma unroll
    for (int i = 0; i < 32; ++i) scr[(2 * i + (lane >> 5)) * 33 + (lane & 31)] = v[i];
    asm volatile("s_waitcnt lgkmcnt(0)" ::: "memory");
    const int c = lane & 7;
#pragma unroll
    for (int j = 0; j < 4; ++j) { const int n = (lane >> 3) + 8 * j; const LAS float* s = scr + (8 * c) * 33 + n;
        u32x4 o; o.x = pk2(s[0 * 33], s[1 * 33]); o.y = pk2(s[2 * 33], s[3 * 33]); o.z = pk2(s[4 * 33], s[5 * 33]); o.w = pk2(s[6 * 33], s[7 * 33]);
        *(u32x4*)(d.dstp + (size_t)j * d.dstep) = o; }
    asm volatile("s_waitcnt lgkmcnt(0)" ::: "memory");
}
__device__ __forceinline__ void prep_phase(const Params& p, LAS unsigned char* lds, int tid, int bid, int nbk, int item_lo, int item_hi, int wg0, bool misc) {
    asm volatile("" : "+v"(tid)); const int lane = tid & 63, wave = __builtin_amdgcn_readfirstlane(tid >> 6);
    LAS float* scr = (LAS float*)(lds + wave * 16384);
    const int gw = (bid - wg0) * 8 + wave, NGW = (nbk - wg0) * 8;
    unsigned char* ws = p.ws;
    if (bid >= wg0 && item_lo + gw < item_hi) {
        TrDesc dc = tr_decode(p, ws, item_lo + gw, lane); float vc[32]; TR_LOAD(dc, vc);
        for (int it = item_lo + gw; it < item_hi; it += NGW) {
            const bool more = it + NGW < item_hi;
            TrDesc dn = dc; float vn[32];
            if (more) { dn = tr_decode(p, ws, it + NGW, lane); TR_LOAD(dn, vn); }
            tr_finish(dc, vc, scr, lane);
            if (more) { dc = dn;
#pragma unroll
                for (int i = 0; i < 32; ++i) vc[i] = vn[i]; }
        }
    }
    bf16* SC = (bf16*)(ws + WS_SC);
    if (misc) for (int i = bid * 512 + tid; i < 256 * D; i += nbk * 512) { const int row = i >> 10, col = i & 1023;
        float v = 0.f; if (row < 32) v = fsilu(p.c[row * D + col]); else if (row == 32) v = fsilu(p.c_ctx[col]);
        SC[i] = (bf16)(pk2(v, 0.f) & 0xffffu); }
}

__device__ __forceinline__ void normmod_phase(const float* xlat, const float* xctx, const float* gain, const float* modl, int sidx, bf16* NBp, int row_lo, int nrows, int tid, int bid, int nbk, int wg0) {
    asm volatile("" : "+v"(tid)); const int lane = tid & 63, wave = __builtin_amdgcn_readfirstlane(tid >> 6);
    if (bid < wg0) return;
    const int gw = row_lo + (bid - wg0) * 8 + wave, NGW = (nbk - wg0) * 8;
    f32x4 gv[4];
#pragma unroll
    for (int j = 0; j < 4; ++j) gv[j] = *(const f32x4*)(gain + 4 * lane + 256 * j);
    constexpr int R = 3;
    for (int row0 = gw; row0 < nrows; row0 += R * NGW) {
        f32x4 v[R][4]; f32x4 sh[R][4], sc[R][4];
#pragma unroll
        for (int q = 0; q < R; ++q) { const int row = row0 + q * NGW; if (row < nrows) {
            const float* xr = row < ML ? xlat + (size_t)row * D : xctx + (size_t)(row - ML) * D;
#pragma unroll
            for (int j = 0; j < 4; ++j) v[q][j] = *(const f32x4*)(xr + 4 * lane + 256 * j); } }
#pragma unroll
        for (int q = 0; q < R; ++q) { const int row = row0 + q * NGW; if (row < nrows) {
            const float* mr = modl + (size_t)(row < ML ? (row >> 11) : 32) * MODW + sidx * D;
#pragma unroll
            for (int j = 0; j < 4; ++j) { sh[q][j] = *(const f32x4*)(mr + 4 * lane + 256 * j); sc[q][j] = *(const f32x4*)(mr + D + 4 * lane + 256 * j); } } }
#pragma unroll
        for (int q = 0; q < R; ++q) { const int row = row0 + q * NGW; if (row < nrows) {
            float ss = 0.f;
#pragma unroll
            for (int j = 0; j < 4; ++j) ss += (v[q][j].x * v[q][j].x + v[q][j].y * v[q][j].y) + (v[q][j].z * v[q][j].z + v[q][j].w * v[q][j].w);
            const float rstd = 1.0f / sqrtf(wave_sum(ss) * (1.f / D) + EPS);
            u32x2* o = (u32x2*)(NBp + (size_t)row * D) + lane;
#pragma unroll
            for (int j = 0; j < 4; ++j) { const f32x4 n = (v[q][j] * rstd) * gv[j] * (sc[q][j] + 1.0f) + sh[q][j];
                u32x2 w; w.x = pk2(n.x, n.y); w.y = pk2(n.z, n.w); o[64 * j] = w; } } }
    }
}
__device__ __forceinline__ void final_phase(float* out, const float* gain, int tid, int bid, int nbk) {
    asm volatile("" : "+v"(tid)); const int lane = tid & 63, wave = __builtin_amdgcn_readfirstlane(tid >> 6);
    const int gw = bid * 8 + wave, NGW = nbk * 8;
    f32x4 gv[4];
#pragma unroll
    for (int j = 0; j < 4; ++j) gv[j] = *(const f32x4*)(gain + 4 * lane + 256 * j);
    constexpr int R = 3;
    for (int row0 = gw; row0 < ML; row0 += R * NGW) {
        f32x4 v[R][4];
#pragma unroll
        for (int q = 0; q < R; ++q) { const int row = row0 + q * NGW; if (row < ML) {
#pragma unroll
            for (int j = 0; j < 4; ++j) v[q][j] = *(const f32x4*)(out + (size_t)row * D + 4 * lane + 256 * j); } }
#pragma unroll
        for (int q = 0; q < R; ++q) { const int row = row0 + q * NGW; if (row < ML) {
            float ss = 0.f;
#pragma unroll
            for (int j = 0; j < 4; ++j) ss += (v[q][j].x * v[q][j].x + v[q][j].y * v[q][j].y) + (v[q][j].z * v[q][j].z + v[q][j].w * v[q][j].w);
            const float rstd = 1.0f / sqrtf(wave_sum(ss) * (1.f / D) + EPS);
#pragma unroll
            for (int j = 0; j < 4; ++j) *(f32x4*)(out + (size_t)row * D + 4 * lane + 256 * j) = (v[q][j] * rstd) * gv[j]; } }
    }
}

__device__ __forceinline__ void post_phase(bf16* bB, bf16* bC, const float* k_norm, const float* mq_norm, const float* mkv_norm, int tid, int bid, int nbk) {
    asm volatile("" : "+v"(tid)); const int lane = tid & 63, wave = __builtin_amdgcn_readfirstlane(tid >> 6);
    const int gw = bid * 8 + wave, NGW = nbk * 8;
    const int hd = lane >> 5, a = (lane >> 4) & 1, f = lane & 15, d0 = 32 * a + f;
    const int a2 = (lane >> 3) & 1, f2 = lane & 7;
    const float kg0 = k_norm[d0], kg1 = k_norm[d0 + 16];
    const f32x4 qg = *(const f32x4*)(mq_norm + 4 * lane);
    const float vg0 = mkv_norm[2 * lane], vg1 = mkv_norm[2 * lane + 1];
    const float fr1 = __builtin_amdgcn_exp2f(-(float)f * (13.287712379549449f / 16.f)), fr2 = __builtin_amdgcn_exp2f(-(float)f2 * (13.287712379549449f / 8.f));
    constexpr int R = 4;
    for (int row0 = gw; row0 < HM; row0 += R * NGW) {
        unsigned k0r[R], k1r[R], cvr[R], r0r[R], r1r[R]; u32x2 cqr[R];
#pragma unroll
        for (int q = 0; q < R; ++q) { const int row = row0 + q * NGW; if (row < HM) {
            const bf16* kp = bB + (size_t)row * 768 + 512 + hd * 64; const bf16* cp = bC + (size_t)row * 512;
            k0r[q] = kp[d0]; k1r[q] = kp[d0 + 16]; cqr[q] = *(const u32x2*)(cp + 4 * lane); cvr[q] = *(const unsigned*)(cp + 256 + 2 * lane);
            r0r[q] = cp[384 + 8 * a2 + f2]; r1r[q] = cp[384 + 16 + 8 * a2 + f2]; } }
#pragma unroll
        for (int q = 0; q < R; ++q) { const int row = row0 + q * NGW; if (row < HM) {
            const bool lat = row < HL; const int t = row & (SEQ - 1); const float prow = (float)(t >> 6), pcol = (float)(t & 63);
            bf16* kp = bB + (size_t)row * 768 + 512 + hd * 64; bf16* cp = bC + (size_t)row * 512;
            { float x0 = bf2f(k0r[q]), x1 = bf2f(k1r[q]);
              const float rstd = 1.0f / sqrtf(sum32(x0 * x0 + x1 * x1) * (1.f / 64.f) + EPS);
              x0 = x0 * rstd * kg0; x1 = x1 * rstd * kg1;
              if (lat) { const float ang = (a ? pcol : prow) * fr1; const float cs = __cosf(ang), sn = __sinf(ang);
                  const float y0 = x0 * cs - x1 * sn, y1 = x1 * cs + x0 * sn; x0 = y0; x1 = y1; }
              kp[d0] = (bf16)(pk2(x0, 0.f) & 0xffffu); kp[d0 + 16] = (bf16)(pk2(x1, 0.f) & 0xffffu); }
            { const u32x2 w = cqr[q];
              const float x[4] = {bf2f(w.x & 0xffffu), __uint_as_float(w.x & 0xffff0000u), bf2f(w.y & 0xffffu), __uint_as_float(w.y & 0xffff0000u)};
              const float rstd = 1.0f / sqrtf(wave_sum((x[0] * x[0] + x[1] * x[1]) + (x[2] * x[2] + x[3] * x[3])) * (1.f / 256.f) + EPS);
              u32x2 o; o.x = pk2(x[0] * rstd * qg.x, x[1] * rstd * qg.y); o.y = pk2(x[2] * rstd * qg.z, x[3] * rstd * qg.w); *(u32x2*)(cp + 4 * lane) = o; }
            { const unsigned w = cvr[q]; const float x0 = bf2f(w & 0xffffu), x1 = __uint_as_float(w & 0xffff0000u);
              const float rstd = 1.0f / sqrtf(wave_sum(x0 * x0 + x1 * x1) * (1.f / 128.f) + EPS);
              *(unsigned*)(cp + 256 + 2 * lane) = pk2(x0 * rstd * vg0, x1 * rstd * vg1); }
            if (lat && lane < 16) { const float x0 = bf2f(r0r[q]), x1 = bf2f(r1r[q]);
              const float ang = (a2 ? pcol : prow) * fr2; const float cs = __cosf(ang), sn = __sinf(ang);
              cp[384 + 8 * a2 + f2] = (bf16)(pk2(x0 * cs - x1 * sn, 0.f) & 0xffffu); cp[384 + 16 + 8 * a2 + f2] = (bf16)(pk2(x1 * cs + x0 * sn, 0.f) & 0xffffu); }
        } }
    }
}
constexpr int KTP = 208, KTB = 64 * KTP, VTP = 144, VTB = 64 * VTP;
constexpr int A_KT = 0, A_VT = 2 * KTB, A_BIAS = A_VT + 3 * VTB, A_END = A_BIAS + 480 * 4;
struct AttnArgs { const bf16* bA; const bf16* bB; const bf16* bC; const bf16* MQ; const bf16* MKV; bf16* OB; const float* q_norm; const float* na_bias; int hb; int with_ctx_q; };
__device__ __forceinline__ int crow(int r, int hi) { return (r & 3) + 8 * (r >> 2) + 4 * hi; }
__device__ __forceinline__ int na_r0(int r) { const int v = r - 4; return v < 0 ? 0 : (v > 24 ? 24 : v); }


template <int QD> __device__ __forceinline__ void attn_tile(const bf16x8 (&qf)[QD], bool& fresh, f32x16& negm, float& m2, float& lsum, f32x16& o0, f32x16& o1, const LAS unsigned char* kb, const LAS unsigned char* vb,
                                                           bool local, const LAS float* bt, int c0, int hi) {
    bf16x8 k0[QD], k1[QD];
#pragma unroll
    for (int d0 = 0; d0 < QD; ++d0) { k0[d0] = *(const LAS bf16x8*)(kb + d0 * 32); k1[d0] = *(const LAS bf16x8*)(kb + 32 * KTP + d0 * 32); }
    bf16x8 vfa[4], vfc[4];
#pragma unroll
    for (int j4 = 0; j4 < 4; ++j4) { vfa[j4] = *(const LAS bf16x8*)(vb + j4 * 32); vfc[j4] = *(const LAS bf16x8*)(vb + 32 * VTP + j4 * 32); }
    __builtin_amdgcn_sched_barrier(0);
    f32x16 s0, s1;
    s0 = __builtin_amdgcn_mfma_f32_32x32x16_bf16(k0[0], qf[0], negm, 0, 0, 0); s1 = __builtin_amdgcn_mfma_f32_32x32x16_bf16(k1[0], qf[0], negm, 0, 0, 0);
#pragma unroll
    for (int d0 = 1; d0 < QD; ++d0) { s0 = __builtin_amdgcn_mfma_f32_32x32x16_bf16(k0[d0], qf[d0], s0, 0, 0, 0); s1 = __builtin_amdgcn_mfma_f32_32x32x16_bf16(k1[d0], qf[d0], s1, 0, 0, 0); }
    if (local) {
        int base = 4 * hi - c0; asm volatile("" : "+v"(base));
        const LAS float* btl = bt + 4 * hi;
#pragma unroll
        for (int r = 0; r < 16; ++r) { const int cr = (r & 3) + 8 * (r >> 2);
            s0[r] = ((unsigned)(cr + base) < 16u) ? s0[r] + btl[cr] : -1e30f;
            s1[r] = ((unsigned)(cr + 32 + base) < 16u) ? s1[r] + btl[cr + 32] : -1e30f; }
    }
    float tmax;
    { float a = __builtin_fmaxf(s0[0], s1[0]), b = __builtin_fmaxf(s0[1], s1[1]);
#pragma unroll
      for (int r = 2; r < 16; r += 2) { a = __builtin_fmaxf(__builtin_fmaxf(a, s0[r]), s1[r]); b = __builtin_fmaxf(__builtin_fmaxf(b, s0[r + 1]), s1[r + 1]); }
      tmax = half_max(__builtin_fmaxf(a, b)); }
    if (fresh || __any(tmax > 8.0f)) {
        const float dl = fresh ? tmax : __builtin_fmaxf(tmax, 0.f); m2 += dl; fresh = false;
#pragma unroll
        for (int r = 0; r < 16; ++r) { s0[r] -= dl; s1[r] -= dl; negm[r] = -m2; }
        const float al = __builtin_amdgcn_exp2f(-dl); lsum *= al;
#pragma unroll
        for (int r = 0; r < 16; ++r) { o0[r] *= al; o1[r] *= al; } }
    float ps0 = 0.f, ps1 = 0.f;
#pragma unroll
    for (int r = 0; r < 16; ++r) { s0[r] = __builtin_amdgcn_exp2f(s0[r]); s1[r] = __builtin_amdgcn_exp2f(s1[r]); ps0 += s0[r]; ps1 += s1[r]; }
    lsum += ps0 + ps1;
    bf16x8 pb[4];
    { u32x4 w;
      w.x = pk2(s0[0], s0[1]); w.y = pk2(s0[2], s0[3]); w.z = pk2(s0[4], s0[5]); w.w = pk2(s0[6], s0[7]); pb[0] = __builtin_bit_cast(bf16x8, w);
      w.x = pk2(s0[8], s0[9]); w.y = pk2(s0[10], s0[11]); w.z = pk2(s0[12], s0[13]); w.w = pk2(s0[14], s0[15]); pb[1] = __builtin_bit_cast(bf16x8, w);
      w.x = pk2(s1[0], s1[1]); w.y = pk2(s1[2], s1[3]); w.z = pk2(s1[4], s1[5]); w.w = pk2(s1[6], s1[7]); pb[2] = __builtin_bit_cast(bf16x8, w);
      w.x = pk2(s1[8], s1[9]); w.y = pk2(s1[10], s1[11]); w.z = pk2(s1[12], s1[13]); w.w = pk2(s1[14], s1[15]); pb[3] = __builtin_bit_cast(bf16x8, w); }
#pragma unroll
    for (int j4 = 0; j4 < 4; ++j4) {
        o0 = __builtin_amdgcn_mfma_f32_32x32x16_bf16(vfa[j4], pb[j4], o0, 0, 0, 0);
        o1 = __builtin_amdgcn_mfma_f32_32x32x16_bf16(vfc[j4], pb[j4], o1, 0, 0, 0); }
}

template <int TYPE  >
__device__ __forceinline__ void attn_unit(const AttnArgs& a, int bl, int head, int qb  , LAS unsigned char* lds, int tid) {
    constexpr int QD = TYPE == 2 ? 6 : 4;
    asm volatile("" : "+v"(tid));
    const int lane = tid & 63, wid = __builtin_amdgcn_readfirstlane(tid >> 6), q32 = lane & 31, hi = lane >> 5;
    const bool isctx = qb < 0;
    const int lat_row0 = bl * SEQ, ctx_row0 = HL + bl * CTXL;
    const bf16* Qb; const bf16* Kb; const bf16* Vb; int qp, kp, vp, ocol; float scale;
    if (TYPE == 0) { Qb = a.bA + 64 * head; Kb = a.bA + 256 + 64 * head; Vb = a.bA + 512 + 64 * head; qp = kp = vp = 768; ocol = 64 * head; scale = 0.125f; }
    else if (TYPE == 1) { Qb = a.bB + 64 * head; Kb = a.bB + 512 + 64 * (head >> 2); Vb = a.bB + 640 + 64 * (head >> 2); qp = kp = vp = 768; ocol = 256 + 64 * head; scale = 0.125f; }
    else { Qb = a.MQ + 96 * head; Kb = a.MKV + 128 * head; Vb = a.MKV + 128 * head + 64; qp = kp = vp = 512; ocol = 768 + 64 * head; scale = 0.10206207261596575f; }
    const float sc2 = scale * LOG2E;
    int nfirst, first_base, kr_lo = 0;
    if (isctx) { nfirst = 0; first_base = 0; }
    else if (TYPE == 0) { kr_lo = na_r0(4 * qb); const int kr_hi = na_r0(4 * qb + 3) + 7; nfirst = kr_hi - kr_lo + 1; first_base = lat_row0 + 64 * kr_lo; }
    else { nfirst = 32; first_base = lat_row0; }
    const int NT = nfirst + 4;
#define TILE_ROW(j) ((j) < nfirst ? first_base + 64 * (j) : ctx_row0 + 64 * ((j) - nfirst))
    const int krow = tid >> 3, kc = tid & 7, k2row = tid >> 2, k2c = tid & 3;
    u32x4 kA, vA, k2A = (u32x4){0u, 0u, 0u, 0u}, kB, vB, k2B = (u32x4){0u, 0u, 0u, 0u};
#define LOAD_TILE(j, kreg, vreg, k2reg) do { const int rb_ = TILE_ROW(j); kreg = *(const u32x4*)(Kb + (size_t)(rb_ + krow) * kp + 8 * kc); vreg = *(const u32x4*)(Vb + (size_t)(rb_ + krow) * vp + 8 * kc); \
        if (TYPE == 2 && tid < 256) k2reg = *(const u32x4*)(a.bC + (size_t)(rb_ + k2row) * 512 + 384 + 8 * k2c); } while (0)
#define STORE_TILE(buf, vbuf, kreg, vreg, k2reg) do { *(LAS u32x4*)(lds + A_KT + (buf) * KTB + krow * KTP + kc * 16) = kreg; \
        if (TYPE == 2 && tid < 256) *(LAS u32x4*)(lds + A_KT + (buf) * KTB + k2row * KTP + 128 + k2c * 16) = k2reg; \
          \
        { const bool odd_ = krow & 1; \
          const unsigned snd0_ = odd_ ? vreg.x : vreg.z, snd1_ = odd_ ? vreg.y : vreg.w;             \
          const unsigned rcv0_ = (unsigned)__builtin_amdgcn_ds_swizzle((int)snd0_, (8 << 10) | 0x1f), rcv1_ = (unsigned)__builtin_amdgcn_ds_swizzle((int)snd1_, (8 << 10) | 0x1f); \
          const unsigned ev0_ = odd_ ? rcv0_ : vreg.x, ev1_ = odd_ ? rcv1_ : vreg.y, od0_ = odd_ ? vreg.z : rcv0_, od1_ = odd_ ? vreg.w : rcv1_;     \
          const int kvp_ = (krow & 0x30) | ((krow & 4) << 1) | ((krow & 8) >> 1) | (krow & 2);        \
          LAS unsigned* vt_ = (LAS unsigned*)(lds + A_VT + (vbuf) * VTB + (8 * kc + 4 * (krow & 1)) * VTP + kvp_ * 2); \
          vt_[0 * (VTP / 4)] = __builtin_amdgcn_perm(od0_, ev0_, 0x05040100u); vt_[1 * (VTP / 4)] = __builtin_amdgcn_perm(od0_, ev0_, 0x07060302u); \
          vt_[2 * (VTP / 4)] = __builtin_amdgcn_perm(od1_, ev1_, 0x05040100u); vt_[3 * (VTP / 4)] = __builtin_amdgcn_perm(od1_, ev1_, 0x07060302u); } } while (0)
    LOAD_TILE(0, kA, vA, k2A);
    if (TYPE == 0 && !isctx) { if (tid < 465) ((LAS float*)(lds + A_BIAS))[tid] = a.na_bias[head * 465 + tid] * LOG2E; }
    const int qloc = 32 * wid + q32;
    const int qrow_l = isctx ? ctx_row0 + qloc : lat_row0 + 256 * qb + qloc;
    const size_t orow_p = isctx ? (size_t)ML + (size_t)(a.hb * BPH + bl) * CTXL + qloc : (size_t)(a.hb * BPH + bl) * SEQ + 256 * qb + qloc;
    bf16x8 qf[QD];
    {
        u32x4 qw[QD];
#pragma unroll
        for (int d0 = 0; d0 < QD; ++d0) qw[d0] = *(const u32x4*)(Qb + (size_t)qrow_l * qp + 16 * d0 + 8 * hi);
        if (TYPE == 1) {
            float x[4][8]; float ss = 0.f;
#pragma unroll
            for (int d0 = 0; d0 < 4; ++d0) { UNPK8(qw[d0], x[d0]);
#pragma unroll
                for (int i = 0; i < 8; ++i) ss += x[d0][i] * x[d0][i]; }
            ss = half_sum(ss);
            const float rstd = sc2 / sqrtf(ss * (1.f / 64.f) + EPS);
#pragma unroll
            for (int d0 = 0; d0 < 4; ++d0) { const f32x4 g0 = *(const f32x4*)(a.q_norm + 16 * d0 + 8 * hi), g1 = *(const f32x4*)(a.q_norm + 16 * d0 + 8 * hi + 4);
#pragma unroll
                for (int i = 0; i < 4; ++i) { x[d0][i] *= rstd * g0[i]; x[d0][4 + i] *= rstd * g1[i]; } }
            if (!isctx) { const int t = 256 * qb + qloc; const float prow = (float)(t >> 6), pcol = (float)(t & 63);
#pragma unroll
                for (int i = 0; i < 8; ++i) { const float fr_ = __builtin_amdgcn_exp2f(-(float)(8 * hi + i) * (13.287712379549449f / 16.f));
                    { const float ang = prow * fr_, cs = __cosf(ang), sn = __sinf(ang), y0 = x[0][i] * cs - x[1][i] * sn, y1 = x[1][i] * cs + x[0][i] * sn; x[0][i] = y0; x[1][i] = y1; }
                    { const float ang = pcol * fr_, cs = __cosf(ang), sn = __sinf(ang), y0 = x[2][i] * cs - x[3][i] * sn, y1 = x[3][i] * cs + x[2][i] * sn; x[2][i] = y0; x[3][i] = y1; } } }
#pragma unroll
            for (int d0 = 0; d0 < 4; ++d0) { qw[d0].x = pk2(x[d0][0], x[d0][1]); qw[d0].y = pk2(x[d0][2], x[d0][3]); qw[d0].z = pk2(x[d0][4], x[d0][5]); qw[d0].w = pk2(x[d0][6], x[d0][7]); }
        }
        if (TYPE == 2 && !isctx) {
            float x0[8], x1[8]; UNPK8(qw[4], x0); UNPK8(qw[5], x1);
            const int t = 256 * qb + qloc; const float pos = hi ? (float)(t & 63) : (float)(t >> 6);
#pragma unroll
            for (int i = 0; i < 8; ++i) { const float ang = pos * __builtin_amdgcn_exp2f(-(float)i * (13.287712379549449f / 8.f)), cs = __cosf(ang), sn = __sinf(ang);
                const float y0 = x0[i] * cs - x1[i] * sn, y1 = x1[i] * cs + x0[i] * sn; x0[i] = y0; x1[i] = y1; }
            qw[4].x = pk2(x0[0], x0[1]); qw[4].y = pk2(x0[2], x0[3]); qw[4].z = pk2(x0[4], x0[5]); qw[4].w = pk2(x0[6], x0[7]);
            qw[5].x = pk2(x1[0], x1[1]); qw[5].y = pk2(x1[2], x1[3]); qw[5].z = pk2(x1[4], x1[5]); qw[5].w = pk2(x1[6], x1[7]);
        }
#pragma unroll
        for (int d0 = 0; d0 < QD; ++d0) qf[d0] = __builtin_bit_cast(bf16x8, qw[d0]);
    }
    STORE_TILE(0, 0, kA, vA, k2A);
    if (NT > 1) LOAD_TILE(1, kA, vA, k2A);
    if (NT > 2) LOAD_TILE(2, kB, vB, k2B);
    __syncthreads();
    const int na_r = 4 * qb + (wid >> 1), na_w0 = na_r0(na_r), qc = 32 * (wid & 1) + q32;
    const int c0 = (qc - 8) < 0 ? 0 : ((qc - 8) > 48 ? 48 : (qc - 8));
    bool fresh = true; float m2 = 0.f, lsum = 0.f; f32x16 o0 = {}, o1 = {}, negm = {};
#define ATT_COMPUTE(IT) do { bool act_c = true; const bool local = (TYPE == 0) && ((IT) < nfirst); \
        if (local) { const int kr = kr_lo + (IT); act_c = (kr >= na_w0) && (kr < na_w0 + 8); } \
        if (act_c) attn_tile<QD>(qf, fresh, negm, m2, lsum, o0, o1, lds + A_KT + ((IT) & 1) * KTB + q32 * KTP + hi * 16, lds + A_VT + ((IT) & 1) * VTB + q32 * VTP + hi * 16, \
                                 local, (const LAS float*)(lds + A_BIAS) + (kr_lo + (IT) - na_r + 7) * 31 + 15 - qc, c0, hi); } while (0)
    for (int it = 0; it < NT; it += 2) {
        ATT_COMPUTE(it);
        if (it + 1 < NT) STORE_TILE(1, 1, kA, vA, k2A);
        if (it + 3 < NT) LOAD_TILE(it + 3, kA, vA, k2A);
        __syncthreads();
        if (it + 1 < NT) {
            ATT_COMPUTE(it + 1);
            if (it + 2 < NT) STORE_TILE(0, 0, kB, vB, k2B);
            if (it + 4 < NT) LOAD_TILE(it + 4, kB, vB, k2B);
            __syncthreads();
        }
    }
#undef ATT_COMPUTE
    lsum = half_sum(lsum);
    const float inv = 1.0f / lsum;
    bf16* op = a.OB + orow_p * D + ocol + 4 * hi;
#pragma unroll
    for (int g = 0; g < 4; ++g) { u32x2 w;
        w.x = pk2(o0[4 * g] * inv, o0[4 * g + 1] * inv); w.y = pk2(o0[4 * g + 2] * inv, o0[4 * g + 3] * inv); *(u32x2*)(op + 8 * g) = w;
        w.x = pk2(o1[4 * g] * inv, o1[4 * g + 1] * inv); w.y = pk2(o1[4 * g + 2] * inv, o1[4 * g + 3] * inv); *(u32x2*)(op + 32 + 8 * g) = w; }
#undef TILE_ROW
#undef LOAD_TILE
#undef STORE_TILE
}
__device__ __forceinline__ void attn_phase(const AttnArgs& a, LAS unsigned char* lds, int tid, int bid, int nbk) {
    const int nunits = 2048 + (a.with_ctx_q ? 256 : 0);
    for (int u = bid; u < nunits; u += nbk) {
        const int rnd = u >> 8, blk = u & 255, x = blk & 7, y = blk >> 3;
        int type, bl, head, qb;
        if (rnd < 4) { const int g = 4 * x + rnd; type = 1; bl = g >> 1; head = 4 * (g & 1) + (y >> 3); qb = y & 7; }
        else if (rnd < 8) { const int g = ((rnd - 4) & 1) * 32 + 4 * x + (y >> 3); type = rnd < 6 ? 2 : 0; bl = g >> 2; head = g & 3; qb = y & 7; }
        else { const int h16 = blk & 15; bl = blk >> 4; qb = -1; if (h16 < 4) { type = 0; head = h16; } else if (h16 < 12) { type = 1; head = h16 - 4; } else { type = 2; head = h16 - 12; } }
        if (type == 1) attn_unit<1>(a, bl, head, qb, lds, tid); else if (type == 2) attn_unit<2>(a, bl, head, qb, lds, tid); else attn_unit<0>(a, bl, head, qb, lds, tid);
    }
}
constexpr size_t WS_CTL = 0, CTL_ZERO_BYTES = 16384;
#define XB_TMO      128
#define XB_XCNT(j)  (256  + 64 * (j))
#define XB_XSUB(j)  (1280 + 64 * (j))
#define XB_XGEN(j)  (2304 + 64 * (j))
#define XB_TOP      3328
#define XB_TOPGEN   3392
#define XCD_BAR_WORDS 3456
#define XB_SPIN_CAP (1u << 18)

__device__ __forceinline__ unsigned xb_ld(unsigned* p)              { return __hip_atomic_load(p, __ATOMIC_RELAXED, __HIP_MEMORY_SCOPE_AGENT); }
__device__ __forceinline__ unsigned xb_add(unsigned* p, unsigned v) { return __hip_atomic_fetch_add(p, v, __ATOMIC_RELAXED, __HIP_MEMORY_SCOPE_AGENT); }
__device__ __forceinline__ unsigned xb_xcc_id() { return (unsigned)__builtin_amdgcn_s_getreg((3 << 11) | 20) & 0xFu; }
#define XB_SPIN(cond, bar) do { unsigned _sp = 0; while (cond) { __builtin_amdgcn_s_sleep(1); \
    if ((++_sp & 255u) == 0u) { if (xb_ld(&(bar)[XB_TMO])) break; if (_sp > XB_SPIN_CAP) { atomicAdd(&(bar)[XB_TMO], 1u); break; } } } } while (0)

struct XcdBarrier {
    unsigned* bar; unsigned x;
    volatile LAS unsigned* st;
};

__device__ __forceinline__ XcdBarrier xcd_barrier_post(unsigned* bar, volatile LAS unsigned* st) {
    XcdBarrier b; b.bar = bar; b.x = xb_xcc_id(); b.st = st;
    if (threadIdx.x == 0) (void)xb_add(&bar[XB_XCNT(b.x)], 1u);
    return b;
}
__device__ __forceinline__ void xcd_barrier_complete(unsigned* bar, unsigned x, unsigned& nloc, unsigned& nx) {
    const unsigned G = gridDim.x * gridDim.y * gridDim.z;
    unsigned sum, cnt, mine, sp = 0u;
    for (;;) {
        sum = 0u; cnt = 0u; mine = 0u;
#pragma unroll
        for (unsigned j = 0; j < 16; ++j) { const unsigned c = xb_ld(&bar[XB_XCNT(j)]); sum += c; cnt += (c > 0u) ? 1u : 0u; mine = (j == x) ? c : mine; }
        if (sum == G) break;
        __builtin_amdgcn_s_sleep(1);
        if ((++sp & 255u) == 0u) { if (xb_ld(&bar[XB_TMO])) break; if (sp > XB_SPIN_CAP) { atomicAdd(&bar[XB_TMO], 1u); break; } }
    }
    nloc = mine > 0u ? mine : 1u; nx = cnt > 0u ? cnt : 1u;
}

__device__ __forceinline__ void xcd_barrier(const XcdBarrier& b) {
    asm volatile("s_waitcnt vmcnt(0)" ::: "memory");
    __syncthreads();
    if (threadIdx.x == 0) {
        unsigned* bar = b.bar;
        __builtin_amdgcn_s_waitcnt(0);
        unsigned nloc = b.st[0], nx = b.st[1];
        if (nloc == 0u) { xcd_barrier_complete(bar, b.x, nloc, nx); b.st[0] = nloc; b.st[1] = nx; }
        const unsigned old = xb_add(&bar[XB_XSUB(b.x)], 1u);
        const unsigned gen = old / nloc;
        if (old + 1u == (gen + 1u) * nloc) {
            __builtin_amdgcn_fence(__ATOMIC_RELEASE, "agent");
            asm volatile("s_waitcnt vmcnt(0)" ::: "memory");
            const unsigned og = xb_add(&bar[XB_TOP], 1u);
            const unsigned tg = og / nx;
            if (og + 1u == (tg + 1u) * nx) xb_add(&bar[XB_TOPGEN], 1u);
            else XB_SPIN(xb_ld(&bar[XB_TOPGEN]) == tg, bar);
            __builtin_amdgcn_fence(__ATOMIC_ACQUIRE, "agent");
            xb_add(&bar[XB_XGEN(b.x)], 1u);
            asm volatile("s_waitcnt vmcnt(0)" ::: "memory");
        } else {
            XB_SPIN(xb_ld(&bar[XB_XGEN(b.x)]) == gen, bar);
            __builtin_amdgcn_fence(__ATOMIC_ACQUIRE, "agent");
            asm volatile("s_waitcnt vmcnt(0)" ::: "memory");
        }
    }
    __syncthreads();
}
constexpr int XB_LDS_OFF = pg8::STAGE_BYTES, LDS_BYTES = pg8::STAGE_BYTES + 64;
static_assert(A_END <= pg8::STAGE_BYTES && XCD_BAR_WORDS * 4 <= (int)CTL_ZERO_BYTES && CTL_ZERO_BYTES <= WS_SC, "LDS / ctl map");
#define GEMM_RUN(EPI_T, E, APTR, LDA, BPTR, LDB, KK, NN, NL, NC, LAT0, CTX0) do { const pg8::Gemm g_{(const bf16*)(APTR), (const bf16*)(BPTR), (LDA), (LDB), (KK)}; \
    MapOrder S_; S_.init((NL), (NC), (LAT0), (CTX0), (NN), nbk, bid); pg8::gemm_phase<EPI_T, MapOrder, EPI_T::ALIGN, true>(lds, g_, S_, E, tid); } while (0)
constexpr int PH_PER_LAYER = 4 + 5 * NCH + 4, PH_TOTAL = 2 + DEPTH * PH_PER_LAYER + 1;

__global__ void __launch_bounds__(512, 2) mega_fwd(Params p_unused) {
#if defined(__HIP_DEVICE_COMPILE__)
    extern __shared__ __attribute__((aligned(16))) unsigned char lds_raw[];
    LAS unsigned char* lds = (LAS unsigned char*)lds_raw;
    cg::grid_group grid = cg::this_grid();
    typedef const __attribute__((address_space(4))) Params* KP;
    const int wave_s = __builtin_amdgcn_readfirstlane(threadIdx.x >> 6);
    if (threadIdx.x < 16) ((LAS unsigned*)(lds + XB_LDS_OFF))[threadIdx.x] = 0u;
    __syncthreads();
    { KP pp0 = (KP)__builtin_amdgcn_kernarg_segment_ptr(); (void)xcd_barrier_post((unsigned*)(pp0->ws + WS_CTL), (volatile LAS unsigned*)(lds + XB_LDS_OFF)); }
#ifndef PROBE_KIND
#define PROBE_KIND -1
#endif
#ifndef PROBE_SYNCS
#define PROBE_SYNCS 0
#endif
    for (int ph2 = 0; ph2 < PH_TOTAL * 2; ++ph2) {
        const int ph = ph2 >> 1;
        if (ph2 & 1) { bool rep = false;
            if (PROBE_KIND >= 0 && ph >= 2 && ph < PH_TOTAL - 1) { const int st_ = (ph - 2) % PH_PER_LAYER; int k_;
                if (st_ < 3) k_ = st_; else if (st_ == 3) k_ = 0; else if (st_ < 4 + 5 * NCH) k_ = 3 + (st_ - 4) % 5; else if (st_ == 4 + 5 * NCH) k_ = 8; else k_ = st_ - (5 + 5 * NCH);
                rep = (k_ == PROBE_KIND); }
            if (PROBE_KIND == 12) rep = (ph == 4);
            if (PROBE_KIND == 13) rep = (ph == 0);
            if (!rep) continue; }
        int lane_, wv_ = wave_s, bid = blockIdx.x, nbk = gridDim.x; KP pp = (KP)__builtin_amdgcn_kernarg_segment_ptr();
        asm volatile("v_mbcnt_lo_u32_b32 %0, -1, 0\n\tv_mbcnt_hi_u32_b32 %0, -1, %0" : "=v"(lane_));
        asm volatile("" : "+s"(wv_), "+s"(bid), "+s"(nbk), "+s"(pp));
        int tid = wv_ * 64 + lane_; asm volatile("" : "+v"(tid));
        unsigned char* ws = pp->ws;
        float* MOD = (float*)(ws + WS_MOD); float* CTXRES = (float*)(ws + WS_CTXRES);
        bf16* NBp = (bf16*)(ws + WS_NB);
        if (ph == 0) { { const Params p = *pp; prep_phase(p, lds, tid, bid, nbk, 0, PREP_ADA + PREP_PER_LAYER, 0, true); } __syncthreads(); }
        else if (ph == 1) { EpiAda E; E.MOD = MOD; E.b_ada = pp->b_ada; GEMM_RUN(EpiAda, E, ws + WS_SC, D, ws + WS_WADA, D, D, 2 * MODW, 1, 0, 0, 0); }
        else if (ph == PH_TOTAL - 1) { final_phase(pp->out, pp->final_norm, tid, bid, nbk); }
        else {
            const int L = (ph - 2) / PH_PER_LAYER, st = (ph - 2) % PH_PER_LAYER;
            const bool last = (L == DEPTH - 1);
            const float* modl = MOD + (size_t)L * 33 * MODW;
            const unsigned char* wl = ws + WS_W + (size_t)L * LW_SIZE;
            int kind, which = 0, hb = 0;
            if (st < 3) { kind = st; which = 0; }
            else if (st == 3) { kind = 0; which = 1; }
            else if (st < 4 + 5 * NCH) { hb = (st - 4) / 5; kind = 3 + (st - 4) % 5; }
            else if (st == 4 + 5 * NCH) { kind = 8; }
            else { kind = st - (5 + 5 * NCH); which = 2; }
            const bool first_in = (L == 0 && which == 0);
            const float* xl = first_in ? pp->x : pp->out; const float* xc = first_in ? pp->ctx : CTXRES;
            const int nctx = (last && (which == 2 || kind >= 7)) ? 0 : 32;
            if (kind == 0) {
                const float* gain = (which == 0 ? pp->f1_norm : which == 1 ? pp->mix_norm : pp->f2_norm) + L * D;
                const bool carry = (which == 1) || (which == 0 && L > 0);
                if (!carry) normmod_phase(xl, xc, gain, modl, 3 * which, NBp, 0, nctx ? MT : ML, tid, bid, nbk, 0);
                else {
                    const int Lp = which == 1 ? L : L - 1, whp = which == 1 ? 0 : 2;
                    const bool firstp = (Lp == 0 && whp == 0);
                    { EpiResid E; E.src_lat = pp->out; E.src_ctx = firstp ? pp->ctx : CTXRES; E.dst_lat = pp->out; E.dst_ctx = CTXRES; E.modl = MOD + (size_t)Lp * 33 * MODW; E.gidx = whp == 0 ? 2 : 8; E.coef = 0.5f;
                      const unsigned char* wlp = ws + WS_W + (size_t)Lp * LW_SIZE;
                      GEMM_RUN(EpiResid, E, ws + WS_H, DFF, wlp + (whp == 0 ? LW_D1 : LW_D2), DFF, DFF, D, 0, 32, 0, 256); }
                    constexpr int CUTL = 7 * SEQ;
                    if (bid < nbk / 2) normmod_phase(xl, xc, gain, modl, 3 * which, NBp, 0, CUTL, tid, bid + nbk / 2, nbk, nbk / 2);
                    else normmod_phase(xl, xc, gain, modl, 3 * which, NBp, CUTL, ML, tid, bid, nbk, nbk / 2);
                    { XcdBarrier xb_; xb_.bar = (unsigned*)(pp->ws + WS_CTL); xb_.x = xb_xcc_id(); xb_.st = (volatile LAS unsigned*)(lds + XB_LDS_OFF); xcd_barrier(xb_); }
                    normmod_phase(xl, xc, gain, modl, 3 * which, NBp, ML, MT, tid, bid, nbk, 0);
                }
            } else if (kind == 1) {
                EpiSwiGLU E; E.H = (bf16*)(ws + WS_H);
                GEMM_RUN(EpiSwiGLU, E, NBp, D, wl + (which == 0 ? LW_U1 : LW_U2), D, D, 2 * DFF, 256, nctx, 0, 256);
            } else if (kind == 2) {
                EpiResid E; E.src_lat = xl; E.src_ctx = xc; E.dst_lat = pp->out; E.dst_ctx = CTXRES; E.modl = modl; E.gidx = which == 0 ? 2 : 8; E.coef = 0.5f;
                GEMM_RUN(EpiResid, E, ws + WS_H, DFF, wl + (which == 0 ? LW_D1 : LW_D2), DFF, DFF, D, 256, 0, 0, 256);
            } else if (kind == 8) {
                EpiResid E; E.src_lat = pp->out; E.src_ctx = CTXRES; E.dst_lat = pp->out; E.dst_ctx = CTXRES; E.modl = modl; E.gidx = 5; E.coef = 1.0f;
                GEMM_RUN(EpiResid, E, ws + WS_Y, D, wl + LW_OUT, D, D, D, 256, nctx, 0, 256);
            } else if (kind == 3) {
                EpiWin E; E.bA = (bf16*)(ws + WS_BA); E.bB = (bf16*)(ws + WS_BB); E.bC = (bf16*)(ws + WS_BC); E.G = (bf16*)(ws + WS_G); E.hb = hb;
                if (!last) { GEMM_RUN(EpiWin, E, NBp, D, wl + LW_IN, D, D, INWP, HL / 256, HC / 256, (HL / 256) * hb, 256 + (HC / 256) * hb);
                    if (L == 0 && DEPTH > 1) { const int lo_ = PREP_ADA + PREP_PER_LAYER + (PREP_PER_LAYER * hb) / NCH, hi_ = PREP_ADA + PREP_PER_LAYER + (PREP_PER_LAYER * (hb + 1)) / NCH;
                        __syncthreads(); const Params p = *pp; prep_phase(p, lds, tid, bid, nbk, lo_, hi_, nbk / 4, false); __syncthreads(); } }
                else {
                    GEMM_RUN(EpiWin, E, NBp, D, wl + LW_IN, D, D, INWP, HL / 256, 0, (HL / 256) * hb, 0);
                    { const pg8::Gemm g_{(const bf16*)NBp, (const bf16*)(wl + LW_IN), D, D, D}; MapOrder S_; S_.init(0, HC / 256, 0, 256 + (HC / 256) * hb, 4 * 256, nbk, (bid + nbk / 2) % nbk); S_.cmap = 0x7521ull;
                      pg8::gemm_phase<EpiWin, MapOrder, EpiWin::ALIGN, true>(lds, g_, S_, E, tid); } }
            } else if (kind == 4) {
                post_phase((bf16*)(ws + WS_BB), (bf16*)(ws + WS_BC), pp->k_norm + L * 64, pp->mq_norm + L * 256, pp->mkv_norm + L * 128, tid, bid, nbk);
            } else if (kind == 5) {
                for (int s = 0; s < 2; ++s) { EpiPlain E; E.O = (bf16*)(ws + (s ? WS_MKV : WS_MQ)); E.ldc = 512; E.scale = s ? 1.0f : 0.10206207261596575f * LOG2E;
                    GEMM_RUN(EpiPlain, E, (bf16*)(ws + WS_BC) + (s ? 256 : 0), 512, wl + (s ? LW_UKV : LW_UQ), s ? 128 : 256, s ? 128 : 256, 512, HM / 256, 0, 0, 0); }
            } else if (kind == 6) {
                AttnArgs a; a.bA = (const bf16*)(ws + WS_BA); a.bB = (const bf16*)(ws + WS_BB); a.bC = (const bf16*)(ws + WS_BC); a.MQ = (const bf16*)(ws + WS_MQ); a.MKV = (const bf16*)(ws + WS_MKV); a.OB = NBp;
                a.q_norm = pp->q_norm + L * 64; a.na_bias = pp->na_bias + (size_t)L * 4 * 465; a.hb = hb; a.with_ctx_q = last ? 0 : 1;
                attn_phase(a, lds, tid, bid, nbk);
            } else {
                EpiBranch E; E.G = (const bf16*)(ws + WS_G); E.Y = (bf16*)(ws + WS_Y); E.hb = hb;
                GEMM_RUN(EpiBranch, E, NBp, D, wl + LW_BR, D, D, D, HL / 256, nctx ? HC / 256 : 0, (HL / 256) * hb, 256 + (HC / 256) * hb);
            }
        }
        if (ph + 1 < PH_TOTAL) {
            if (ph == 0) grid.sync();
            else { XcdBarrier xb_; xb_.bar = (unsigned*)(pp->ws + WS_CTL); xb_.x = xb_xcc_id(); xb_.st = (volatile LAS unsigned*)(lds + XB_LDS_OFF); xcd_barrier(xb_); }
            for (int e_ = 0; e_ < PROBE_SYNCS; ++e_) grid.sync(); }
    }
#endif
}

extern "C" void kernel_launch(void* const* d_in, const int* in_sizes, int n_in, void* d_out, int out_size, void* d_ws, size_t ws_size, hipStream_t stream) {
    static int grid = 0;
    if (grid == 0) {
        if (n_in != 28 || out_size != ML * D || ws_size < (size_t)1024 * MiB) { fprintf(stderr, "kernel_launch: unexpected problem (n_in %d, out %d, ws %zu)\n", n_in, out_size, ws_size); grid = -1; return; }
        int dev = 0, cus = 0, per_cu = 0;
        (void)hipGetDevice(&dev); (void)hipDeviceGetAttribute(&cus, hipDeviceAttributeMultiprocessorCount, dev);
        (void)hipFuncSetAttribute((const void*)mega_fwd, hipFuncAttributeMaxDynamicSharedMemorySize, LDS_BYTES);
        (void)hipOccupancyMaxActiveBlocksPerMultiprocessor(&per_cu, (const void*)mega_fwd, 512, LDS_BYTES);
        if (per_cu < 1) per_cu = 1;
        grid = cus * per_cu;
    }
    if (grid < 0) return;
    if (hipMemsetAsync((char*)d_ws + WS_CTL, 0, CTL_ZERO_BYTES, stream) != hipSuccess) { fprintf(stderr, "kernel_launch: memset of barrier words failed\n"); return; }
    Params p{};
    const float* const* in = (const float* const*)d_in;
    p.x = in[0]; p.c = in[1]; p.ctx = in[2]; p.c_ctx = in[3]; p.w_ada = in[4]; p.b_ada = in[5];
    p.f1_norm = in[6]; p.f1_wg = in[7]; p.f1_wu = in[8]; p.f1_wd = in[9];
    p.mix_norm = in[10]; p.w_in = in[11]; p.na_bias = in[12]; p.q_norm = in[13]; p.k_norm = in[14]; p.mq_norm = in[15]; p.mkv_norm = in[16];
    p.w_uq = in[17]; p.w_ukv = in[18]; p.w_ba = in[19]; p.w_bb = in[20]; p.w_bc = in[21]; p.w_out = in[22];
    p.f2_norm = in[23]; p.f2_wg = in[24]; p.f2_wu = in[25]; p.f2_wd = in[26]; p.final_norm = in[27];
    p.out = (float*)d_out; p.ws = (unsigned char*)d_ws;
    void* args[] = {&p};
    hipError_t e = hipLaunchCooperativeKernel((const void*)mega_fwd, dim3(grid), dim3(512), args, LDS_BYTES, stream);
    if (e != hipSuccess) fprintf(stderr, "cooperative launch failed: %s (grid %d)\n", hipGetErrorString(e), grid);
}
```
